# Optimizing an MI355X kernel written in HIP

```python
import jax, jax.numpy as jnp
from jax import lax
import numpy as np

D_MODEL = 2048
BATCH = 2
SEQ = 16384
DEPTH = 1

GRID_W = 64
N_META = 16
EPS = 1e-6
NEG_INF = -1e30
NA_HEADS = 8
NA_HEAD_DIM = 128
NA_WIN_ROWS = 8
NA_WIN_COLS = 16
NA_COL_BLOCK = 16
NA_KEY_COLS = NA_COL_BLOCK + NA_WIN_COLS
MLA_HEADS = 8
MLA_Q_RANK = 512
MLA_KV_RANK = 256
MLA_NOPE_DIM = 128
MLA_ROPE_DIM = 64
MLA_V_DIM = 128
MLA_QK_DIM = MLA_NOPE_DIM + MLA_ROPE_DIM
ROPE_THETA = 10000.0
Q_BLOCK = 128
D_FF = 5632
CONV_W = 3

NA_WIDTH = NA_HEADS * NA_HEAD_DIM
MLA_WIDTH = MLA_HEADS * MLA_V_DIM
D_MIX = NA_WIDTH + MLA_WIDTH
IN_COLS = 3 * NA_WIDTH + MLA_Q_RANK + MLA_KV_RANK + MLA_ROPE_DIM
IN_SPLITS = [NA_WIDTH, 2 * NA_WIDTH, 3 * NA_WIDTH, 3 * NA_WIDTH + MLA_Q_RANK, 3 * NA_WIDTH + MLA_Q_RANK + MLA_KV_RANK]

kernel_name = "hybrid_na_mla_convffn_encoder"


def rmsnorm(x, g):
    xf = x.astype(jnp.float32)
    y = xf * lax.rsqrt(jnp.mean(xf * xf, axis=-1, keepdims=True) + EPS)
    return (y * g.astype(jnp.float32)).astype(x.dtype)


def rope_tables(length, dtype):
    inv = ROPE_THETA ** (-jnp.arange(0, MLA_ROPE_DIM, 2, dtype=jnp.float32) / MLA_ROPE_DIM)
    ang = jnp.arange(length, dtype=jnp.float32)[:, None] * inv[None, :]
    return jnp.cos(ang)[:, None, :].astype(dtype), jnp.sin(ang)[:, None, :].astype(dtype)


def apply_rope(x, cos, sin):
    half = x.shape[-1] // 2
    x1, x2 = x[..., :half], x[..., half:]
    return jnp.concatenate([x1 * cos - x2 * sin, x2 * cos + x1 * sin], axis=-1)


def neighbourhood_attention(q, k, v, rpb, meta_bias):
    B, L, H, D = q.shape
    T = L - N_META
    rows = T // GRID_W
    kh = min(NA_WIN_ROWS, rows)
    scale = D ** -0.5
    n_cb = GRID_W // NA_COL_BLOCK
    qm, km, vm = q[:, :N_META], k[:, :N_META], v[:, :N_META]

    s_mm = jnp.einsum('bqhd,bkhd->bhqk', qm, km).astype(jnp.float32) * scale + meta_bias.astype(jnp.float32)[None, :, None, :]
    p_mm = jax.nn.softmax(s_mm, axis=-1).astype(vm.dtype)
    meta_out = jnp.einsum('bhqk,bkhd->bqhd', p_mm, vm)

    qg = q[:, N_META:].reshape(B, rows, GRID_W, H, D)
    kg = k[:, N_META:].reshape(B, rows, GRID_W, H, D)
    vg = v[:, N_META:].reshape(B, rows, GRID_W, H, D)

    qcols = np.arange(GRID_W).reshape(n_cb, NA_COL_BLOCK)
    col_start = np.clip(qcols - NA_WIN_COLS // 2, 0, GRID_W - NA_WIN_COLS)
    kblk_start = np.clip(np.arange(n_cb) * NA_COL_BLOCK - NA_WIN_COLS // 2, 0, GRID_W - NA_KEY_COLS)
    key_cols = kblk_start[:, None] + np.arange(NA_KEY_COLS)[None, :]
    col_valid = (key_cols[:, None, :] >= col_start[:, :, None]) & (key_cols[:, None, :] < col_start[:, :, None] + NA_WIN_COLS)
    col_mask = jnp.asarray(np.where(col_valid, 0.0, NEG_INF), jnp.float32)
    dc_idx = np.clip(key_cols[:, None, :] - qcols[:, :, None] + NA_WIN_COLS - 1, 0, 2 * NA_WIN_COLS - 2)
    rpb32 = rpb.astype(jnp.float32)
    mbias = meta_bias.astype(jnp.float32)[None, None, None]

    def row_block(r):
        rs = jnp.clip(r - kh // 2, 0, rows - kh)
        kb = lax.dynamic_slice_in_dim(kg, rs, kh, axis=1)[:, :, key_cols]
        vb = lax.dynamic_slice_in_dim(vg, rs, kh, axis=1)[:, :, key_cols]
        qr = lax.dynamic_index_in_dim(qg, r, axis=1, keepdims=False).reshape(B, n_cb, NA_COL_BLOCK, H, D)
        s_win = jnp.einsum('bjqhd,bijkhd->bjqhik', qr, kb).astype(jnp.float32) * scale
        dr_idx = rs + jnp.arange(kh) - r + NA_WIN_ROWS - 1
        bias = rpb32[:, dr_idx][:, :, dc_idx].transpose(2, 3, 0, 1, 4)
        s_win = s_win + bias[None] + col_mask[None, :, :, None, None, :]
        s_met = jnp.einsum('bjqhd,bmhd->bjqhm', qr, km).astype(jnp.float32) * scale + mbias
        s = jnp.concatenate([s_met, s_win.reshape(B, n_cb, NA_COL_BLOCK, H, kh * NA_KEY_COLS)], axis=-1)
        p = jax.nn.softmax(s, axis=-1).astype(vb.dtype)
        p_win = p[..., N_META:].reshape(B, n_cb, NA_COL_BLOCK, H, kh, NA_KEY_COLS)
        out = jnp.einsum('bjqhm,bmhd->bjqhd', p[..., :N_META], vm) + jnp.einsum('bjqhik,bijkhd->bjqhd', p_win, vb)
        return out.reshape(B, GRID_W, H, D)

    real = lax.map(row_block, jnp.arange(rows))
    real = real.transpose(1, 0, 2, 3, 4).reshape(B, T, H, D)
    return jnp.concatenate([meta_out, real], axis=1)


def mla_attention(cq, ckv, k_pe, cq_g, ckv_g, w_q_up, w_kv_up, q_g, k_g, cos, sin):
    B, L, _ = cq.shape
    q = (rmsnorm(cq, cq_g) @ w_q_up).reshape(B, L, MLA_HEADS, MLA_QK_DIM)
    kv = (rmsnorm(ckv, ckv_g) @ w_kv_up).reshape(B, L, MLA_HEADS, MLA_NOPE_DIM + MLA_V_DIM)
    k_nope, v = kv[..., :MLA_NOPE_DIM], kv[..., MLA_NOPE_DIM:]
    k = jnp.concatenate([k_nope, jnp.broadcast_to(k_pe[:, :, None, :], (B, L, MLA_HEADS, MLA_ROPE_DIM))], axis=-1)
    q = rmsnorm(q, q_g)
    k = rmsnorm(k, k_g)
    q = jnp.concatenate([q[..., :MLA_NOPE_DIM], apply_rope(q[..., MLA_NOPE_DIM:], cos, sin)], axis=-1)
    k = jnp.concatenate([k[..., :MLA_NOPE_DIM], apply_rope(k[..., MLA_NOPE_DIM:], cos, sin)], axis=-1)
    scale = MLA_QK_DIM ** -0.5

    def attend(qb):
        s = jnp.einsum('bqhd,bkhd->bhqk', qb, k).astype(jnp.float32) * scale
        p = jax.nn.softmax(s, axis=-1).astype(v.dtype)
        return jnp.einsum('bhqk,bkhd->bqhd', p, v)

    out_meta = attend(q[:, :N_META])
    nb = (L - N_META) // Q_BLOCK
    qr = q[:, N_META:].reshape(B, nb, Q_BLOCK, MLA_HEADS, MLA_QK_DIM).transpose(1, 0, 2, 3, 4)
    out_real = lax.map(attend, qr).transpose(1, 0, 2, 3, 4).reshape(B, L - N_META, MLA_HEADS, MLA_V_DIM)
    return jnp.concatenate([out_meta, out_real], axis=1)


def conv_glu(x, w_gate, w_up, conv_w, conv_b, w_down):
    L = x.shape[1]
    g = x @ w_gate
    u = x @ w_up
    pad = CONV_W // 2
    gp = jnp.pad(g, ((0, 0), (pad, pad), (0, 0)))
    gc = conv_b
    for i in range(CONV_W):
        gc = gc + conv_w[i] * gp[:, i:i + L]
    return (jax.nn.silu(gc) * u) @ w_down


def setup_inputs(seed: int = 0) -> dict:
    key = jax.random.key(seed)
    ks = jax.random.split(key, 24)
    f32 = jnp.float32

    def nrm(k, shape, s):
        return jax.random.normal(k, shape, f32) * s

    def gain(k, shape):
        return 1.0 + 0.05 * jax.random.normal(k, shape, f32)

    return {
        "x": nrm(ks[0], (BATCH, SEQ, D_MODEL), 1.0),
        "meta_tokens": nrm(ks[1], (N_META, D_MODEL), 1.0),
        "mix_norm_g": gain(ks[2], (DEPTH, D_MODEL)),
        "w_in": nrm(ks[3], (DEPTH, D_MODEL, IN_COLS), D_MODEL ** -0.5),
        "na_q_g": gain(ks[4], (DEPTH, NA_HEAD_DIM)),
        "na_k_g": gain(ks[5], (DEPTH, NA_HEAD_DIM)),
        "na_rpb": nrm(ks[6], (DEPTH, NA_HEADS, 2 * NA_WIN_ROWS - 1, 2 * NA_WIN_COLS - 1), 0.1),
        "na_meta_bias": nrm(ks[7], (DEPTH, NA_HEADS, N_META), 0.1),
        "mla_cq_g": gain(ks[8], (DEPTH, MLA_Q_RANK)),
        "mla_ckv_g": gain(ks[9], (DEPTH, MLA_KV_RANK)),
        "w_q_up": nrm(ks[10], (DEPTH, MLA_Q_RANK, MLA_HEADS * MLA_QK_DIM), MLA_Q_RANK ** -0.5),
        "w_kv_up": nrm(ks[11], (DEPTH, MLA_KV_RANK, MLA_HEADS * (MLA_NOPE_DIM + MLA_V_DIM)), MLA_KV_RANK ** -0.5),
        "mla_q_g": gain(ks[12], (DEPTH, MLA_QK_DIM)),
        "mla_k_g": gain(ks[13], (DEPTH, MLA_QK_DIM)),
        "na_out_g": gain(ks[14], (DEPTH, NA_WIDTH)),
        "mla_out_g": gain(ks[15], (DEPTH, MLA_WIDTH)),
        "w_out": nrm(ks[16], (DEPTH, D_MIX, D_MODEL), D_MIX ** -0.5),
        "ffn_norm_g": gain(ks[17], (DEPTH, D_MODEL)),
        "w_gate": nrm(ks[18], (DEPTH, D_MODEL, D_FF), D_MODEL ** -0.5),
        "w_up": nrm(ks[19], (DEPTH, D_MODEL, D_FF), D_MODEL ** -0.5),
        "conv_w": nrm(ks[20], (DEPTH, CONV_W, D_FF), CONV_W ** -0.5),
        "conv_b": nrm(ks[21], (DEPTH, D_FF), 0.01),
        "w_down": nrm(ks[22], (DEPTH, D_FF, D_MODEL), D_FF ** -0.5),
    }


def reference(x, meta_tokens, mix_norm_g, w_in, na_q_g, na_k_g, na_rpb, na_meta_bias, mla_cq_g, mla_ckv_g,
              w_q_up, w_kv_up, mla_q_g, mla_k_g, na_out_g, mla_out_g, w_out, ffn_norm_g, w_gate, w_up,
              conv_w, conv_b, w_down):
    B = x.shape[0]
    meta = jnp.broadcast_to(meta_tokens.astype(x.dtype)[None], (B, N_META, D_MODEL))
    h = jnp.concatenate([meta, x], axis=1)
    L = h.shape[1]
    cos, sin = rope_tables(L, x.dtype)
    for l in range(DEPTH):
        hn = rmsnorm(h, mix_norm_g[l])
        proj = hn @ w_in[l]
        q_a, k_a, v_a, cq, ckv, k_pe = jnp.split(proj, IN_SPLITS, axis=-1)
        q_a = rmsnorm(q_a.reshape(B, L, NA_HEADS, NA_HEAD_DIM), na_q_g[l])
        k_a = rmsnorm(k_a.reshape(B, L, NA_HEADS, NA_HEAD_DIM), na_k_g[l])
        v_a = v_a.reshape(B, L, NA_HEADS, NA_HEAD_DIM)
        out_a = neighbourhood_attention(q_a, k_a, v_a, na_rpb[l], na_meta_bias[l]).reshape(B, L, NA_WIDTH)
        out_b = mla_attention(cq, ckv, k_pe, mla_cq_g[l], mla_ckv_g[l], w_q_up[l], w_kv_up[l],
                              mla_q_g[l], mla_k_g[l], cos, sin).reshape(B, L, MLA_WIDTH)
        mix = jnp.concatenate([rmsnorm(out_a, na_out_g[l]), rmsnorm(out_b, mla_out_g[l])], axis=-1)
        h = h + mix @ w_out[l]
        h = h + conv_glu(rmsnorm(h, ffn_norm_g[l]), w_gate[l], w_up[l], conv_w[l], conv_b[l], w_down[l])
    return h[:, N_META:]
```

```cpp
#include <hip/hip_runtime.h>
#include <hip/hip_cooperative_groups.h>
#include <cstdio>
#include <cstdint>
namespace cg = cooperative_groups;

#define LAS __attribute__((address_space(3)))
typedef unsigned short bf16_t;
typedef short bf16x8 __attribute__((ext_vector_type(8)));
typedef short s16x4 __attribute__((ext_vector_type(4)));
typedef float f32x4 __attribute__((ext_vector_type(4)));
typedef float f32x16 __attribute__((ext_vector_type(16)));
typedef unsigned u32x4 __attribute__((ext_vector_type(4)));
typedef unsigned u32x2 __attribute__((ext_vector_type(2)));

constexpr int DM = 2048, SEQ = 16384, NREAL = 32768, MROW0 = 32768, MP = 33024, DFF = 5632, INC = 3904, LTOT = 16400;
constexpr float EPS = 1e-6f, LOG2E = 1.4426950408889634f;
constexpr int PJ = 3072;
constexpr int NCHUNK = 257;
constexpr int PARTW = 132;

constexpr size_t MiB = 1u << 20;
constexpr size_t WS_TAB = 1 * MiB, WS_PART = 6 * MiB, WS_SMALL = 9 * MiB;
constexpr size_t SM_OA15 = 0, SM_MIX15 = 8192, SM_H115 = 32768, SM_HN215 = 65536, SM_G15 = 131072, SM_SSQ = 262144;
constexpr size_t WS_W1T = 16 * MiB, WS_WVT = 28 * MiB, WS_WQT = 32 * MiB, WS_WKVT = 34 * MiB, WS_WOT = 36 * MiB, WS_WGT = 44 * MiB, WS_WUT = 66 * MiB, WS_WDT = 88 * MiB;
constexpr size_t WS_HN = 112 * MiB, WS_PROJ = 241 * MiB, WS_VT = 435 * MiB, WS_CQN = 500 * MiB, WS_CKVN = 533 * MiB, WS_QRAW = 550 * MiB, WS_KV = 647 * MiB;
constexpr size_t WS_OUTA = 776 * MiB, WS_OUTB = 840 * MiB, WS_QP = 112 * MiB, WS_KP = 435 * MiB, WS_MIX = 112 * MiB, WS_HN2 = 816 * MiB, WS_G = 112 * MiB, WS_ACT = 464 * MiB;
constexpr size_t WS_END = 944 * MiB;

__device__ __forceinline__ unsigned cvt_pk_bf16(float lo, float hi) { unsigned r; asm volatile("v_cvt_pk_bf16_f32 %0, %1, %2" : "=v"(r) : "v"(lo), "v"(hi)); return r; }
__device__ __forceinline__ float bflo(unsigned u) { return __uint_as_float(u << 16); }
__device__ __forceinline__ float bfhi(unsigned u) { return __uint_as_float(u & 0xffff0000u); }
__device__ __forceinline__ unsigned short f2bf(float f) { unsigned u = __float_as_uint(f); return (unsigned short)((u + 0x7fffu + ((u >> 16) & 1u)) >> 16); }
__device__ __forceinline__ float bfround(float f) { return __uint_as_float(((unsigned)f2bf(f)) << 16); }
__device__ __forceinline__ float wave_sum(float v) {
#pragma unroll
    for (int o = 1; o < 64; o <<= 1) v += __shfl_xor(v, o);
    return v;
}
__device__ __forceinline__ float wave_max(float v) {
#pragma unroll
    for (int o = 1; o < 64; o <<= 1) v = fmaxf(v, __shfl_xor(v, o));
    return v;
}
__device__ __forceinline__ float dot8(u32x4 a, u32x4 b) {
    return bflo(a.x) * bflo(b.x) + bfhi(a.x) * bfhi(b.x) + bflo(a.y) * bflo(b.y) + bfhi(a.y) * bfhi(b.y)
         + bflo(a.z) * bflo(b.z) + bfhi(a.z) * bfhi(b.z) + bflo(a.w) * bflo(b.w) + bfhi(a.w) * bfhi(b.w);
}

namespace pg8 {
#define PG8_LAS __attribute__((address_space(3)))
constexpr int BM = 256, BK = 64, HALF = 128, HTB = HALF * BK * 2, STAGE_BYTES = 8 * HTB, NXCD = 8, WGM = 8;
__host__ __device__ __forceinline__ int lds_byte(int r, int c) { const int st = (r >> 4) * 2 + (c >> 5), rr = r & 15, cc = c & 31, ob = rr * 64 + cc * 2; return st * 1024 + (ob ^ (((ob >> 9) & 1) << 5)); }
__host__ __device__ __forceinline__ void stage_rc(int b, int& R, int& C) { const int st = b / 1024, sb = b % 1024, swz = sb ^ (((sb >> 9) & 1) << 5); R = (st >> 1) * 16 + swz / 64; C = (st & 1) * 32 + (swz % 64) / 2; }
__host__ __device__ __forceinline__ int perm32(int rho) { const int n = rho >> 4, i = rho & 15; return 8 * (i >> 2) + 4 * n + (i & 3); }
struct Unit { int pm, pn; };
struct Gemm { const bf16_t* A; const bf16_t* Bt; int M, N, K; };
struct StaticOrder {
    int nM, nN, nwg, G, c;
    __host__ __device__ void init(int M, int N, int G_, int c_) { nM = M / BM; nN = N / BM; nwg = nM * nN; G = G_; c = c_; }
    __host__ __device__ bool next(int i, Unit& u) const {
        const long L = (long)i * G + c; if (L >= nwg) return false;
        int wgid = (int)L; { const int q = nwg / NXCD, r = nwg % NXCD, xcd = wgid % NXCD, off = wgid / NXCD; wgid = (xcd < r ? xcd * (q + 1) : r * (q + 1) + (xcd - r) * q) + off; }
        const int nig = WGM * nN, gid = wgid / nig, fm = gid * WGM, gsz = (nM - fm) < WGM ? (nM - fm) : WGM;
        u.pm = fm + ((wgid % nig) % gsz); u.pn = (wgid % nig) / gsz; return true;
    }
    __device__ __forceinline__ void a_ready(const Unit&) const {}
    __device__ __forceinline__ void done(const Unit&) const {}
};
struct EpiBf16 {
    static constexpr bool PERM = true, AFTER_DRAIN = false;
    bf16_t* O; int ldc; const float* ssq;
    __device__ __forceinline__ void operator()(const f32x4 (&acc)[2][2][4][2], const Unit& u, int wr, int wc, int fr, int fq) const {
        const int row0 = u.pm * BM + wr * 64 + fr; const int col0 = u.pn * BM + wc * 32 + 8 * fq;
#pragma unroll
        for (int ai = 0; ai < 2; ++ai)
#pragma unroll
            for (int m = 0; m < 4; ++m) { bf16_t* rowp = O + (size_t)(row0 + ai * HALF + m * 16) * ldc + col0;
                const float rsc = ssq ? __builtin_amdgcn_rsqf(ssq[row0 + ai * HALF + m * 16] * (1.f / DM) + EPS) : 1.f;
#pragma unroll
                for (int bj = 0; bj < 2; ++bj) { const f32x4 v0 = acc[ai][bj][m][0] * rsc, v1 = acc[ai][bj][m][1] * rsc;
                    u32x4 w; w.x = cvt_pk_bf16(v0[0], v0[1]); w.y = cvt_pk_bf16(v0[2], v0[3]); w.z = cvt_pk_bf16(v1[0], v1[1]); w.w = cvt_pk_bf16(v1[2], v1[3]);
                    *(u32x4*)(rowp + bj * HALF) = w; } }
    }
};
struct EpiResF32 {
    static constexpr bool PERM = true, AFTER_DRAIN = false;
    const float* base; float* out; int ldc;
    __device__ __forceinline__ void operator()(const f32x4 (&acc)[2][2][4][2], const Unit& u, int wr, int wc, int fr, int fq) const {
        const int row0 = u.pm * BM + wr * 64 + fr; const int col0 = u.pn * BM + wc * 32 + 8 * fq;
#pragma unroll
        for (int ai = 0; ai < 2; ++ai)
#pragma unroll
            for (int m = 0; m < 4; ++m) { const size_t off = (size_t)(row0 + ai * HALF + m * 16) * ldc + col0;
#pragma unroll
                for (int bj = 0; bj < 2; ++bj) {
                    const f32x4 o0 = *(const f32x4*)(base + off + bj * HALF) + acc[ai][bj][m][0], o1 = *(const f32x4*)(base + off + bj * HALF + 4) + acc[ai][bj][m][1];
                    *(f32x4*)(out + off + bj * HALF) = o0; *(f32x4*)(out + off + bj * HALF + 4) = o1; }
                asm volatile("" ::: "memory"); }
    }
};
struct EpiResSsq {
    static constexpr bool PERM = true, AFTER_DRAIN = false;
    const float* base; float* out; bf16_t* xb; float* ssq; int ldc;
    __device__ __forceinline__ void operator()(const f32x4 (&acc)[2][2][4][2], const Unit& u, int wr, int wc, int fr, int fq) const {
        const int row0 = u.pm * BM + wr * 64 + fr; const int col0 = u.pn * BM + wc * 32 + 8 * fq;
#pragma unroll
        for (int ai = 0; ai < 2; ++ai)
#pragma unroll
            for (int m = 0; m < 4; ++m) { const int row = row0 + ai * HALF + m * 16; const size_t off = (size_t)row * ldc + col0; float sq = 0.f;
#pragma unroll
                for (int bj = 0; bj < 2; ++bj) {
                    const f32x4 o0 = *(const f32x4*)(base + off + bj * HALF) + acc[ai][bj][m][0], o1 = *(const f32x4*)(base + off + bj * HALF + 4) + acc[ai][bj][m][1];
                    *(f32x4*)(out + off + bj * HALF) = o0; *(f32x4*)(out + off + bj * HALF + 4) = o1;
                    u32x4 w; w.x = cvt_pk_bf16(o0[0], o0[1]); w.y = cvt_pk_bf16(o0[2], o0[3]); w.z = cvt_pk_bf16(o1[0], o1[1]); w.w = cvt_pk_bf16(o1[2], o1[3]);
                    *(u32x4*)(xb + off + bj * HALF) = w;
                    sq += (o0[0] * o0[0] + o0[1] * o0[1]) + (o0[2] * o0[2] + o0[3] * o0[3]) + (o1[0] * o1[0] + o1[1] * o1[1]) + (o1[2] * o1[2] + o1[3] * o1[3]); }
                (void)sq; (void)fq;
                asm volatile("" ::: "memory"); }
    }
};
struct EpiConvGlu {
    static constexpr bool PERM = true, AFTER_DRAIN = false;
    const bf16_t* Gt; bf16_t* O; int ldc; const float* cw; const float* cb; const float* g15; const float* ssq;
    __device__ __forceinline__ void operator()(const f32x4 (&acc)[2][2][4][2], const Unit& u, int wr, int wc, int fr, int fq) const {
        const int row0 = u.pm * BM + wr * 64 + fr; const int col0 = u.pn * BM + wc * 32 + 8 * fq;
#pragma unroll
        for (int bj = 0; bj < 2; ++bj) {
            const int col = col0 + bj * HALF;
            const f32x4 w0a = *(const f32x4*)(cw + col), w0b = *(const f32x4*)(cw + col + 4);
            const f32x4 w1a = *(const f32x4*)(cw + DFF + col), w1b = *(const f32x4*)(cw + DFF + col + 4);
            const f32x4 w2a = *(const f32x4*)(cw + 2 * DFF + col), w2b = *(const f32x4*)(cw + 2 * DFF + col + 4);
            const f32x4 cba = *(const f32x4*)(cb + col), cbb = *(const f32x4*)(cb + col + 4);
#pragma unroll
            for (int ai = 0; ai < 2; ++ai)
#pragma unroll
                for (int m = 0; m < 4; ++m) {
                    const int row = row0 + ai * HALF + m * 16; const int t = row & (SEQ - 1), b = row >> 14;
                    const bf16_t* gp = Gt + (size_t)row * ldc + col; const float rsc = __builtin_amdgcn_rsqf(ssq[row] * (1.f / DM) + EPS);
                    const u32x4 gc = *(const u32x4*)gp;
                    f32x4 pa, pb, na, nb;
                    if (t == 0) { pa = *(const f32x4*)(g15 + b * DFF + col); pb = *(const f32x4*)(g15 + b * DFF + col + 4); }
                    else { const u32x4 gq = *(const u32x4*)(gp - ldc); pa = (f32x4){bflo(gq.x), bfhi(gq.x), bflo(gq.y), bfhi(gq.y)}; pb = (f32x4){bflo(gq.z), bfhi(gq.z), bflo(gq.w), bfhi(gq.w)}; }
                    if (t == SEQ - 1) { na = (f32x4){0.f, 0.f, 0.f, 0.f}; nb = na; }
                    else { const u32x4 gq = *(const u32x4*)(gp + ldc); na = (f32x4){bflo(gq.x), bfhi(gq.x), bflo(gq.y), bfhi(gq.y)}; nb = (f32x4){bflo(gq.z), bfhi(gq.z), bflo(gq.w), bfhi(gq.w)}; }
                    const f32x4 ca = (f32x4){bflo(gc.x), bfhi(gc.x), bflo(gc.y), bfhi(gc.y)}, cbv = (f32x4){bflo(gc.z), bfhi(gc.z), bflo(gc.w), bfhi(gc.w)};
                    f32x4 ra, rb;
#pragma unroll
                    for (int e = 0; e < 4; ++e) {
                        const float xa = __builtin_fmaf(w2a[e], na[e], __builtin_fmaf(w1a[e], ca[e], __builtin_fmaf(w0a[e], pa[e], cba[e])));
                        const float xb = __builtin_fmaf(w2b[e], nb[e], __builtin_fmaf(w1b[e], cbv[e], __builtin_fmaf(w0b[e], pb[e], cbb[e])));
                        ra[e] = (xa * __builtin_amdgcn_rcpf(1.f + __builtin_amdgcn_exp2f(xa * -LOG2E))) * (acc[ai][bj][m][0][e] * rsc);
                        rb[e] = (xb * __builtin_amdgcn_rcpf(1.f + __builtin_amdgcn_exp2f(xb * -LOG2E))) * (acc[ai][bj][m][1][e] * rsc); }
                    u32x4 w; w.x = cvt_pk_bf16(ra[0], ra[1]); w.y = cvt_pk_bf16(ra[2], ra[3]); w.z = cvt_pk_bf16(rb[0], rb[1]); w.w = cvt_pk_bf16(rb[2], rb[3]);
                    *(u32x4*)(O + (size_t)row * ldc + col) = w;
                }
        }
    }
};

template <class Epi, class Sched, bool ALIGN_EPI = false, bool SP2 = false>
__device__ __forceinline__ void gemm_phase(PG8_LAS unsigned char* lds, const Gemm g, const Sched& S, const Epi& E, const int tid) {
    const int wid = __builtin_amdgcn_readfirstlane(tid >> 6), lane = tid & 63, wr = wid >> 2, wc = wid & 3, fr = lane & 15, fq = lane >> 4;
    const int K = g.K, nt = K / BK;
    unsigned voffA[2], voffB[2];
#pragma unroll
    for (int i = 0; i < 2; ++i) { int R, C; stage_rc(tid * 16 + i * 8192, R, C); const int Rb = Epi::PERM ? ((R & ~31) + perm32(R & 31)) : R;
        voffA[i] = (unsigned)(R * K + C) * 2u; voffB[i] = (unsigned)(Rb * K + C) * 2u; }
    const size_t kstep = (size_t)(BK * 2);
    const size_t hstep = (size_t)HALF * K * 2;
    const size_t tstep = 2 * hstep;
    const unsigned ldsw = (unsigned)wid * 1024u;
    const int aoff = lds_byte(wr * 64 + fr, fq * 8), boff = lds_byte(wc * 32 + fr, fq * 8);
#define PG8_SA(b, h) (((b) * 2 + (h)) * HTB)
#define PG8_SB(b, h) ((4 + (b) * 2 + (h)) * HTB)
#define PG8_STAGE(bufoff, gbase, voff) do { _Pragma("unroll") for (int _i = 0; _i < 2; ++_i) \
        __builtin_amdgcn_global_load_lds((const unsigned*)((const char*)(gbase) + (voff)[_i]), (PG8_LAS unsigned*)(lds + (bufoff) + ldsw + _i * 8192), 16, 0, 0); } while (0)
#define PG8_LDA(dst, b, h) do { _Pragma("unroll") for (int m = 0; m < 4; ++m) _Pragma("unroll") for (int k = 0; k < 2; ++k) dst[m][k] = *(const PG8_LAS bf16x8*)(lds + PG8_SA(b, h) + aoff + m * 2048 + k * 1024); } while (0)
#define PG8_LDB(dst, b, h) do { _Pragma("unroll") for (int n = 0; n < 2; ++n) _Pragma("unroll") for (int k = 0; k < 2; ++k) dst[n][k] = *(const PG8_LAS bf16x8*)(lds + PG8_SB(b, h) + boff + n * 2048 + k * 1024); } while (0)
#define PG8_MMA(ai, bj, At, Bt) do { __builtin_amdgcn_s_setprio(1); _Pragma("unroll") for (int m = 0; m < 4; ++m) _Pragma("unroll") for (int n = 0; n < 2; ++n) _Pragma("unroll") for (int k = 0; k < 2; ++k) \
        acc[ai][bj][m][n] = __builtin_amdgcn_mfma_f32_16x16x32_bf16(Bt[n][k], At[m][k], acc[ai][bj][m][n], 0, 0, 0); __builtin_amdgcn_s_setprio(0); } while (0)
#define PG8_WAIT_V(n) asm volatile("s_waitcnt vmcnt(" #n ")" ::: "memory")
#define PG8_WAIT_L(n) asm volatile("s_waitcnt lgkmcnt(" #n ")" ::: "memory")
#define PG8_BAR __builtin_amdgcn_s_barrier()
#define PG8_SCHED __builtin_amdgcn_sched_barrier(0)
    Unit cur, nxt; int ui = 0;
    if (!S.next(0, cur)) return;
    f32x4 acc[2][2][4][2];
#pragma unroll
    for (int a = 0; a < 2; ++a)
#pragma unroll
        for (int b = 0; b < 2; ++b)
#pragma unroll
            for (int m = 0; m < 4; ++m)
#pragma unroll
                for (int n = 0; n < 2; ++n) acc[a][b][m][n] = (f32x4){0.f, 0.f, 0.f, 0.f};
    bf16x8 At[4][2], B0[2][2], B1[2][2];
    const char* cA = (const char*)g.A + (size_t)cur.pm * tstep; const char* cB = (const char*)g.Bt + (size_t)cur.pn * tstep;
    S.a_ready(cur);
    if constexpr (SP2) {
        PG8_STAGE(PG8_SB(0, 0), cB, voffB); PG8_STAGE(PG8_SB(0, 1), cB + hstep, voffB); PG8_STAGE(PG8_SA(0, 0), cA, voffA); PG8_STAGE(PG8_SA(0, 1), cA + hstep, voffA);
        if (wr == 1) PG8_BAR;
        PG8_WAIT_V(2); PG8_BAR;
        PG8_STAGE(PG8_SB(1, 0), cB + kstep, voffB); PG8_STAGE(PG8_SA(1, 0), cA + kstep, voffA); PG8_STAGE(PG8_SB(1, 1), cB + hstep + kstep, voffB);
        PG8_WAIT_V(6); PG8_BAR;
    } else {
        PG8_STAGE(PG8_SB(0, 0), cB, voffB); PG8_STAGE(PG8_SA(0, 0), cA, voffA); PG8_STAGE(PG8_SB(0, 1), cB + hstep, voffB); PG8_STAGE(PG8_SA(0, 1), cA + hstep, voffA);
        if (wr == 1) PG8_BAR;
        PG8_WAIT_V(4); PG8_BAR;
        PG8_STAGE(PG8_SB(1, 0), cB + kstep, voffB); PG8_STAGE(PG8_SA(1, 0), cA + kstep, voffA); PG8_STAGE(PG8_SB(1, 1), cB + hstep + kstep, voffB);
        PG8_WAIT_V(6); PG8_BAR;
    }
    for (;;) {
        const bool has_next = S.next(ui + 1, nxt);
        const char* nA = has_next ? (const char*)g.A + (size_t)nxt.pm * tstep : cA; const char* nB = has_next ? (const char*)g.Bt + (size_t)nxt.pn * tstep : cB;
        for (int t = 0; t < nt; t += 2) {
            const bool last = (t == nt - 2);
            const char* a1 = cA + (size_t)(t + 1) * kstep;
            const char* a2 = last ? nA : cA + (size_t)(t + 2) * kstep; const char* b2 = last ? nB : cB + (size_t)(t + 2) * kstep;
            const char* a3 = a2 + kstep; const char* b3 = b2 + kstep;
            if (last && has_next) S.a_ready(nxt);
            if constexpr (SP2) {
            PG8_LDB(B0, 0, 0); PG8_LDB(B1, 0, 1); PG8_SCHED; PG8_LDA(At, 0, 0); PG8_STAGE(PG8_SA(1, 1), a1 + hstep, voffA);
            PG8_WAIT_V(8); PG8_WAIT_L(0); PG8_BAR; PG8_MMA(0, 0, At, B0); PG8_MMA(0, 1, At, B1); PG8_BAR; PG8_SCHED;
            PG8_LDA(At, 0, 1); PG8_STAGE(PG8_SB(0, 0), b2, voffB); PG8_STAGE(PG8_SB(0, 1), b2 + hstep, voffB); PG8_STAGE(PG8_SA(0, 0), a2, voffA);
            PG8_WAIT_V(8); PG8_WAIT_L(0); PG8_BAR; PG8_MMA(1, 0, At, B0); PG8_MMA(1, 1, At, B1); PG8_BAR; PG8_SCHED;
            PG8_LDB(B0, 1, 0); PG8_LDB(B1, 1, 1); PG8_SCHED; PG8_LDA(At, 1, 0); PG8_STAGE(PG8_SA(0, 1), a2 + hstep, voffA);
            PG8_WAIT_V(8); PG8_WAIT_L(0); PG8_BAR; PG8_MMA(0, 0, At, B0); PG8_MMA(0, 1, At, B1); PG8_BAR; PG8_SCHED;
            PG8_LDA(At, 1, 1); PG8_STAGE(PG8_SB(1, 0), b3, voffB); PG8_STAGE(PG8_SB(1, 1), b3 + hstep, voffB); PG8_STAGE(PG8_SA(1, 0), a3, voffA);
            PG8_WAIT_V(8); PG8_WAIT_L(0); PG8_BAR; PG8_MMA(1, 0, At, B0); PG8_MMA(1, 1, At, B1); PG8_BAR; PG8_SCHED;
            } else {
            PG8_LDB(B0, 0, 0); PG8_SCHED; PG8_LDA(At, 0, 0); PG8_STAGE(PG8_SA(1, 1), a1 + hstep, voffA);
            PG8_WAIT_L(8); PG8_BAR; PG8_WAIT_L(0); PG8_MMA(0, 0, At, B0); PG8_BAR; PG8_SCHED;
            PG8_LDB(B1, 0, 1); PG8_STAGE(PG8_SB(0, 0), b2, voffB);
            PG8_BAR; PG8_WAIT_L(0); PG8_MMA(0, 1, At, B1); PG8_BAR;
            PG8_LDA(At, 0, 1); PG8_STAGE(PG8_SA(0, 0), a2, voffA);
            PG8_BAR; PG8_WAIT_L(0); PG8_MMA(1, 0, At, B0); PG8_BAR; PG8_SCHED;
            PG8_STAGE(PG8_SB(0, 1), b2 + hstep, voffB);
            PG8_WAIT_V(6); PG8_BAR; PG8_MMA(1, 1, At, B1); PG8_BAR;
            PG8_LDB(B0, 1, 0); PG8_SCHED; PG8_LDA(At, 1, 0); PG8_STAGE(PG8_SA(0, 1), a2 + hstep, voffA);
            PG8_WAIT_L(8); PG8_BAR; PG8_WAIT_L(0); PG8_MMA(0, 0, At, B0); PG8_BAR; PG8_SCHED;
            PG8_LDB(B1, 1, 1); PG8_STAGE(PG8_SB(1, 0), b3, voffB);
            PG8_BAR; PG8_WAIT_L(0); PG8_MMA(0, 1, At, B1); PG8_BAR;
            PG8_LDA(At, 1, 1); PG8_STAGE(PG8_SA(1, 0), a3, voffA);
            PG8_BAR; PG8_WAIT_L(0); PG8_MMA(1, 0, At, B0); PG8_BAR; PG8_SCHED;
            PG8_STAGE(PG8_SB(1, 1), b3 + hstep, voffB);
            PG8_WAIT_V(6); PG8_BAR; PG8_MMA(1, 1, At, B1); PG8_BAR;
            }
        }
        if constexpr (ALIGN_EPI) { if (wr == 0) PG8_BAR; }
        if constexpr (!Epi::AFTER_DRAIN) { E(acc, cur, wr, wc, fr, fq); S.done(cur); }
        if (!has_next) break;
#pragma unroll
        for (int a = 0; a < 2; ++a)
#pragma unroll
            for (int b = 0; b < 2; ++b)
#pragma unroll
                for (int m = 0; m < 4; ++m)
#pragma unroll
                    for (int n = 0; n < 2; ++n) acc[a][b][m][n] = (f32x4){0.f, 0.f, 0.f, 0.f};
        cur = nxt; cA = nA; cB = nB; ++ui;
        if constexpr (ALIGN_EPI) { if (wr == 1) PG8_BAR; }
    }
    PG8_WAIT_V(0);
    if constexpr (!ALIGN_EPI) { if (wr == 0) PG8_BAR; }
    PG8_BAR;
#undef PG8_SA
#undef PG8_SB
#undef PG8_STAGE
#undef PG8_LDA
#undef PG8_LDB
#undef PG8_MMA
#undef PG8_WAIT_V
#undef PG8_WAIT_L
#undef PG8_BAR
#undef PG8_SCHED
}
}

namespace mla {
constexpr int NW = 8, QBLK = 32, KVBLK = 64;
constexpr float SCALE = 0.07216878364870322f;
constexpr float THR = 8.f;
constexpr int SHM_V = 64 * 128 * 2, SHM_K = 64 * 192 * 2, SHM_ATTN = 2 * SHM_V + 2 * SHM_K + NW * 64 * 4;
constexpr int LDQ = 1536, LDKK = 1536, LDV = 2048, LDO = 1024;
#define SBAR() __builtin_amdgcn_sched_barrier(0)
__device__ __forceinline__ int crow(int r, int hi) { return (r & 3) + 8 * (r >> 2) + 4 * hi; }
__device__ __forceinline__ void partialSM(f32x16& p0, f32x16& p1, float& m_reg, float& mn, float& alpha) {
  constexpr float C = SCALE * 1.4426950408889634f;
  float pmax = p0[0];
#pragma unroll
  for (int r = 1; r < 16; ++r) pmax = fmaxf(pmax, p0[r]);
#pragma unroll
  for (int r = 0; r < 16; ++r) pmax = fmaxf(pmax, p1[r]);
  { auto rr = __builtin_amdgcn_permlane32_swap(__float_as_uint(pmax), __float_as_uint(pmax), false, false);
    pmax = fmaxf(__uint_as_float(rr[0]), __uint_as_float(rr[1])); }
  if (__builtin_expect(__all(pmax - m_reg <= THR / SCALE), 1)) { mn = m_reg; alpha = 1.f; }
  else { mn = fmaxf(m_reg, pmax); alpha = __builtin_amdgcn_exp2f((m_reg - mn) * C); m_reg = mn; }
  float mnC = -mn * C;
#pragma unroll
  for (int r = 0; r < 16; ++r) p0[r] = fmaf(p0[r], C, mnC);
#pragma unroll
  for (int r = 0; r < 16; ++r) p1[r] = fmaf(p1[r], C, mnC);
#pragma unroll
  for (int r = 0; r < 16; ++r) p0[r] = __builtin_amdgcn_exp2f(p0[r]);
}
__device__ __forceinline__ void finishSM(f32x16& p0, f32x16& p1, float alpha, float& l_reg, bf16x8& pa0, bf16x8& pa1, bf16x8& pa2, bf16x8& pa3) {
#pragma unroll
  for (int r = 0; r < 16; ++r) p1[r] = __builtin_amdgcn_exp2f(p1[r]);
  float ps = 0;
#pragma unroll
  for (int r = 0; r < 16; ++r) ps += p0[r];
#pragma unroll
  for (int r = 0; r < 16; ++r) ps += p1[r];
  { auto rr = __builtin_amdgcn_permlane32_swap(__float_as_uint(ps), __float_as_uint(ps), false, false);
    ps = __uint_as_float(rr[0]) + __uint_as_float(rr[1]); }
  l_reg = l_reg * alpha + ps;
#define PK4(P, BASE, OUT) do { unsigned a0 = cvt_pk_bf16(P[BASE + 0], P[BASE + 1]), a1 = cvt_pk_bf16(P[BASE + 2], P[BASE + 3]);   \
    unsigned b0 = cvt_pk_bf16(P[BASE + 4], P[BASE + 5]), b1 = cvt_pk_bf16(P[BASE + 6], P[BASE + 7]);                              \
    auto r0 = __builtin_amdgcn_permlane32_swap(a0, b0, false, false); auto r1 = __builtin_amdgcn_permlane32_swap(a1, b1, false, false); \
    u32x4 w = {r0[0], r1[0], r0[1], r1[1]}; OUT = *reinterpret_cast<bf16x8*>(&w); } while (0)
  PK4(p0, 0, pa0); PK4(p0, 8, pa1); PK4(p1, 0, pa2); PK4(p1, 8, pa3);
#undef PK4
}
__device__ __forceinline__ void qkt(f32x16& p0, f32x16& p1, const char* Ks, const bf16x8* qr, const int* kb4) {
  p0 = f32x16{}; p1 = f32x16{};
#pragma unroll
  for (int d0 = 0; d0 < 12; ++d0) {
    bf16x8 b0 = *reinterpret_cast<const bf16x8*>(Ks + kb4[d0 & 3] + (d0 >> 2) * 128);
    bf16x8 b1 = *reinterpret_cast<const bf16x8*>(Ks + kb4[d0 & 3] + (d0 >> 2) * 128 + 32 * 384);
    p0 = __builtin_amdgcn_mfma_f32_32x32x16_bf16(b0, qr[d0], p0, 0, 0, 0);
    p1 = __builtin_amdgcn_mfma_f32_32x32x16_bf16(b1, qr[d0], p1, 0, 0, 0); }
}
__device__ __forceinline__ int v_st(int k, int c) { const int kk = (k & ~0xC) | ((k & 4) << 1) | ((k & 8) >> 1); return ((kk >> 3) * 4 + (c >> 5)) * 512 + ((kk & 7) * 32 + (c & 31)) * 2; }
__device__ __forceinline__ int v_rd_base(int lane) { return ((lane & 3) << 3) | (((lane >> 2) & 3) << 6) | (((lane >> 4) & 1) << 5) | (((lane >> 5) & 1) << 8); }
constexpr int v_rd_off(int d0, int ks, int half) { return d0 * 512 + ks * 4096 + half * 2048; }
template <int OFF> __device__ __forceinline__ s16x4 tr_read(int vb) {
  s16x4 r; asm volatile("ds_read_b64_tr_b16 %0, %1 offset:%2" : "=&v"(r) : "v"(vb), "i"(OFF) : "memory"); return r;
}
template <int D0> __device__ __forceinline__ void pv_one(f32x16& od, int vb, bf16x8 pa0, bf16x8 pa1, bf16x8 pa2, bf16x8 pa3) {
  const s16x4 l0 = tr_read<v_rd_off(D0, 0, 0)>(vb), h0 = tr_read<v_rd_off(D0, 0, 1)>(vb), l1 = tr_read<v_rd_off(D0, 1, 0)>(vb), h1 = tr_read<v_rd_off(D0, 1, 1)>(vb);
  const s16x4 l2 = tr_read<v_rd_off(D0, 2, 0)>(vb), h2 = tr_read<v_rd_off(D0, 2, 1)>(vb), l3 = tr_read<v_rd_off(D0, 3, 0)>(vb), h3 = tr_read<v_rd_off(D0, 3, 1)>(vb);
  asm volatile("s_waitcnt lgkmcnt(0)" ::: "memory"); SBAR();
#define PK(L, H) (bf16x8){L[0], L[1], L[2], L[3], H[0], H[1], H[2], H[3]}
  od = __builtin_amdgcn_mfma_f32_32x32x16_bf16(pa0, PK(l0, h0), od, 0, 0, 0);
  od = __builtin_amdgcn_mfma_f32_32x32x16_bf16(pa1, PK(l1, h1), od, 0, 0, 0);
  od = __builtin_amdgcn_mfma_f32_32x32x16_bf16(pa2, PK(l2, h2), od, 0, 0, 0);
  od = __builtin_amdgcn_mfma_f32_32x32x16_bf16(pa3, PK(l3, h3), od, 0, 0, 0);
#undef PK
}
__device__ __forceinline__ void pv_d0(f32x16* o, int vb, bf16x8 pa0, bf16x8 pa1, bf16x8 pa2, bf16x8 pa3) {
  pv_one<0>(o[0], vb, pa0, pa1, pa2, pa3); pv_one<1>(o[1], vb, pa0, pa1, pa2, pa3); pv_one<2>(o[2], vb, pa0, pa1, pa2, pa3); pv_one<3>(o[3], vb, pa0, pa1, pa2, pa3);
}

__device__ __forceinline__ void attn_unit(const bf16_t* __restrict__ Qb, const bf16_t* __restrict__ Kh, const bf16_t* __restrict__ Vh,
                                          bf16_t* __restrict__ Ob, int metaRow, int realRow0, char* lds, const int tid) {
  const int wid = tid >> 6, lane = tid & 63, r32 = lane & 31, hi = lane >> 5;
  char* V_lds = lds; char* K_lds = lds + 2 * SHM_V;
  float* ws = (float*)(lds + 2 * SHM_V + 2 * SHM_K) + wid * 64; float* li_l = ws; float* al_l = ws + 32;
  float m_reg = -1e30f, l_reg = 0; f32x16 o[4] = {}; bf16x8 qr[12];
  const bf16_t* Qw = Qb + (long)(wid * QBLK + r32) * LDQ + hi * 8;
#pragma unroll
  for (int d0 = 0; d0 < 12; ++d0) qr[d0] = *reinterpret_cast<const bf16x8*>(Qw + d0 * 16);
  const int sr = tid >> 3, vc = (tid & 7) * 8, vst0 = v_st(sr, vc);
  const int vgo0 = sr * LDV + vc;
  const int kgo0 = sr * LDKK + vc, klo0 = sr * 384 + ((vc * 2) ^ (((sr >> 1) & 7) << 4));
  int kb4[4];
#pragma unroll
  for (int q = 0; q < 4; ++q) kb4[q] = r32 * 384 + ((q * 32 + hi * 16) ^ (((r32 >> 1) & 7) << 4));
  const int vb0 = (int)(uintptr_t)V_lds + v_rd_base(lane);
  bf16x8 vs0, vs1, ks0, ks1, ks2;
#define TROW(t) ((t) == 0 ? (long)metaRow : (long)realRow0 + (long)((t) - 1) * KVBLK)
#define SLOAD(t) do { const long r0_ = TROW(t); const bf16_t* vp_ = Vh + r0_ * LDV + vgo0; const bf16_t* kp_ = Kh + r0_ * LDKK + kgo0; \
    vs0 = *reinterpret_cast<const bf16x8*>(vp_); vs1 = *reinterpret_cast<const bf16x8*>(vp_ + 64); \
    ks0 = *reinterpret_cast<const bf16x8*>(kp_); ks1 = *reinterpret_cast<const bf16x8*>(kp_ + 64); ks2 = *reinterpret_cast<const bf16x8*>(kp_ + 128); } while (0)
#define SWRITE(b) do { *(bf16x8*)(V_lds + (b) * SHM_V + vst0) = vs0; *(bf16x8*)(V_lds + (b) * SHM_V + vst0 + 1024) = vs1; \
    *(bf16x8*)(K_lds + (b) * SHM_K + klo0) = ks0; *(bf16x8*)(K_lds + (b) * SHM_K + klo0 + 128) = ks1; *(bf16x8*)(K_lds + (b) * SHM_K + klo0 + 256) = ks2; } while (0)
#define SWAIT() asm volatile("s_waitcnt vmcnt(0)" ::: "memory")
#define BARL() asm volatile("s_waitcnt lgkmcnt(0)\n\ts_barrier" ::: "memory")
#define RESC(a) do { if (__any((a) < 1.f)) { if (hi == 0) al_l[r32] = (a); asm volatile("s_waitcnt lgkmcnt(0)" ::: "memory"); \
    _Pragma("unroll") for (int d = 0; d < 4; ++d) _Pragma("unroll") for (int r = 0; r < 16; ++r) o[d][r] *= al_l[crow(r, hi)]; } } while (0)
  f32x16 pA0, pA1, pB0, pB1; float mnA, mnB, alA, alB; bf16x8 pa0, pa1, pa2, pa3; constexpr int NT = NCHUNK;
  SLOAD(0); SWAIT(); SWRITE(0); __syncthreads();
  qkt(pA0, pA1, K_lds, qr, kb4);
#pragma unroll
  for (int r = 8; r < 16; ++r) pA0[r] = -1e30f;
#pragma unroll
  for (int r = 0; r < 16; ++r) pA1[r] = -1e30f;
  partialSM(pA0, pA1, m_reg, mnA, alA);
  SLOAD(1); SWAIT(); SWRITE(1); SLOAD(2); BARL();
  for (int j = 1; j + 1 < NT; j += 2) {
    SBAR(); qkt(pB0, pB1, K_lds + SHM_K, qr, kb4);
    finishSM(pA0, pA1, alA, l_reg, pa0, pa1, pa2, pa3); SBAR();
    pv_d0(o, vb0, pa0, pa1, pa2, pa3); partialSM(pB0, pB1, m_reg, mnB, alB);
    BARL(); SWAIT(); SWRITE(0); if (j + 2 < NT) SLOAD(j + 2);
    RESC(alB); BARL();
    SBAR(); qkt(pA0, pA1, K_lds, qr, kb4);
    finishSM(pB0, pB1, alB, l_reg, pa0, pa1, pa2, pa3); SBAR();
    pv_d0(o, vb0 + (int)SHM_V, pa0, pa1, pa2, pa3); partialSM(pA0, pA1, m_reg, mnA, alA);
    BARL(); if (j + 2 < NT) { SWAIT(); SWRITE(1); } if (j + 3 < NT) SLOAD(j + 3);
    RESC(alA); BARL();
  }
  finishSM(pA0, pA1, alA, l_reg, pa0, pa1, pa2, pa3); SBAR();
  pv_d0(o, vb0, pa0, pa1, pa2, pa3);
  if (hi == 0) li_l[r32] = l_reg; asm volatile("s_waitcnt lgkmcnt(0)" ::: "memory");
  float rli[16];
#pragma unroll
  for (int r = 0; r < 16; ++r) rli[r] = __builtin_amdgcn_rcpf(li_l[crow(r, hi)]);
  bf16_t* Ow = Ob + (long)(wid * QBLK) * LDO;
#pragma unroll
  for (int r = 0; r < 16; ++r) { const int orow = crow(r, hi);
#pragma unroll
    for (int d0 = 0; d0 < 4; ++d0) Ow[(long)orow * LDO + d0 * 32 + r32] = f2bf(o[d0][r] * rli[r]); }
  __syncthreads();
#undef TROW
#undef SLOAD
#undef SWRITE
#undef SWAIT
#undef RESC
}


__device__ __forceinline__ void qkt2(f32x16& p0, f32x16& p1, const char* Ks, const bf16x8* qr, const int* kb4) {
#define KLD(d, half) (*reinterpret_cast<const bf16x8*>(Ks + kb4[(d) & 3] + ((d) >> 2) * 128 + (half) * 12288))
  p0 = f32x16{}; p1 = f32x16{};
  bf16x8 a0 = KLD(0, 0), b0 = KLD(0, 1), a1 = KLD(1, 0), b1 = KLD(1, 1), a2, b2;
#define QSTEP(d, A, B, NA, NB) do { if ((d) + 2 < 12) { NA = KLD((d) + 2, 0); NB = KLD((d) + 2, 1); } SBAR(); \
    p0 = __builtin_amdgcn_mfma_f32_32x32x16_bf16(A, qr[d], p0, 0, 0, 0); p1 = __builtin_amdgcn_mfma_f32_32x32x16_bf16(B, qr[d], p1, 0, 0, 0); SBAR(); } while (0)
  QSTEP(0, a0, b0, a2, b2); QSTEP(1, a1, b1, a0, b0); QSTEP(2, a2, b2, a1, b1);
  QSTEP(3, a0, b0, a2, b2); QSTEP(4, a1, b1, a0, b0); QSTEP(5, a2, b2, a1, b1);
  QSTEP(6, a0, b0, a2, b2); QSTEP(7, a1, b1, a0, b0); QSTEP(8, a2, b2, a1, b1);
  QSTEP(9, a0, b0, a2, b2); QSTEP(10, a1, b1, a0, b0); QSTEP(11, a2, b2, a1, b1);
#undef QSTEP
#undef KLD
}
struct VSet { s16x4 l0, h0, l1, h1, l2, h2, l3, h3; };
template <int D0> __device__ __forceinline__ void v_issue(VSet& s, int vb) {
  s.l0 = tr_read<v_rd_off(D0, 0, 0)>(vb); s.h0 = tr_read<v_rd_off(D0, 0, 1)>(vb); s.l1 = tr_read<v_rd_off(D0, 1, 0)>(vb); s.h1 = tr_read<v_rd_off(D0, 1, 1)>(vb);
  s.l2 = tr_read<v_rd_off(D0, 2, 0)>(vb); s.h2 = tr_read<v_rd_off(D0, 2, 1)>(vb); s.l3 = tr_read<v_rd_off(D0, 3, 0)>(vb); s.h3 = tr_read<v_rd_off(D0, 3, 1)>(vb);
}
__device__ __forceinline__ void v_mma(f32x16& od, VSet& s, bf16x8 pa0, bf16x8 pa1, bf16x8 pa2, bf16x8 pa3) {
  asm volatile("" : "+v"(s.l0), "+v"(s.h0), "+v"(s.l1), "+v"(s.h1), "+v"(s.l2), "+v"(s.h2), "+v"(s.l3), "+v"(s.h3));
#define PK(L, H) (bf16x8){L[0], L[1], L[2], L[3], H[0], H[1], H[2], H[3]}
  od = __builtin_amdgcn_mfma_f32_32x32x16_bf16(pa0, PK(s.l0, s.h0), od, 0, 0, 0);
  od = __builtin_amdgcn_mfma_f32_32x32x16_bf16(pa1, PK(s.l1, s.h1), od, 0, 0, 0);
  od = __builtin_amdgcn_mfma_f32_32x32x16_bf16(pa2, PK(s.l2, s.h2), od, 0, 0, 0);
  od = __builtin_amdgcn_mfma_f32_32x32x16_bf16(pa3, PK(s.l3, s.h3), od, 0, 0, 0);
#undef PK
}
__device__ __forceinline__ void pv2(f32x16* o, int vb, bf16x8 pa0, bf16x8 pa1, bf16x8 pa2, bf16x8 pa3) {
  VSet X, Y;
  SBAR(); v_issue<0>(X, vb); v_issue<1>(Y, vb);
  asm volatile("s_waitcnt lgkmcnt(8)" ::: "memory"); SBAR(); v_mma(o[0], X, pa0, pa1, pa2, pa3); SBAR();
  v_issue<2>(X, vb);
  asm volatile("s_waitcnt lgkmcnt(8)" ::: "memory"); SBAR(); v_mma(o[1], Y, pa0, pa1, pa2, pa3); SBAR();
  v_issue<3>(Y, vb);
  asm volatile("s_waitcnt lgkmcnt(8)" ::: "memory"); SBAR(); v_mma(o[2], X, pa0, pa1, pa2, pa3); SBAR();
  asm volatile("s_waitcnt lgkmcnt(0)" ::: "memory"); SBAR(); v_mma(o[3], Y, pa0, pa1, pa2, pa3); SBAR();
}
__device__ __forceinline__ void attn_unit2(const bf16_t* __restrict__ Qb, const bf16_t* __restrict__ Kh, const bf16_t* __restrict__ Vh,
                                           bf16_t* __restrict__ Ob, int metaRow, int realRow0, char* lds, const int tid) {
  const int wid = __builtin_amdgcn_readfirstlane(tid >> 6), lane = tid & 63, r32 = lane & 31, hi = lane >> 5;
  char* V_lds = lds; char* K_lds = lds + 2 * SHM_V;
  float* ws = (float*)(lds + 2 * SHM_V + 2 * SHM_K) + wid * 64; float* li_l = ws; float* al_l = ws + 32;
  float m_reg = -1e30f, l_reg = 0; f32x16 o[4] = {}; bf16x8 qr[12];
  const bf16_t* Qw = Qb + (long)(wid * QBLK + r32) * LDQ + hi * 8;
#pragma unroll
  for (int d0 = 0; d0 < 12; ++d0) qr[d0] = *reinterpret_cast<const bf16x8*>(Qw + d0 * 16);
  const int sr = tid >> 3, vc = (tid & 7) * 8, vst0 = v_st(sr, vc);
  const int vgo0 = sr * LDV + vc;
  const int kgo0 = sr * LDKK + vc, klo0 = sr * 384 + ((vc * 2) ^ (((sr >> 1) & 7) << 4));
  int kb4[4];
#pragma unroll
  for (int q = 0; q < 4; ++q) kb4[q] = r32 * 384 + ((q * 32 + hi * 16) ^ (((r32 >> 1) & 7) << 4));
  const int vb0 = (int)(uintptr_t)V_lds + v_rd_base(lane);
  bf16x8 vs0, vs1, ks0, ks1, ks2;
#define TROW(t) ((t) == 0 ? (long)metaRow : (long)realRow0 + (long)((t) - 1) * KVBLK)
#define SLOAD(t) do { const long r0_ = TROW(t); const bf16_t* vp_ = Vh + r0_ * LDV + vgo0; const bf16_t* kp_ = Kh + r0_ * LDKK + kgo0; \
    vs0 = *reinterpret_cast<const bf16x8*>(vp_); vs1 = *reinterpret_cast<const bf16x8*>(vp_ + 64); \
    ks0 = *reinterpret_cast<const bf16x8*>(kp_); ks1 = *reinterpret_cast<const bf16x8*>(kp_ + 64); ks2 = *reinterpret_cast<const bf16x8*>(kp_ + 128); } while (0)
#define SWRITE(b) do { *(bf16x8*)(V_lds + (b) * SHM_V + vst0) = vs0; *(bf16x8*)(V_lds + (b) * SHM_V + vst0 + 1024) = vs1; \
    *(bf16x8*)(K_lds + (b) * SHM_K + klo0) = ks0; *(bf16x8*)(K_lds + (b) * SHM_K + klo0 + 128) = ks1; *(bf16x8*)(K_lds + (b) * SHM_K + klo0 + 256) = ks2; } while (0)
#define SWAIT() asm volatile("s_waitcnt vmcnt(0)" ::: "memory")
#define BARRIER() asm volatile("s_waitcnt lgkmcnt(0)\n\ts_barrier" ::: "memory")
#define RESC(a) do { if (__any((a) < 1.f)) { if (hi == 0) al_l[r32] = (a); asm volatile("s_waitcnt lgkmcnt(0)" ::: "memory"); \
    _Pragma("unroll") for (int d = 0; d < 4; ++d) _Pragma("unroll") for (int r = 0; r < 16; ++r) o[d][r] *= al_l[crow(r, hi)]; } } while (0)
#define MASK0() do { _Pragma("unroll") for (int r = 8; r < 16; ++r) p0[r] = -1e30f; _Pragma("unroll") for (int r = 0; r < 16; ++r) p1[r] = -1e30f; } while (0)
  f32x16 p0, p1; float mn, al = 1.f; bf16x8 pa0, pa1, pa2, pa3; constexpr int NT = NCHUNK;
  SLOAD(0); SWAIT(); SWRITE(0); BARRIER();
#define S1(t, CUR) do { SBAR(); qkt2(p0, p1, K_lds + (CUR) * SHM_K, qr, kb4); if ((t) == 0) MASK0(); partialSM(p0, p1, m_reg, mn, al); } while (0)
#define S2(t, CUR) do { RESC(al); finishSM(p0, p1, al, l_reg, pa0, pa1, pa2, pa3); SBAR(); pv2(o, vb0 + (CUR) * (int)SHM_V, pa0, pa1, pa2, pa3); } while (0)
  if (wid < 4) {
#define A_TILE(t, CUR) do { S1(t, CUR); BARRIER(); \
      if ((t) + 1 < NT) { SWAIT(); SWRITE((CUR) ^ 1); if ((t) + 2 < NT) SLOAD((t) + 2); } S2(t, CUR); BARRIER(); } while (0)
    SLOAD(1);
    for (int t = 0; t + 1 < NT; t += 2) { A_TILE(t, 0); A_TILE(t + 1, 1); }
    A_TILE(NT - 1, 0);
    BARRIER();
#undef A_TILE
  } else {
    SLOAD(1); BARRIER();
#define B_TILE(t, CUR) do { if ((t) + 1 < NT) { SWAIT(); SWRITE((CUR) ^ 1); if ((t) + 2 < NT) SLOAD((t) + 2); } S1(t, CUR); BARRIER(); \
      S2(t, CUR); BARRIER(); } while (0)
    for (int t = 0; t + 1 < NT; t += 2) { B_TILE(t, 0); B_TILE(t + 1, 1); }
    B_TILE(NT - 1, 0);
#undef B_TILE
  }
  if (hi == 0) li_l[r32] = l_reg; asm volatile("s_waitcnt lgkmcnt(0)" ::: "memory");
  float rli[16];
#pragma unroll
  for (int r = 0; r < 16; ++r) rli[r] = __builtin_amdgcn_rcpf(li_l[crow(r, hi)]);
  bf16_t* Ow = Ob + (long)(wid * QBLK) * LDO;
#pragma unroll
  for (int r = 0; r < 16; ++r) { const int orow = crow(r, hi);
#pragma unroll
    for (int d0 = 0; d0 < 4; ++d0) Ow[(long)orow * LDO + d0 * 32 + r32] = f2bf(o[d0][r] * rli[r]); }
  __syncthreads();
#undef TROW
#undef SLOAD
#undef SWRITE
#undef SWAIT
#undef BARRIER
#undef RESC
#undef MASK0
#undef S1
#undef S2
}
#undef SBAR
}


#define XB_TMO      128
#define XB_XCNT(j)  (256  + 64 * (j))
#define XB_XSUB(j)  (1280 + 64 * (j))
#define XB_XGEN(j)  (2304 + 64 * (j))
#define XB_TOP      3328
#define XB_TOPGEN   3392
#define XCD_BAR_WORDS 3456
#define XB_SPIN_CAP (1u << 18)
__device__ __forceinline__ unsigned xb_ld(unsigned* p)              { return __hip_atomic_load(p, __ATOMIC_RELAXED, __HIP_MEMORY_SCOPE_AGENT); }
__device__ __forceinline__ unsigned xb_add(unsigned* p, unsigned v) { return __hip_atomic_fetch_add(p, v, __ATOMIC_RELAXED, __HIP_MEMORY_SCOPE_AGENT); }
__device__ __forceinline__ unsigned xb_xcc_id() { return (unsigned)__builtin_amdgcn_s_getreg((3 << 11) | 20) & 0xFu; }
#define XB_SPIN(cond, bar) do { unsigned _sp = 0; while (cond) { __builtin_amdgcn_s_sleep(1); \
    if ((++_sp & 255u) == 0u) { if (xb_ld(&(bar)[XB_TMO])) break; if (_sp > XB_SPIN_CAP) { atomicAdd(&(bar)[XB_TMO], 1u); break; } } } } while (0)
struct XcdBarrier { unsigned* bar; unsigned x; volatile LAS unsigned* st; };
__device__ __forceinline__ XcdBarrier xcd_barrier_post(unsigned* bar, volatile LAS unsigned* st) {
    XcdBarrier b; b.bar = bar; b.x = xb_xcc_id(); b.st = st;
    if (threadIdx.x == 0) (void)xb_add(&bar[XB_XCNT(b.x)], 1u);
    return b;
}
__device__ __forceinline__ void xcd_barrier_complete(unsigned* bar, unsigned x, unsigned& nloc, unsigned& nx) {
    const unsigned G = gridDim.x * gridDim.y * gridDim.z;
    unsigned sum, cnt, mine, sp = 0u;
    for (;;) {
        sum = 0u; cnt = 0u; mine = 0u;
#pragma unroll
        for (unsigned j = 0; j < 16; ++j) { const unsigned c = xb_ld(&bar[XB_XCNT(j)]); sum += c; cnt += (c > 0u) ? 1u : 0u; mine = (j == x) ? c : mine; }
        if (sum == G) break;
        __builtin_amdgcn_s_sleep(1);
        if ((++sp & 255u) == 0u) { if (xb_ld(&bar[XB_TMO])) break; if (sp > XB_SPIN_CAP) { atomicAdd(&bar[XB_TMO], 1u); break; } }
    }
    nloc = mine > 0u ? mine : 1u; nx = cnt > 0u ? cnt : 1u;
}
__device__ __forceinline__ void xcd_barrier(const XcdBarrier& b) {
    asm volatile("s_waitcnt vmcnt(0)" ::: "memory");
    __syncthreads();
    if (threadIdx.x == 0) {
        unsigned* bar = b.bar;
        __builtin_amdgcn_s_waitcnt(0);
        unsigned nloc = b.st[0], nx = b.st[1];
        if (nloc == 0u) { xcd_barrier_complete(bar, b.x, nloc, nx); b.st[0] = nloc; b.st[1] = nx; }
        const unsigned old = xb_add(&bar[XB_XSUB(b.x)], 1u);
        const unsigned gen = old / nloc;
        if (old + 1u == (gen + 1u) * nloc) {
            __builtin_amdgcn_fence(__ATOMIC_RELEASE, "agent");
            asm volatile("s_waitcnt vmcnt(0)" ::: "memory");
            const unsigned og = xb_add(&bar[XB_TOP], 1u);
            const unsigned tg = og / nx;
            if (og + 1u == (tg + 1u) * nx) xb_add(&bar[XB_TOPGEN], 1u);
            else XB_SPIN(xb_ld(&bar[XB_TOPGEN]) == tg, bar);
            __builtin_amdgcn_fence(__ATOMIC_ACQUIRE, "agent");
            xb_add(&bar[XB_XGEN(b.x)], 1u);
            asm volatile("s_waitcnt vmcnt(0)" ::: "memory");
        } else {
            XB_SPIN(xb_ld(&bar[XB_XGEN(b.x)]) == gen, bar);
            __builtin_amdgcn_fence(__ATOMIC_ACQUIRE, "agent");
            asm volatile("s_waitcnt vmcnt(0)" ::: "memory");
        }
    }
    __syncthreads();
}

struct Args {
    const float *x, *meta, *mix_g, *w_in, *na_q_g, *na_k_g, *rpb, *meta_bias, *cq_g, *ckv_g, *w_q_up, *w_kv_up, *mq_g, *mk_g, *na_out_g, *mla_out_g, *w_out, *ffn_g, *w_gate, *w_up, *conv_w, *conv_b, *w_down;
    float* out; unsigned char* ws;
};
constexpr int LDS_BYTES = 135168;

__device__ __forceinline__ void tr_item(const float* __restrict__ W, int ldw, int c0, int ncb, int K, bf16_t* __restrict__ WT, int row_off, LAS float* scr, int item, int lane, const float* __restrict__ kgain = nullptr) {
    const int kb = item / ncb, nb = item % ncb, k0 = 64 * kb, n0 = 32 * nb;
    float tv[32];
#pragma unroll
    for (int i = 0; i < 32; ++i) { const int kk = 2 * i + (lane >> 5); tv[i] = W[(size_t)(k0 + kk) * ldw + c0 + n0 + (lane & 31)]; }
    if (kgain) {
#pragma unroll
        for (int i = 0; i < 32; ++i) { const int kk = 2 * i + (lane >> 5); tv[i] *= kgain[k0 + kk]; } }
#pragma unroll
    for (int i = 0; i < 32; ++i) { const int kk = 2 * i + (lane >> 5); scr[kk * 33 + (lane & 31)] = tv[i]; }
    asm volatile("s_waitcnt lgkmcnt(0)" ::: "memory");
    const int c = lane & 7;
#pragma unroll
    for (int j = 0; j < 4; ++j) { const int n = (lane >> 3) + 8 * j; const LAS float* s = scr + (8 * c) * 33 + n;
        u32x4 o; o.x = cvt_pk_bf16(s[0 * 33], s[1 * 33]); o.y = cvt_pk_bf16(s[2 * 33], s[3 * 33]); o.z = cvt_pk_bf16(s[4 * 33], s[5 * 33]); o.w = cvt_pk_bf16(s[6 * 33], s[7 * 33]);
        *(u32x4*)(WT + (size_t)(row_off + n0 + n) * K + k0 + 8 * c) = o; }
    asm volatile("s_waitcnt lgkmcnt(0)" ::: "memory");
}

__device__ __forceinline__ void rms_row_f32(const float* __restrict__ src, const float* __restrict__ gain, bf16_t* __restrict__ dst, int lane) {
    f32x4 v[8]; float s = 0.f;
#pragma unroll
    for (int j = 0; j < 8; ++j) { v[j] = *(const f32x4*)(src + 4 * lane + 256 * j); s += (v[j].x * v[j].x + v[j].y * v[j].y) + (v[j].z * v[j].z + v[j].w * v[j].w); }
    const float rs = __builtin_amdgcn_rsqf(wave_sum(s) * (1.f / DM) + EPS);
#pragma unroll
    for (int j = 0; j < 8; ++j) { const f32x4 g = *(const f32x4*)(gain + 4 * lane + 256 * j); u32x2 w; w.x = cvt_pk_bf16(v[j].x * rs * g.x, v[j].y * rs * g.y); w.y = cvt_pk_bf16(v[j].z * rs * g.z, v[j].w * rs * g.w);
        *(u32x2*)(dst + 4 * lane + 256 * j) = w; }
}

__global__ void __launch_bounds__(512, 2) fwd_kernel(Args P) {
    extern __shared__ __attribute__((aligned(16))) unsigned char lds[];
    cg::grid_group grid = cg::this_grid();
    volatile LAS unsigned* bst = (volatile LAS unsigned*)((LAS unsigned char*)lds + 131072 + 64);
    if (threadIdx.x < 2) bst[threadIdx.x] = 0u;
    __syncthreads();
    const XcdBarrier xbar = xcd_barrier_post((unsigned*)P.ws, bst);
    const int wid0 = __builtin_amdgcn_readfirstlane((int)threadIdx.x >> 6);
    const int G = gridDim.x, NGW = G * 8;
#define CAS __attribute__((address_space(4)))
#define PH_BEGIN const CAS Args* pa_ = (const CAS Args*)__builtin_amdgcn_kernarg_segment_ptr(); asm volatile("" : "+s"(pa_)); const CAS Args& P = *pa_; (void)P;   \
    int tid; asm volatile("v_mbcnt_lo_u32_b32 %0, -1, 0\n\tv_mbcnt_hi_u32_b32 %0, -1, %0" : "=v"(tid)); tid += wid0 * 64;     const int lane = tid & 63, wid = __builtin_amdgcn_readfirstlane(tid >> 6), gw = blockIdx.x * 8 + wid; (void)lane; (void)gw;
    unsigned char* ws = P.ws;
        bf16_t* W1T = (bf16_t*)(ws + WS_W1T); bf16_t* WVT = (bf16_t*)(ws + WS_WVT); bf16_t* WQT = (bf16_t*)(ws + WS_WQT); bf16_t* WKVT = (bf16_t*)(ws + WS_WKVT);
        bf16_t* WOT = (bf16_t*)(ws + WS_WOT); bf16_t* WGT = (bf16_t*)(ws + WS_WGT); bf16_t* WUT = (bf16_t*)(ws + WS_WUT); bf16_t* WDT = (bf16_t*)(ws + WS_WDT);
        bf16_t* HN = (bf16_t*)(ws + WS_HN); bf16_t* PROJ = (bf16_t*)(ws + WS_PROJ); bf16_t* VT = (bf16_t*)(ws + WS_VT); bf16_t* CQN = (bf16_t*)(ws + WS_CQN); bf16_t* CKVN = (bf16_t*)(ws + WS_CKVN);
        bf16_t* QRAW = (bf16_t*)(ws + WS_QRAW); bf16_t* KV = (bf16_t*)(ws + WS_KV); bf16_t* OUTA = (bf16_t*)(ws + WS_OUTA); bf16_t* OUTB = (bf16_t*)(ws + WS_OUTB);
        bf16_t* QP = (bf16_t*)(ws + WS_QP); bf16_t* KP = (bf16_t*)(ws + WS_KP); bf16_t* MIX = (bf16_t*)(ws + WS_MIX); bf16_t* HN2 = (bf16_t*)(ws + WS_HN2);
        bf16_t* GB = (bf16_t*)(ws + WS_G); bf16_t* ACT = (bf16_t*)(ws + WS_ACT);
        float* TAB = (float*)(ws + WS_TAB); float* PART = (float*)(ws + WS_PART);
        float* OA15 = (float*)(ws + WS_SMALL + SM_OA15); float* MIX15 = (float*)(ws + WS_SMALL + SM_MIX15); float* H115 = (float*)(ws + WS_SMALL + SM_H115);
        float* HN215 = (float*)(ws + WS_SMALL + SM_HN215); float* G15 = (float*)(ws + WS_SMALL + SM_G15); float* SSQ = (float*)(ws + WS_SMALL + SM_SSQ); (void)HN215;

        { PH_BEGIN
            LAS float* scr = (LAS float*)((LAS unsigned char*)lds + wid * 16384);
            constexpr int I1 = 32 * 64, I2 = 32 * 32, I3 = 32 * 26, I4 = 8 * 48, I5 = 4 * 64, I6 = 32 * 64, I7 = 32 * 176, I8 = 32 * 176, I9 = 88 * 64;
            constexpr int NIT = I1 + I2 + I3 + I4 + I5 + I6 + I7 + I8 + I9;
            for (int it = gw; it < NIT; it += NGW) {
                int r = it;
                if (r < I1) { tr_item(P.w_in, INC, 0, 64, DM, W1T, 0, scr, r, lane); continue; } r -= I1;
                if (r < I2) { tr_item(P.w_in, INC, 2048, 32, DM, WVT, 0, scr, r, lane); continue; } r -= I2;
                if (r < I3) { tr_item(P.w_in, INC, 3072, 26, DM, W1T, 2048, scr, r, lane); continue; } r -= I3;
                if (r < I4) { tr_item(P.w_q_up, 1536, 0, 48, 512, WQT, 0, scr, r, lane); continue; } r -= I4;
                if (r < I5) { tr_item(P.w_kv_up, 2048, 0, 64, 256, WKVT, 0, scr, r, lane); continue; } r -= I5;
                if (r < I6) { tr_item(P.w_out, DM, 0, 64, DM, WOT, 0, scr, r, lane); continue; } r -= I6;
                if (r < I7) { tr_item(P.w_gate, DFF, 0, 176, DM, WGT, 0, scr, r, lane, P.ffn_g); continue; } r -= I7;
                if (r < I8) { tr_item(P.w_up, DFF, 0, 176, DM, WUT, 0, scr, r, lane, P.ffn_g); continue; } r -= I8;
                tr_item(P.w_down, DM, 0, 64, DFF, WDT, 0, scr, r, lane);
            }
            for (int i = blockIdx.x * 512 + tid; i < NREAL; i += G * 512) SSQ[i] = 0.f;
            { const u32x4 z = {0u, 0u, 0u, 0u};
              for (size_t i = (size_t)blockIdx.x * 512 + tid; i < (size_t)192 * DM / 8; i += (size_t)G * 512) *(u32x4*)(W1T + (size_t)2880 * DM + i * 8) = z;
              for (size_t i = (size_t)blockIdx.x * 512 + tid; i < (size_t)(MP - 32800) * DM / 8; i += (size_t)G * 512) *(u32x4*)(HN + (size_t)32800 * DM + i * 8) = z; }
            for (int row = gw; row < 32800; row += NGW) {
                const float* src = row < NREAL ? P.x + (size_t)row * DM : P.meta + (size_t)((row - MROW0) & 15) * DM;
                rms_row_f32(src, P.mix_g, HN + (size_t)row * DM, lane);
            }
            for (int e = blockIdx.x * 512 + tid; e < LTOT * 32; e += G * 512) {
                const int pos = e >> 5, i = e & 31;
                const double inv = exp2(-(double)i * (13.287712379549449 / 32.0));
                const float a = (float)pos * (float)inv;
                double rev = (double)a * 0.15915494309189535; rev -= rint(rev);
                const float fr = (float)rev;
                TAB[2 * e] = __builtin_amdgcn_cosf(fr); TAB[2 * e + 1] = __builtin_amdgcn_sinf(fr);
            }
        }
        grid.sync();
        { PH_BEGIN pg8::Gemm g = pg8::Gemm{HN, W1T, MP, PJ, DM}; pg8::EpiBf16 E = pg8::EpiBf16{PROJ, PJ, nullptr}; pg8::StaticOrder S; S.init(g.M, g.N, G, (int)blockIdx.x);
          pg8::gemm_phase<pg8::EpiBf16, pg8::StaticOrder, true, true>((LAS unsigned char*)lds, g, S, E, tid); }
        { PH_BEGIN pg8::Gemm g = pg8::Gemm{WVT, HN, 1024, MP, DM}; pg8::EpiBf16 E = pg8::EpiBf16{VT, MP, nullptr}; pg8::StaticOrder S; S.init(g.M, g.N, G, (int)((blockIdx.x + G / 2) % G));
          pg8::gemm_phase<pg8::EpiBf16, pg8::StaticOrder, true, true>((LAS unsigned char*)lds, g, S, E, tid); }
        xcd_barrier(xbar);
        { PH_BEGIN
            for (int row = gw; row < MP; row += NGW) {
                bf16_t* pr = PROJ + (size_t)row * PJ;
#pragma unroll
                for (int i = 0; i < 4; ++i) {
                    const u32x4 v = *(const u32x4*)(pr + 512 * i + 8 * lane);
                    float f0 = bflo(v.x), f1 = bfhi(v.x), f2 = bflo(v.y), f3 = bfhi(v.y), f4 = bflo(v.z), f5 = bfhi(v.z), f6 = bflo(v.w), f7 = bfhi(v.w);
                    float ss = f0 * f0 + f1 * f1 + f2 * f2 + f3 * f3 + f4 * f4 + f5 * f5 + f6 * f6 + f7 * f7;
                    ss += __shfl_xor(ss, 1); ss += __shfl_xor(ss, 2); ss += __shfl_xor(ss, 4); ss += __shfl_xor(ss, 8);
                    const float rs = __builtin_amdgcn_rsqf(ss * (1.f / 128.f) + EPS);
                    const float* gp = (i < 2 ? P.na_q_g : P.na_k_g) + ((8 * lane) & 127);
                    const f32x4 g0 = *(const f32x4*)gp, g1 = *(const f32x4*)(gp + 4);
                    u32x4 w; w.x = cvt_pk_bf16(f0 * rs * g0.x, f1 * rs * g0.y); w.y = cvt_pk_bf16(f2 * rs * g0.z, f3 * rs * g0.w); w.z = cvt_pk_bf16(f4 * rs * g1.x, f5 * rs * g1.y); w.w = cvt_pk_bf16(f6 * rs * g1.z, f7 * rs * g1.w);
                    *(u32x4*)(pr + 512 * i + 8 * lane) = w;
                }
                {
                    const u32x4 v = *(const u32x4*)(pr + 2048 + 8 * lane);
                    float f0 = bflo(v.x), f1 = bfhi(v.x), f2 = bflo(v.y), f3 = bfhi(v.y), f4 = bflo(v.z), f5 = bfhi(v.z), f6 = bflo(v.w), f7 = bfhi(v.w);
                    const float ss = wave_sum(f0 * f0 + f1 * f1 + f2 * f2 + f3 * f3 + f4 * f4 + f5 * f5 + f6 * f6 + f7 * f7);
                    const float rs = __builtin_amdgcn_rsqf(ss * (1.f / 512.f) + EPS);
                    const float* gp = P.cq_g + 8 * lane; const f32x4 g0 = *(const f32x4*)gp, g1 = *(const f32x4*)(gp + 4);
                    u32x4 w; w.x = cvt_pk_bf16(f0 * rs * g0.x, f1 * rs * g0.y); w.y = cvt_pk_bf16(f2 * rs * g0.z, f3 * rs * g0.w); w.z = cvt_pk_bf16(f4 * rs * g1.x, f5 * rs * g1.y); w.w = cvt_pk_bf16(f6 * rs * g1.z, f7 * rs * g1.w);
                    *(u32x4*)(CQN + (size_t)row * 512 + 8 * lane) = w;
                }
                {
                    const u32x4 v = *(const u32x4*)(pr + 2560 + 8 * lane);
                    float f0 = bflo(v.x), f1 = bfhi(v.x), f2 = bflo(v.y), f3 = bfhi(v.y), f4 = bflo(v.z), f5 = bfhi(v.z), f6 = bflo(v.w), f7 = bfhi(v.w);
                    float ss = f0 * f0 + f1 * f1 + f2 * f2 + f3 * f3 + f4 * f4 + f5 * f5 + f6 * f6 + f7 * f7;
                    ss += __shfl_xor(ss, 1); ss += __shfl_xor(ss, 2); ss += __shfl_xor(ss, 4); ss += __shfl_xor(ss, 8); ss += __shfl_xor(ss, 16);
                    const float rs = __builtin_amdgcn_rsqf(ss * (1.f / 256.f) + EPS);
                    const float* gp = P.ckv_g + ((8 * lane) & 255); const f32x4 g0 = *(const f32x4*)gp, g1 = *(const f32x4*)(gp + 4);
                    u32x4 w; w.x = cvt_pk_bf16(f0 * rs * g0.x, f1 * rs * g0.y); w.y = cvt_pk_bf16(f2 * rs * g0.z, f3 * rs * g0.w); w.z = cvt_pk_bf16(f4 * rs * g1.x, f5 * rs * g1.y); w.w = cvt_pk_bf16(f6 * rs * g1.z, f7 * rs * g1.w);
                    if (lane < 32) *(u32x4*)(CKVN + (size_t)row * 256 + 8 * lane) = w;
                }
            }
        }
        xcd_barrier(xbar);
        { PH_BEGIN pg8::Gemm g = pg8::Gemm{CQN, WQT, MP, 1536, 512}; pg8::EpiBf16 E = pg8::EpiBf16{QRAW, 1536, nullptr}; pg8::StaticOrder S; S.init(g.M, g.N, G, (int)blockIdx.x);
          pg8::gemm_phase<pg8::EpiBf16, pg8::StaticOrder, true, true>((LAS unsigned char*)lds, g, S, E, tid); }
        { PH_BEGIN pg8::Gemm g = pg8::Gemm{CKVN, WKVT, MP, 2048, 256}; pg8::EpiBf16 E = pg8::EpiBf16{KV, 2048, nullptr}; pg8::StaticOrder S; S.init(g.M, g.N, G, (int)((blockIdx.x + G / 2) % G));
          pg8::gemm_phase<pg8::EpiBf16, pg8::StaticOrder, true, true>((LAS unsigned char*)lds, g, S, E, tid); }
        { PH_BEGIN
            const int ql = lane & 15, g = lane >> 4, rsel = wid >> 2, j = wid & 3;
            float* rp = (float*)lds + wid * 512;
            char* stg = (char*)lds + 16384;
            int hcur = -1;
            const int xcd = (int)blockIdx.x & 7, cblk = (int)blockIdx.x >> 3;
            const int ktok = tid >> 4, kc = tid & 15, klds = ktok * 256 + 16 * (kc ^ ((((ktok >> 3) & 3) << 2) | (ktok & 3)));
            const int vd = tid >> 3, vc = tid & 7, vlds = vd * 128 + 16 * (vc ^ ((vd >> 1) & 7));
            const int kb = min(max(16 * j - 8, 0), 32);
            const int xh = ((kb >> 3) + (ql >> 2)) & 3, xl = ql & 3;
            const int kbase = (kb + 8 * (ql >> 2) + (ql & 3)) * 256 + 16 * (g ^ xl);
            const int kofs0 = kbase + 64 * (0 ^ xh), kofs1 = kbase + 64 * (1 ^ xh), kofs2 = kbase + 64 * (2 ^ xh), kofs3 = kbase + 64 * (3 ^ xh);
            const int vofs = ql * 128 + 16 * (((kb >> 3) + g) ^ (ql >> 1));
            for (int k = 0;; ++k) {
                int combo, rpair;
                if (G == 256) { if (k >= 8) break; const int lin = k * 32 + cblk; combo = xcd * 2 + (lin >> 7); rpair = lin & 127; }
                else { const int bi = (int)blockIdx.x + k * G; if (bi >= 2048) break; combo = bi >> 7; rpair = bi & 127; }
                const int h = combo & 7, b = combo >> 3, r0 = 2 * rpair, r = r0 + rsel;
                if (h != hcur) { for (int i = lane; i < 465; i += 64) rp[i] = P.rpb[h * 465 + i]; hcur = h; }
                const int u0 = min(max(r0 - 4, 0), 248), rs = min(max(r - 4, 0), 248);
                const size_t tokb = (size_t)b * SEQ, tok_q = tokb + r * 64 + 16 * j;
                const bf16_t* qp = PROJ + (tok_q + ql) * PJ + h * 128 + 8 * g;
                bf16x8 qf[4];
#pragma unroll
                for (int ds = 0; ds < 4; ++ds) qf[ds] = *(const bf16x8*)(qp + 32 * ds);
#define NA_LOADT(s, R0, R1) do { const size_t t0_ = tokb + (size_t)min(u0 + ((s) % 9), 255) * 64; \
                    if ((s) < 9) { const bf16_t* p_ = PROJ + (t0_ + ktok) * PJ + 1024 + h * 128 + kc * 8; R0 = *(const bf16x8*)p_; R1 = *(const bf16x8*)(p_ + (size_t)32 * PJ); } \
                    else { const bf16_t* p_ = VT + (size_t)(h * 128 + vd) * MP + t0_ + vc * 8; R0 = *(const bf16x8*)p_; R1 = *(const bf16x8*)(p_ + (size_t)64 * MP); } } while (0)
#define NA_WRITET(s, R0, R1) do { char* b_ = stg + ((s) & 1) * 16384; \
                    if ((s) < 9) { *(bf16x8*)(b_ + klds) = R0; *(bf16x8*)(b_ + klds + 8192) = R1; } else { *(bf16x8*)(b_ + vlds) = R0; *(bf16x8*)(b_ + vlds + 8192) = R1; } } while (0)
#define NA_BAR() asm volatile("s_waitcnt lgkmcnt(0)\n\ts_barrier" ::: "memory")
                bf16x8 ra0, ra1, rb0, rb1;
                NA_LOADT(0, ra0, ra1); NA_LOADT(1, rb0, rb1);
                f32x4 st[19];
#define NA_SSTEP(s, R0, R1) do { NA_WRITET(s, R0, R1); NA_LOADT((s) + 2, R0, R1); NA_BAR(); \
                    const char* kbuf_ = stg + ((s) & 1) * 16384; \
                    _Pragma("unroll") for (int hh = 0; hh < 2; ++hh) { f32x4 a = {0.f, 0.f, 0.f, 0.f}; \
                        a = __builtin_amdgcn_mfma_f32_16x16x32_bf16(*(const bf16x8*)(kbuf_ + hh * 1024 + kofs0), qf[0], a, 0, 0, 0); \
                        a = __builtin_amdgcn_mfma_f32_16x16x32_bf16(*(const bf16x8*)(kbuf_ + hh * 1024 + kofs1), qf[1], a, 0, 0, 0); \
                        a = __builtin_amdgcn_mfma_f32_16x16x32_bf16(*(const bf16x8*)(kbuf_ + hh * 1024 + kofs2), qf[2], a, 0, 0, 0); \
                        a = __builtin_amdgcn_mfma_f32_16x16x32_bf16(*(const bf16x8*)(kbuf_ + hh * 1024 + kofs3), qf[3], a, 0, 0, 0); \
                        st[2 * (s) + hh] = a; } } while (0)
                NA_SSTEP(0, ra0, ra1); NA_SSTEP(1, rb0, rb1); NA_SSTEP(2, ra0, ra1); NA_SSTEP(3, rb0, rb1); NA_SSTEP(4, ra0, ra1);
                NA_SSTEP(5, rb0, rb1); NA_SSTEP(6, ra0, ra1);
                bf16x8 km[4];
                { const bf16_t* kpm = PROJ + (size_t)(MROW0 + ql) * PJ + 1024 + h * 128 + 8 * g;
#pragma unroll
                  for (int ds = 0; ds < 4; ++ds) km[ds] = *(const bf16x8*)(kpm + 32 * ds); }
                NA_SSTEP(7, rb0, rb1); NA_SSTEP(8, ra0, ra1);
                { f32x4 a = {0.f, 0.f, 0.f, 0.f};
#pragma unroll
                  for (int ds = 0; ds < 4; ++ds) a = __builtin_amdgcn_mfma_f32_16x16x32_bf16(km[ds], qf[ds], a, 0, 0, 0);
                  st[18] = a; }
                const int c = 16 * j + ql, cs = min(max(c - 8, 0), 48);
                constexpr float SC = 0.08838834764831845f;
                float mx = -1e30f;
#pragma unroll
                for (int t = 0; t < 18; ++t) {
                    const int kr = u0 + (t >> 1); const bool rowok = (kr >= rs) && (kr < rs + 8);
                    const int dr = min(max(kr - r + 7, 0), 14);
#pragma unroll
                    for (int e = 0; e < 4; ++e) {
                        const int kcol = kb + 8 * g + 4 * (t & 1) + e; const bool valid = rowok && (kcol >= cs) && (kcol < cs + 16);
                        const int dc = min(max(kcol - c + 15, 0), 30);
                        float sv = (st[t][e] * SC + rp[dr * 31 + dc]) * LOG2E; sv = valid ? sv : -1e30f; st[t][e] = sv; mx = fmaxf(mx, sv);
                    }
                }
#pragma unroll
                for (int e = 0; e < 4; ++e) { const float sv = (st[18][e] * SC + P.meta_bias[h * 16 + 4 * g + e]) * LOG2E; st[18][e] = sv; mx = fmaxf(mx, sv); }
                mx = fmaxf(mx, __shfl_xor(mx, 16)); mx = fmaxf(mx, __shfl_xor(mx, 32));
                float l = 0.f;
#pragma unroll
                for (int t = 0; t < 19; ++t)
#pragma unroll
                    for (int e = 0; e < 4; ++e) { const float p = __builtin_amdgcn_exp2f(st[t][e] - mx); st[t][e] = p; l += p; }
                l += __shfl_xor(l, 16); l += __shfl_xor(l, 32);
                f32x4 o[8];
#pragma unroll
                for (int dg = 0; dg < 8; ++dg) o[dg] = (f32x4){0.f, 0.f, 0.f, 0.f};
#define NA_VSTEP(s, R0, R1) do { NA_WRITET(s, R0, R1); if ((s) + 2 < 18) NA_LOADT((s) + 2, R0, R1); NA_BAR(); \
                    const char* vbuf_ = stg + ((s) & 1) * 16384 + vofs; constexpr int i_ = (s) - 9; \
                    u32x4 pw; pw.x = cvt_pk_bf16(st[2 * i_][0], st[2 * i_][1]); pw.y = cvt_pk_bf16(st[2 * i_][2], st[2 * i_][3]); pw.z = cvt_pk_bf16(st[2 * i_ + 1][0], st[2 * i_ + 1][1]); pw.w = cvt_pk_bf16(st[2 * i_ + 1][2], st[2 * i_ + 1][3]); \
                    const bf16x8 pa = __builtin_bit_cast(bf16x8, pw); \
                    _Pragma("unroll") for (int dg = 0; dg < 8; ++dg) o[dg] = __builtin_amdgcn_mfma_f32_16x16x32_bf16(pa, *(const bf16x8*)(vbuf_ + dg * 2048), o[dg], 0, 0, 0); } while (0)
                NA_VSTEP(9, rb0, rb1); NA_VSTEP(10, ra0, ra1); NA_VSTEP(11, rb0, rb1); NA_VSTEP(12, ra0, ra1); NA_VSTEP(13, rb0, rb1);
                NA_VSTEP(14, ra0, ra1); NA_VSTEP(15, rb0, rb1);
                u32x2 vmf[8];
                { const bf16_t* vm = VT + (size_t)(h * 128 + ql) * MP + MROW0 + 4 * g;
#pragma unroll
                  for (int dg = 0; dg < 8; ++dg) vmf[dg] = *(const u32x2*)(vm + (size_t)(16 * dg) * MP); }
                NA_VSTEP(16, ra0, ra1); NA_VSTEP(17, rb0, rb1);
                {   u32x4 pw; pw.x = cvt_pk_bf16(st[18][0], st[18][1]); pw.y = cvt_pk_bf16(st[18][2], st[18][3]); pw.z = 0u; pw.w = 0u;
                    const bf16x8 pa = __builtin_bit_cast(bf16x8, pw);
#pragma unroll
                    for (int dg = 0; dg < 8; ++dg) { const u32x4 bw = {vmf[dg].x, vmf[dg].y, 0u, 0u};
                        o[dg] = __builtin_amdgcn_mfma_f32_16x16x32_bf16(pa, __builtin_bit_cast(bf16x8, bw), o[dg], 0, 0, 0); }
                }
#undef NA_LOADT
#undef NA_WRITET
#undef NA_BAR
#undef NA_SSTEP
#undef NA_VSTEP
                const float inv = __builtin_amdgcn_rcpf(l);
                float il[4];
#pragma unroll
                for (int e = 0; e < 4; ++e) il[e] = __shfl(inv, 4 * g + e);
#pragma unroll
                for (int e = 0; e < 4; ++e) { bf16_t* op = OUTA + (tok_q + 4 * g + e) * 1024 + h * 128 + ql;
#pragma unroll
                    for (int dg = 0; dg < 8; ++dg) op[16 * dg] = f2bf(o[dg][e] * il[e]); }
            }
            __syncthreads();
            if (gw < 8) {
                const int h = gw;
                const bf16_t* qp = PROJ + (size_t)(MROW0 + ql) * PJ + h * 128 + 8 * g; const bf16_t* kp = qp + 1024;
                f32x4 a = {0.f, 0.f, 0.f, 0.f};
#pragma unroll
                for (int ds = 0; ds < 4; ++ds) a = __builtin_amdgcn_mfma_f32_16x16x32_bf16(*(const bf16x8*)(kp + 32 * ds), *(const bf16x8*)(qp + 32 * ds), a, 0, 0, 0);
                float mx = -1e30f;
#pragma unroll
                for (int e = 0; e < 4; ++e) { a[e] = (a[e] * 0.08838834764831845f + P.meta_bias[h * 16 + 4 * g + e]) * LOG2E; mx = fmaxf(mx, a[e]); }
                mx = fmaxf(mx, __shfl_xor(mx, 16)); mx = fmaxf(mx, __shfl_xor(mx, 32));
                float l = 0.f;
#pragma unroll
                for (int e = 0; e < 4; ++e) { a[e] = __builtin_amdgcn_exp2f(a[e] - mx); l += a[e]; }
                l += __shfl_xor(l, 16); l += __shfl_xor(l, 32);
                u32x4 pw; pw.x = cvt_pk_bf16(a[0], a[1]); pw.y = cvt_pk_bf16(a[2], a[3]); pw.z = 0u; pw.w = 0u;
                const bf16x8 pa = __builtin_bit_cast(bf16x8, pw);
                const bf16_t* vm = VT + (size_t)(h * 128 + ql) * MP + MROW0 + 4 * g;
                const float inv15 = __shfl(__builtin_amdgcn_rcpf(l), 15);
#pragma unroll
                for (int dg = 0; dg < 8; ++dg) { const u32x2 lo = *(const u32x2*)(vm + (size_t)(16 * dg) * MP); const u32x4 bw = {lo.x, lo.y, 0u, 0u};
                    f32x4 o = {0.f, 0.f, 0.f, 0.f}; o = __builtin_amdgcn_mfma_f32_16x16x32_bf16(pa, __builtin_bit_cast(bf16x8, bw), o, 0, 0, 0);
                    if (g == 3) OA15[h * 128 + 16 * dg + ql] = o[3] * inv15; }
            }
        }
        xcd_barrier(xbar);
        { PH_BEGIN
            const int h = lane >> 3, sub = lane & 7;
            for (int row = gw; row < MP; row += NGW) {
                const int pos = row < NREAL ? 16 + (row & (SEQ - 1)) : ((row - MROW0) & 15);
                const float* tb = TAB + ((size_t)pos * 32 + 8 * (sub & 3)) * 2;
                const f32x4 t0 = *(const f32x4*)tb, t1 = *(const f32x4*)(tb + 4), t2 = *(const f32x4*)(tb + 8), t3 = *(const f32x4*)(tb + 12);
#pragma unroll
                for (int which = 0; which < 2; ++which) {
                    const bf16_t* np = which == 0 ? QRAW + (size_t)row * 1536 + h * 192 + 16 * sub : KV + (size_t)row * 2048 + h * 256 + 16 * sub;
                    const bf16_t* rpp = which == 0 ? QRAW + (size_t)row * 1536 + h * 192 + 128 + 8 * sub : PROJ + (size_t)row * PJ + 2816 + 8 * sub;
                    const float* gn = which == 0 ? P.mq_g : P.mk_g;
                    bf16_t* dst = (which == 0 ? QP : KP) + (size_t)row * 1536 + h * 192;
                    const u32x4 a = *(const u32x4*)np, bq = *(const u32x4*)(np + 8), c = *(const u32x4*)rpp;
                    float n0 = bflo(a.x), n1 = bfhi(a.x), n2 = bflo(a.y), n3 = bfhi(a.y), n4 = bflo(a.z), n5 = bfhi(a.z), n6 = bflo(a.w), n7 = bfhi(a.w);
                    float m0 = bflo(bq.x), m1 = bfhi(bq.x), m2 = bflo(bq.y), m3 = bfhi(bq.y), m4 = bflo(bq.z), m5 = bfhi(bq.z), m6 = bflo(bq.w), m7 = bfhi(bq.w);
                    float r0 = bflo(c.x), r1 = bfhi(c.x), r2 = bflo(c.y), r3 = bfhi(c.y), r4 = bflo(c.z), r5 = bfhi(c.z), r6 = bflo(c.w), r7 = bfhi(c.w);
                    float ss = n0 * n0 + n1 * n1 + n2 * n2 + n3 * n3 + n4 * n4 + n5 * n5 + n6 * n6 + n7 * n7 + m0 * m0 + m1 * m1 + m2 * m2 + m3 * m3 + m4 * m4 + m5 * m5 + m6 * m6 + m7 * m7
                             + r0 * r0 + r1 * r1 + r2 * r2 + r3 * r3 + r4 * r4 + r5 * r5 + r6 * r6 + r7 * r7;
                    ss += __shfl_xor(ss, 1); ss += __shfl_xor(ss, 2); ss += __shfl_xor(ss, 4);
                    const float rs = __builtin_amdgcn_rsqf(ss * (1.f / 192.f) + EPS);
                    const f32x4 ga = *(const f32x4*)(gn + 16 * sub), gb = *(const f32x4*)(gn + 16 * sub + 4), gc = *(const f32x4*)(gn + 16 * sub + 8), gd = *(const f32x4*)(gn + 16 * sub + 12);
                    const f32x4 ge = *(const f32x4*)(gn + 128 + 8 * sub), gf = *(const f32x4*)(gn + 128 + 8 * sub + 4);
                    u32x4 w;
                    w.x = cvt_pk_bf16(n0 * rs * ga.x, n1 * rs * ga.y); w.y = cvt_pk_bf16(n2 * rs * ga.z, n3 * rs * ga.w); w.z = cvt_pk_bf16(n4 * rs * gb.x, n5 * rs * gb.y); w.w = cvt_pk_bf16(n6 * rs * gb.z, n7 * rs * gb.w);
                    *(u32x4*)(dst + 16 * sub) = w;
                    w.x = cvt_pk_bf16(m0 * rs * gc.x, m1 * rs * gc.y); w.y = cvt_pk_bf16(m2 * rs * gc.z, m3 * rs * gc.w); w.z = cvt_pk_bf16(m4 * rs * gd.x, m5 * rs * gd.y); w.w = cvt_pk_bf16(m6 * rs * gd.z, m7 * rs * gd.w);
                    *(u32x4*)(dst + 16 * sub + 8) = w;
                    const float y0 = r0 * rs * ge.x, y1 = r1 * rs * ge.y, y2 = r2 * rs * ge.z, y3 = r3 * rs * ge.w, y4 = r4 * rs * gf.x, y5 = r5 * rs * gf.y, y6 = r6 * rs * gf.z, y7 = r7 * rs * gf.w;
                    const float z0 = __shfl_xor(y0, 4), z1 = __shfl_xor(y1, 4), z2 = __shfl_xor(y2, 4), z3 = __shfl_xor(y3, 4), z4 = __shfl_xor(y4, 4), z5 = __shfl_xor(y5, 4), z6 = __shfl_xor(y6, 4), z7 = __shfl_xor(y7, 4);
                    const float sg = (sub < 4) ? -1.f : 1.f;
                    w.x = cvt_pk_bf16(y0 * t0.x + sg * z0 * t0.y, y1 * t0.z + sg * z1 * t0.w); w.y = cvt_pk_bf16(y2 * t1.x + sg * z2 * t1.y, y3 * t1.z + sg * z3 * t1.w);
                    w.z = cvt_pk_bf16(y4 * t2.x + sg * z4 * t2.y, y5 * t2.z + sg * z5 * t2.w); w.w = cvt_pk_bf16(y6 * t3.x + sg * z6 * t3.y, y7 * t3.z + sg * z7 * t3.w);
                    *(u32x4*)(dst + 128 + 8 * sub) = w;
                }
            }
        }
        xcd_barrier(xbar);
        { PH_BEGIN
            for (int it = gw; it < 16 * NCHUNK; it += NGW) {
                const int bh = it / NCHUNK, c = it % NCHUNK, b = bh >> 3, h = bh & 7;
                const size_t rowbase = (c == 0) ? (size_t)(MROW0 + 16 * b) : (size_t)b * SEQ + (size_t)(c - 1) * 64;
                const bf16_t* q = QP + (size_t)(MROW0 + 16 * b + 15) * 1536 + h * 192; const bf16_t* k = KP + (rowbase + lane) * 1536 + h * 192;
                float s = 0.f;
#pragma unroll 4
                for (int ch = 0; ch < 24; ++ch) s += dot8(*(const u32x4*)(q + ch * 8), *(const u32x4*)(k + ch * 8));
                s *= mla::SCALE * LOG2E; if (c == 0 && lane >= 16) s = -1e30f;
                const float m = wave_max(s); const float p = __builtin_amdgcn_exp2f(s - m); const float l = wave_sum(p);
                const bf16_t* vp = KV + rowbase * 2048 + h * 256 + 128 + 2 * lane;
                float o0 = 0.f, o1 = 0.f;
#pragma unroll 8
                for (int key = 0; key < 64; ++key) { const float pk = __shfl(p, key); const unsigned u = *(const unsigned*)(vp + (size_t)key * 2048); o0 += pk * bflo(u); o1 += pk * bfhi(u); }
                float* pt = PART + (size_t)it * PARTW;
                if (lane == 0) { pt[0] = m; pt[1] = l; }
                pt[4 + 2 * lane] = o0; pt[5 + 2 * lane] = o1;
            }
            __syncthreads();
            const int xcd = blockIdx.x & 7, idx = blockIdx.x >> 3, nper = G >> 3;
            for (int i = 0;; ++i) {
                int u;
                if ((G & 7) == 0 && nper == 32) { const int slot = i * 8 + xcd; if (slot >= 32) break; u = (slot >> 1) * 64 + (slot & 1) * 32 + idx; }
                else { u = blockIdx.x + i * G; if (u >= 1024) break; }
                const int bh = u >> 6, qb = u & 63, b = bh >> 3, h = bh & 7;
                const size_t q0 = (size_t)b * SEQ + (size_t)qb * 256;
                int tid_u = tid; asm volatile("" : "+v"(tid_u));
                mla::attn_unit2(QP + q0 * 1536 + h * 192, KP + h * 192, KV + h * 256 + 128, OUTB + q0 * 1024 + h * 128, MROW0 + 16 * b, b * SEQ, (char*)lds, tid_u);
            }
        }
        xcd_barrier(xbar);
        { PH_BEGIN
            const int nw9 = (G > 1) ? (G - 1) * 8 : 8;
            if ((int)blockIdx.x < G - 1 || G == 1)
            for (int row = gw; row < NREAL; row += nw9) {
#pragma unroll
                for (int which = 0; which < 2; ++which) {
                    const bf16_t* src = (which == 0 ? OUTA : OUTB) + (size_t)row * 1024 + 16 * lane; const float* gn = (which == 0 ? P.na_out_g : P.mla_out_g) + 16 * lane;
                    const u32x4 a = *(const u32x4*)src, bq = *(const u32x4*)(src + 8);
                    float n0 = bflo(a.x), n1 = bfhi(a.x), n2 = bflo(a.y), n3 = bfhi(a.y), n4 = bflo(a.z), n5 = bfhi(a.z), n6 = bflo(a.w), n7 = bfhi(a.w);
                    float m0 = bflo(bq.x), m1 = bfhi(bq.x), m2 = bflo(bq.y), m3 = bfhi(bq.y), m4 = bflo(bq.z), m5 = bfhi(bq.z), m6 = bflo(bq.w), m7 = bfhi(bq.w);
                    const float ss = wave_sum(n0 * n0 + n1 * n1 + n2 * n2 + n3 * n3 + n4 * n4 + n5 * n5 + n6 * n6 + n7 * n7 + m0 * m0 + m1 * m1 + m2 * m2 + m3 * m3 + m4 * m4 + m5 * m5 + m6 * m6 + m7 * m7);
                    const float rs = __builtin_amdgcn_rsqf(ss * (1.f / 1024.f) + EPS);
                    const f32x4 ga = *(const f32x4*)gn, gb = *(const f32x4*)(gn + 4), gc = *(const f32x4*)(gn + 8), gd = *(const f32x4*)(gn + 12);
                    bf16_t* dst = MIX + (size_t)row * DM + which * 1024 + 16 * lane; u32x4 w;
                    w.x = cvt_pk_bf16(n0 * rs * ga.x, n1 * rs * ga.y); w.y = cvt_pk_bf16(n2 * rs * ga.z, n3 * rs * ga.w); w.z = cvt_pk_bf16(n4 * rs * gb.x, n5 * rs * gb.y); w.w = cvt_pk_bf16(n6 * rs * gb.z, n7 * rs * gb.w);
                    *(u32x4*)dst = w;
                    w.x = cvt_pk_bf16(m0 * rs * gc.x, m1 * rs * gc.y); w.y = cvt_pk_bf16(m2 * rs * gc.z, m3 * rs * gc.w); w.z = cvt_pk_bf16(m4 * rs * gd.x, m5 * rs * gd.y); w.w = cvt_pk_bf16(m6 * rs * gd.z, m7 * rs * gd.w);
                    *(u32x4*)(dst + 8) = w;
                }
            }
            if ((int)blockIdx.x == G - 1) {
                float* sh = (float*)lds;
                __syncthreads();
                for (int bh = wid; bh < 16; bh += 8) {
                    const float* pt = PART + (size_t)bh * NCHUNK * PARTW;
                    float mm = -1e30f;
                    for (int c = lane; c < NCHUNK; c += 64) mm = fmaxf(mm, pt[(size_t)c * PARTW]);
                    mm = wave_max(mm);
                    float L = 0.f, o0 = 0.f, o1 = 0.f;
                    for (int c = 0; c < NCHUNK; ++c) { const float* pc = pt + (size_t)c * PARTW; const float w = __builtin_amdgcn_exp2f(pc[0] - mm); L += w * pc[1]; o0 += w * pc[4 + 2 * lane]; o1 += w * pc[5 + 2 * lane]; }
                    const float inv = 1.f / L;
                    sh[bh * 128 + 2 * lane] = bfround(o0 * inv); sh[bh * 128 + 2 * lane + 1] = bfround(o1 * inv);
                }
                __syncthreads();
                if (wid < 2) {
                    const int b = wid; float sa = 0.f, sb = 0.f;
#pragma unroll
                    for (int e = 0; e < 16; ++e) { const float va = bfround(OA15[16 * lane + e]), vb = sh[b * 1024 + 16 * lane + e]; sa += va * va; sb += vb * vb; }
                    const float ra = __builtin_amdgcn_rsqf(wave_sum(sa) * (1.f / 1024.f) + EPS), rb = __builtin_amdgcn_rsqf(wave_sum(sb) * (1.f / 1024.f) + EPS);
#pragma unroll
                    for (int e = 0; e < 16; ++e) { const int i = 16 * lane + e;
                        MIX15[b * DM + i] = bfround(bfround(OA15[i]) * ra * P.na_out_g[i]); MIX15[b * DM + 1024 + i] = bfround(sh[b * 1024 + i] * rb * P.mla_out_g[i]); }
                }
                __syncthreads();
            }
        }
        xcd_barrier(xbar);
        { PH_BEGIN pg8::Gemm g = pg8::Gemm{MIX, WOT, NREAL, DM, DM}; pg8::EpiResSsq E = pg8::EpiResSsq{P.x, P.out, HN2, SSQ, DM}; pg8::StaticOrder S; S.init(g.M, g.N, G, (int)blockIdx.x);
          pg8::gemm_phase<pg8::EpiResSsq, pg8::StaticOrder, true, true>((LAS unsigned char*)lds, g, S, E, tid); }
        { PH_BEGIN
            {
                for (int n = gw; n < DM; n += NGW) {
                    const bf16_t* w = WOT + (size_t)n * DM; float a0 = 0.f, a1 = 0.f;
#pragma unroll
                    for (int i = 0; i < 4; ++i) { const int k = 8 * lane + 512 * i; const u32x4 wv = *(const u32x4*)(w + k);
                        const f32x4 x0 = *(const f32x4*)(MIX15 + k), x1 = *(const f32x4*)(MIX15 + k + 4), y0 = *(const f32x4*)(MIX15 + DM + k), y1 = *(const f32x4*)(MIX15 + DM + k + 4);
                        const float w0 = bflo(wv.x), w1 = bfhi(wv.x), w2 = bflo(wv.y), w3 = bfhi(wv.y), w4 = bflo(wv.z), w5 = bfhi(wv.z), w6 = bflo(wv.w), w7 = bfhi(wv.w);
                        a0 += w0 * x0.x + w1 * x0.y + w2 * x0.z + w3 * x0.w + w4 * x1.x + w5 * x1.y + w6 * x1.z + w7 * x1.w;
                        a1 += w0 * y0.x + w1 * y0.y + w2 * y0.z + w3 * y0.w + w4 * y1.x + w5 * y1.y + w6 * y1.z + w7 * y1.w; }
                    a0 = wave_sum(a0); a1 = wave_sum(a1);
                    if (lane == 0) { const float mb = P.meta[15 * DM + n]; H115[n] = mb + a0; H115[DM + n] = mb + a1; }
                }
            }
        }
        xcd_barrier(xbar);
        { PH_BEGIN
            for (int row = gw; row < NREAL; row += NGW) {
                const bf16_t* src = HN2 + (size_t)row * DM + 8 * lane; float ss = 0.f;
#pragma unroll
                for (int i = 0; i < 4; ++i) { const u32x4 v = *(const u32x4*)(src + 512 * i);
                    const float f0 = bflo(v.x), f1 = bfhi(v.x), f2 = bflo(v.y), f3 = bfhi(v.y), f4 = bflo(v.z), f5 = bfhi(v.z), f6 = bflo(v.w), f7 = bfhi(v.w);
                    ss += f0 * f0 + f1 * f1 + f2 * f2 + f3 * f3 + f4 * f4 + f5 * f5 + f6 * f6 + f7 * f7; }
                ss = wave_sum(ss);
                if (lane == 0) SSQ[row] = ss;
            }
        }
        xcd_barrier(xbar);
        { PH_BEGIN pg8::Gemm g = pg8::Gemm{HN2, WGT, NREAL, DFF, DM}; pg8::EpiBf16 E = pg8::EpiBf16{GB, DFF, SSQ}; pg8::StaticOrder S; S.init(g.M, g.N, G, (int)blockIdx.x);
          pg8::gemm_phase<pg8::EpiBf16, pg8::StaticOrder, true, true>((LAS unsigned char*)lds, g, S, E, tid); }
        { PH_BEGIN
            {
                for (int n = gw; n < DFF; n += NGW) {
                    const bf16_t* w = WGT + (size_t)n * DM; float a0 = 0.f, a1 = 0.f, s0 = 0.f, s1 = 0.f;
#pragma unroll
                    for (int i = 0; i < 4; ++i) { const int k = 8 * lane + 512 * i; const u32x4 wv = *(const u32x4*)(w + k);
                        const f32x4 x0 = *(const f32x4*)(H115 + k), x1 = *(const f32x4*)(H115 + k + 4), y0 = *(const f32x4*)(H115 + DM + k), y1 = *(const f32x4*)(H115 + DM + k + 4);
                        const float w0 = bflo(wv.x), w1 = bfhi(wv.x), w2 = bflo(wv.y), w3 = bfhi(wv.y), w4 = bflo(wv.z), w5 = bfhi(wv.z), w6 = bflo(wv.w), w7 = bfhi(wv.w);
                        a0 += w0 * x0.x + w1 * x0.y + w2 * x0.z + w3 * x0.w + w4 * x1.x + w5 * x1.y + w6 * x1.z + w7 * x1.w;
                        a1 += w0 * y0.x + w1 * y0.y + w2 * y0.z + w3 * y0.w + w4 * y1.x + w5 * y1.y + w6 * y1.z + w7 * y1.w;
                        s0 += x0.x * x0.x + x0.y * x0.y + x0.z * x0.z + x0.w * x0.w + x1.x * x1.x + x1.y * x1.y + x1.z * x1.z + x1.w * x1.w;
                        s1 += y0.x * y0.x + y0.y * y0.y + y0.z * y0.z + y0.w * y0.w + y1.x * y1.x + y1.y * y1.y + y1.z * y1.z + y1.w * y1.w; }
                    a0 = wave_sum(a0) * __builtin_amdgcn_rsqf(wave_sum(s0) * (1.f / DM) + EPS); a1 = wave_sum(a1) * __builtin_amdgcn_rsqf(wave_sum(s1) * (1.f / DM) + EPS);
                    if (lane == 0) { G15[n] = a0; G15[DFF + n] = a1; }
                }
            }
        }
        xcd_barrier(xbar);
        { PH_BEGIN pg8::Gemm g{HN2, WUT, NREAL, DFF, DM}; pg8::EpiConvGlu E{GB, ACT, DFF, P.conv_w, P.conv_b, G15, SSQ}; pg8::StaticOrder S; S.init(g.M, g.N, G, (int)blockIdx.x);
          pg8::gemm_phase<pg8::EpiConvGlu, pg8::StaticOrder, true, true>((LAS unsigned char*)lds, g, S, E, tid); }
        xcd_barrier(xbar);
        { PH_BEGIN pg8::Gemm g = pg8::Gemm{ACT, WDT, NREAL, DM, DFF}; pg8::EpiResF32 E = pg8::EpiResF32{P.out, P.out, DM}; pg8::StaticOrder S; S.init(g.M, g.N, G, (int)blockIdx.x);
          pg8::gemm_phase<pg8::EpiResF32, pg8::StaticOrder, true, true>((LAS unsigned char*)lds, g, S, E, tid); }
}

extern "C" void kernel_launch(void* const* d_in, const int* in_sizes, int n_in, void* d_out, int out_size, void* d_ws, size_t ws_size, hipStream_t stream) {
    static int grid = 0;
    if (grid == 0) {
        if (n_in != 23 || in_sizes[0] != NREAL * DM || out_size != NREAL * DM || ws_size < WS_END) {
            fprintf(stderr, "kernel_launch: unexpected shapes: n_in %d in0 %d out %d ws %zu (need %zu)\n", n_in, n_in > 0 ? in_sizes[0] : -1, out_size, ws_size, (size_t)WS_END); grid = -1; return; }
        int dev = 0, cus = 0, per_cu = 0;
        hipGetDevice(&dev); hipDeviceGetAttribute(&cus, hipDeviceAttributeMultiprocessorCount, dev);
        if (hipFuncSetAttribute((const void*)fwd_kernel, hipFuncAttributeMaxDynamicSharedMemorySize, LDS_BYTES) != hipSuccess) { fprintf(stderr, "kernel_launch: hipFuncSetAttribute failed\n"); grid = -1; return; }
        if (hipOccupancyMaxActiveBlocksPerMultiprocessor(&per_cu, (const void*)fwd_kernel, 512, LDS_BYTES) != hipSuccess || per_cu < 1) { fprintf(stderr, "kernel_launch: occupancy query gave %d\n", per_cu); per_cu = 1; }
        (void)hipGetLastError();
        grid = cus * per_cu;
    }
    if (grid < 0) return;
    Args a{};
    const float** ap = (const float**)&a;
    for (int i = 0; i < 23; ++i) ap[i] = (const float*)d_in[i];
    a.out = (float*)d_out; a.ws = (unsigned char*)d_ws;
    if (hipMemsetAsync(d_ws, 0, 16384, stream) != hipSuccess) { fprintf(stderr, "kernel_launch: memset failed\n"); return; }
    void* args[] = {&a};
    hipError_t e = hipLaunchCooperativeKernel((const void*)fwd_kernel, dim3(grid), dim3(512), args, LDS_BYTES, stream);
    if (e != hipSuccess) fprintf(stderr, "cooperative launch failed: %s (grid %d)\n", hipGetErrorString(e), grid);
}
```

```cpp
#include <hip/hip_runtime.h>
#include <hip/hip_cooperative_groups.h>
#include <cstdio>
#include <cstdint>
namespace cg = cooperative_groups;

#define LAS __attribute__((address_space(3)))
typedef unsigned short bf16_t;
typedef short bf16x8 __attribute__((ext_vector_type(8)));
typedef short s16x4 __attribute__((ext_vector_type(4)));
typedef float f32x4 __attribute__((ext_vector_type(4)));
typedef float f32x16 __attribute__((ext_vector_type(16)));
typedef unsigned u32x4 __attribute__((ext_vector_type(4)));
typedef unsigned u32x2 __attribute__((ext_vector_type(2)));

constexpr int DM = 2048, SEQ = 16384, NREAL = 32768, MROW0 = 32768, MP = 33024, DFF = 5632, INC = 3904, LTOT = 16400;
constexpr float EPS = 1e-6f, LOG2E = 1.4426950408889634f;
constexpr int PJ = 3072;
constexpr int NCHUNK = 257;
constexpr int PARTW = 132;

constexpr size_t MiB = 1u << 20;
constexpr size_t WS_TAB = 1 * MiB, WS_PART = 6 * MiB, WS_SMALL = 9 * MiB;
constexpr size_t SM_OA15 = 0, SM_MIX15 = 8192, SM_H115 = 32768, SM_HN215 = 65536, SM_G15 = 131072, SM_SSQ = 262144;
constexpr size_t WS_W1T = 16 * MiB, WS_WVT = 28 * MiB, WS_WQT = 32 * MiB, WS_WKVT = 34 * MiB, WS_WOT = 36 * MiB, WS_WGT = 44 * MiB, WS_WUT = 66 * MiB, WS_WDT = 88 * MiB;
constexpr size_t WS_HN = 112 * MiB, WS_PROJ = 241 * MiB, WS_VT = 435 * MiB, WS_CQN = 500 * MiB, WS_CKVN = 533 * MiB, WS_QRAW = 550 * MiB, WS_KV = 647 * MiB;
constexpr size_t WS_OUTA = 776 * MiB, WS_OUTB = 840 * MiB, WS_QP = 112 * MiB, WS_KP = 435 * MiB, WS_MIX = 112 * MiB, WS_HN2 = 816 * MiB, WS_G = 112 * MiB, WS_ACT = 464 * MiB;
constexpr size_t WS_END = 944 * MiB;

__device__ __forceinline__ unsigned cvt_pk_bf16(float lo, float hi) { unsigned r; asm volatile("v_cvt_pk_bf16_f32 %0, %1, %2" : "=v"(r) : "v"(lo), "v"(hi)); return r; }
__device__ __forceinline__ float bflo(unsigned u) { return __uint_as_float(u << 16); }
__device__ __forceinline__ float bfhi(unsigned u) { return __uint_as_float(u & 0xffff0000u); }
__device__ __forceinline__ unsigned short f2bf(float f) { unsigned u = __float_as_uint(f); return (unsigned short)((u + 0x7fffu + ((u >> 16) & 1u)) >> 16); }
__device__ __forceinline__ float bfround(float f) { return __uint_as_float(((unsigned)f2bf(f)) << 16); }
__device__ __forceinline__ float wave_sum(float v) {
#pragma unroll
    for (int o = 1; o < 64; o <<= 1) v += __shfl_xor(v, o);
    return v;
}
__device__ __forceinline__ float wave_max(float v) {
#pragma unroll
    for (int o = 1; o < 64; o <<= 1) v = fmaxf(v, __shfl_xor(v, o));
    return v;
}
__device__ __forceinline__ float dot8(u32x4 a, u32x4 b) {
    return bflo(a.x) * bflo(b.x) + bfhi(a.x) * bfhi(b.x) + bflo(a.y) * bflo(b.y) + bfhi(a.y) * bfhi(b.y)
         + bflo(a.z) * bflo(b.z) + bfhi(a.z) * bfhi(b.z) + bflo(a.w) * bflo(b.w) + bfhi(a.w) * bfhi(b.w);
}

namespace pg8 {
#define PG8_LAS __attribute__((address_space(3)))
constexpr int BM = 256, BK = 64, HALF = 128, HTB = HALF * BK * 2, STAGE_BYTES = 8 * HTB, NXCD = 8, WGM = 8;
__host__ __device__ __forceinline__ int lds_byte(int r, int c) { const int st = (r >> 4) * 2 + (c >> 5), rr = r & 15, cc = c & 31, ob = rr * 64 + cc * 2; return st * 1024 + (ob ^ (((ob >> 9) & 1) << 5)); }
__host__ __device__ __forceinline__ void stage_rc(int b, int& R, int& C) { const int st = b / 1024, sb = b % 1024, swz = sb ^ (((sb >> 9) & 1) << 5); R = (st >> 1) * 16 + swz / 64; C = (st & 1) * 32 + (swz % 64) / 2; }
__host__ __device__ __forceinline__ int perm32(int rho) { const int n = rho >> 4, i = rho & 15; return 8 * (i >> 2) + 4 * n + (i & 3); }
struct Unit { int pm, pn; };
struct Gemm { const bf16_t* A; const bf16_t* Bt; int M, N, K; };
struct StaticOrder {
    int nM, nN, nwg, G, c;
    __host__ __device__ void init(int M, int N, int G_, int c_) { nM = M / BM; nN = N / BM; nwg = nM * nN; G = G_; c = c_; }
    __host__ __device__ bool next(int i, Unit& u) const {
        const long L = (long)i * G + c; if (L >= nwg) return false;
        int wgid = (int)L; { const int q = nwg / NXCD, r = nwg % NXCD, xcd = wgid % NXCD, off = wgid / NXCD; wgid = (xcd < r ? xcd * (q + 1) : r * (q + 1) + (xcd - r) * q) + off; }
        const int nig = WGM * nN, gid = wgid / nig, fm = gid * WGM, gsz = (nM - fm) < WGM ? (nM - fm) : WGM;
        u.pm = fm + ((wgid % nig) % gsz); u.pn = (wgid % nig) / gsz; return true;
    }
    __device__ __forceinline__ void a_ready(const Unit&) const {}
    __device__ __forceinline__ void done(const Unit&) const {}
};
struct EpiBf16 {
    static constexpr bool PERM = true, AFTER_DRAIN = false;
    bf16_t* O; int ldc; const float* ssq;
    __device__ __forceinline__ void operator()(const f32x4 (&acc)[2][2][4][2], const Unit& u, int wr, int wc, int fr, int fq) const {
        const int row0 = u.pm * BM + wr * 64 + fr; const int col0 = u.pn * BM + wc * 32 + 8 * fq;
#pragma unroll
        for (int ai = 0; ai < 2; ++ai)
#pragma unroll
            for (int m = 0; m < 4; ++m) { bf16_t* rowp = O + (size_t)(row0 + ai * HALF + m * 16) * ldc + col0;
                const float rsc = ssq ? __builtin_amdgcn_rsqf(ssq[row0 + ai * HALF + m * 16] * (1.f / DM) + EPS) : 1.f;
#pragma unroll
                for (int bj = 0; bj < 2; ++bj) { const f32x4 v0 = acc[ai][bj][m][0] * rsc, v1 = acc[ai][bj][m][1] * rsc;
                    u32x4 w; w.x = cvt_pk_bf16(v0[0], v0[1]); w.y = cvt_pk_bf16(v0[2], v0[3]); w.z = cvt_pk_bf16(v1[0], v1[1]); w.w = cvt_pk_bf16(v1[2], v1[3]);
                    *(u32x4*)(rowp + bj * HALF) = w; } }
    }
};
struct EpiResF32 {
    static constexpr bool PERM = true, AFTER_DRAIN = false;
    const float* base; float* out; int ldc;
    __device__ __forceinline__ void operator()(const f32x4 (&acc)[2][2][4][2], const Unit& u, int wr, int wc, int fr, int fq) const {
        const int row0 = u.pm * BM + wr * 64 + fr; const int col0 = u.pn * BM + wc * 32 + 8 * fq;
#pragma unroll
        for (int ai = 0; ai < 2; ++ai)
#pragma unroll
            for (int m = 0; m < 4; ++m) { const size_t off = (size_t)(row0 + ai * HALF + m * 16) * ldc + col0;
#pragma unroll
                for (int bj = 0; bj < 2; ++bj) {
                    const f32x4 o0 = *(const f32x4*)(base + off + bj * HALF) + acc[ai][bj][m][0], o1 = *(const f32x4*)(base + off + bj * HALF + 4) + acc[ai][bj][m][1];
                    *(f32x4*)(out + off + bj * HALF) = o0; *(f32x4*)(out + off + bj * HALF + 4) = o1; }
                asm volatile("" ::: "memory"); }
    }
};
struct EpiResSsq {
    static constexpr bool PERM = true, AFTER_DRAIN = false;
    const float* base; float* out; bf16_t* xb; float* ssq; int ldc;
    __device__ __forceinline__ void operator()(const f32x4 (&acc)[2][2][4][2], const Unit& u, int wr, int wc, int fr, int fq) const {
        const int row0 = u.pm * BM + wr * 64 + fr; const int col0 = u.pn * BM + wc * 32 + 8 * fq;
#pragma unroll
        for (int ai = 0; ai < 2; ++ai)
#pragma unroll
            for (int m = 0; m < 4; ++m) { const int row = row0 + ai * HALF + m * 16; const size_t off = (size_t)row * ldc + col0; float sq = 0.f;
#pragma unroll
                for (int bj = 0; bj < 2; ++bj) {
                    const f32x4 o0 = *(const f32x4*)(base + off + bj * HALF) + acc[ai][bj][m][0], o1 = *(const f32x4*)(base + off + bj * HALF + 4) + acc[ai][bj][m][1];
                    *(f32x4*)(out + off + bj * HALF) = o0; *(f32x4*)(out + off + bj * HALF + 4) = o1;
                    u32x4 w; w.x = cvt_pk_bf16(o0[0], o0[1]); w.y = cvt_pk_bf16(o0[2], o0[3]); w.z = cvt_pk_bf16(o1[0], o1[1]); w.w = cvt_pk_bf16(o1[2], o1[3]);
                    *(u32x4*)(xb + off + bj * HALF) = w;
                    sq += (o0[0] * o0[0] + o0[1] * o0[1]) + (o0[2] * o0[2] + o0[3] * o0[3]) + (o1[0] * o1[0] + o1[1] * o1[1]) + (o1[2] * o1[2] + o1[3] * o1[3]); }
                (void)sq; (void)fq;
                asm volatile("" ::: "memory"); }
    }
};
struct EpiConvGlu {
    static constexpr bool PERM = true, AFTER_DRAIN = false;
    const bf16_t* Gt; bf16_t* O; int ldc; const float* cw; const float* cb; const float* g15; const float* ssq;
    __device__ __forceinline__ void operator()(const f32x4 (&acc)[2][2][4][2], const Unit& u, int wr, int wc, int fr, int fq) const {
        const int row0 = u.pm * BM + wr * 64 + fr; const int col0 = u.pn * BM + wc * 32 + 8 * fq;
#pragma unroll
        for (int bj = 0; bj < 2; ++bj) {
            const int col = col0 + bj * HALF;
            const f32x4 w0a = *(const f32x4*)(cw + col), w0b = *(const f32x4*)(cw + col + 4);
            const f32x4 w1a = *(const f32x4*)(cw + DFF + col), w1b = *(const f32x4*)(cw + DFF + col + 4);
            const f32x4 w2a = *(const f32x4*)(cw + 2 * DFF + col), w2b = *(const f32x4*)(cw + 2 * DFF + col + 4);
            const f32x4 cba = *(const f32x4*)(cb + col), cbb = *(const f32x4*)(cb + col + 4);
#pragma unroll
            for (int ai = 0; ai < 2; ++ai)
#pragma unroll
                for (int m = 0; m < 4; ++m) {
                    const int row = row0 + ai * HALF + m * 16; const int t = row & (SEQ - 1), b = row >> 14;
                    const bf16_t* gp = Gt + (size_t)row * ldc + col; const float rsc = __builtin_amdgcn_rsqf(ssq[row] * (1.f / DM) + EPS);
                    const u32x4 gc = *(const u32x4*)gp;
                    f32x4 pa, pb, na, nb;
                    if (t == 0) { pa = *(const f32x4*)(g15 + b * DFF + col); pb = *(const f32x4*)(g15 + b * DFF + col + 4); }
                    else { const u32x4 gq = *(const u32x4*)(gp - ldc); pa = (f32x4){bflo(gq.x), bfhi(gq.x), bflo(gq.y), bfhi(gq.y)}; pb = (f32x4){bflo(gq.z), bfhi(gq.z), bflo(gq.w), bfhi(gq.w)}; }
                    if (t == SEQ - 1) { na = (f32x4){0.f, 0.f, 0.f, 0.f}; nb = na; }
                    else { const u32x4 gq = *(const u32x4*)(gp + ldc); na = (f32x4){bflo(gq.x), bfhi(gq.x), bflo(gq.y), bfhi(gq.y)}; nb = (f32x4){bflo(gq.z), bfhi(gq.z), bflo(gq.w), bfhi(gq.w)}; }
                    const f32x4 ca = (f32x4){bflo(gc.x), bfhi(gc.x), bflo(gc.y), bfhi(gc.y)}, cbv = (f32x4){bflo(gc.z), bfhi(gc.z), bflo(gc.w), bfhi(gc.w)};
                    f32x4 ra, rb;
#pragma unroll
                    for (int e = 0; e < 4; ++e) {
                        const float xa = __builtin_fmaf(w2a[e], na[e], __builtin_fmaf(w1a[e], ca[e], __builtin_fmaf(w0a[e], pa[e], cba[e])));
                        const float xb = __builtin_fmaf(w2b[e], nb[e], __builtin_fmaf(w1b[e], cbv[e], __builtin_fmaf(w0b[e], pb[e], cbb[e])));
                        ra[e] = (xa * __builtin_amdgcn_rcpf(1.f + __builtin_amdgcn_exp2f(xa * -LOG2E))) * (acc[ai][bj][m][0][e] * rsc);
                        rb[e] = (xb * __builtin_amdgcn_rcpf(1.f + __builtin_amdgcn_exp2f(xb * -LOG2E))) * (acc[ai][bj][m][1][e] * rsc); }
                    u32x4 w; w.x = cvt_pk_bf16(ra[0], ra[1]); w.y = cvt_pk_bf16(ra[2], ra[3]); w.z = cvt_pk_bf16(rb[0], rb[1]); w.w = cvt_pk_bf16(rb[2], rb[3]);
                    *(u32x4*)(O + (size_t)row * ldc + col) = w;
                }
        }
    }
};

template <class Epi, class Sched, bool ALIGN_EPI = false, bool SP2 = false>
__device__ __forceinline__ void gemm_phase(PG8_LAS unsigned char* lds, const Gemm g, const Sched& S, const Epi& E, const int tid) {
    const int wid = __builtin_amdgcn_readfirstlane(tid >> 6), lane = tid & 63, wr = wid >> 2, wc = wid & 3, fr = lane & 15, fq = lane >> 4;
    const int K = g.K, nt = K / BK;
    unsigned voffA[2], voffB[2];
#pragma unroll
    for (int i = 0; i < 2; ++i) { int R, C; stage_rc(tid * 16 + i * 8192, R, C); const int Rb = Epi::PERM ? ((R & ~31) + perm32(R & 31)) : R;
        voffA[i] = (unsigned)(R * K + C) * 2u; voffB[i] = (unsigned)(Rb * K + C) * 2u; }
    const size_t kstep = (size_t)(BK * 2);
    const size_t hstep = (size_t)HALF * K * 2;
    const size_t tstep = 2 * hstep;
    const unsigned ldsw = (unsigned)wid * 1024u;
    const int aoff = lds_byte(wr * 64 + fr, fq * 8), boff = lds_byte(wc * 32 + fr, fq * 8);
#define PG8_SA(b, h) (((b) * 2 + (h)) * HTB)
#define PG8_SB(b, h) ((4 + (b) * 2 + (h)) * HTB)
#define PG8_STAGE(bufoff, gbase, voff) do { _Pragma("unroll") for (int _i = 0; _i < 2; ++_i) \
        __builtin_amdgcn_global_load_lds((const unsigned*)((const char*)(gbase) + (voff)[_i]), (PG8_LAS unsigned*)(lds + (bufoff) + ldsw + _i * 8192), 16, 0, 0); } while (0)
#define PG8_LDA(dst, b, h) do { _Pragma("unroll") for (int m = 0; m < 4; ++m) _Pragma("unroll") for (int k = 0; k < 2; ++k) dst[m][k] = *(const PG8_LAS bf16x8*)(lds + PG8_SA(b, h) + aoff + m * 2048 + k * 1024); } while (0)
#define PG8_LDB(dst, b, h) do { _Pragma("unroll") for (int n = 0; n < 2; ++n) _Pragma("unroll") for (int k = 0; k < 2; ++k) dst[n][k] = *(const PG8_LAS bf16x8*)(lds + PG8_SB(b, h) + boff + n * 2048 + k * 1024); } while (0)
#define PG8_MMA(ai, bj, At, Bt) do { __builtin_amdgcn_s_setprio(1); _Pragma("unroll") for (int m = 0; m < 4; ++m) _Pragma("unroll") for (int n = 0; n < 2; ++n) _Pragma("unroll") for (int k = 0; k < 2; ++k) \
        acc[ai][bj][m][n] = __builtin_amdgcn_mfma_f32_16x16x32_bf16(Bt[n][k], At[m][k], acc[ai][bj][m][n], 0, 0, 0); __builtin_amdgcn_s_setprio(0); } while (0)
#define PG8_WAIT_V(n) asm volatile("s_waitcnt vmcnt(" #n ")" ::: "memory")
#define PG8_WAIT_L(n) asm volatile("s_waitcnt lgkmcnt(" #n ")" ::: "memory")
#define PG8_BAR __builtin_amdgcn_s_barrier()
#define PG8_SCHED __builtin_amdgcn_sched_barrier(0)
    Unit cur, nxt; int ui = 0;
    if (!S.next(0, cur)) return;
    f32x4 acc[2][2][4][2];
#pragma unroll
    for (int a = 0; a < 2; ++a)
#pragma unroll
        for (int b = 0; b < 2; ++b)
#pragma unroll
            for (int m = 0; m < 4; ++m)
#pragma unroll
                for (int n = 0; n < 2; ++n) acc[a][b][m][n] = (f32x4){0.f, 0.f, 0.f, 0.f};
    bf16x8 At[4][2], B0[2][2], B1[2][2];
    const char* cA = (const char*)g.A + (size_t)cur.pm * tstep; const char* cB = (const char*)g.Bt + (size_t)cur.pn * tstep;
    S.a_ready(cur);
    if constexpr (SP2) {
        PG8_STAGE(PG8_SB(0, 0), cB, voffB); PG8_STAGE(PG8_SB(0, 1), cB + hstep, voffB); PG8_STAGE(PG8_SA(0, 0), cA, voffA); PG8_STAGE(PG8_SA(0, 1), cA + hstep, voffA);
        if (wr == 1) PG8_BAR;
        PG8_WAIT_V(2); PG8_BAR;
        PG8_STAGE(PG8_SB(1, 0), cB + kstep, voffB); PG8_STAGE(PG8_SA(1, 0), cA + kstep, voffA); PG8_STAGE(PG8_SB(1, 1), cB + hstep + kstep, voffB);
        PG8_WAIT_V(6); PG8_BAR;
    } else {
        PG8_STAGE(PG8_SB(0, 0), cB, voffB); PG8_STAGE(PG8_SA(0, 0), cA, voffA); PG8_STAGE(PG8_SB(0, 1), cB + hstep, voffB); PG8_STAGE(PG8_SA(0, 1), cA + hstep, voffA);
        if (wr == 1) PG8_BAR;
        PG8_WAIT_V(4); PG8_BAR;
        PG8_STAGE(PG8_SB(1, 0), cB + kstep, voffB); PG8_STAGE(PG8_SA(1, 0), cA + kstep, voffA); PG8_STAGE(PG8_SB(1, 1), cB + hstep + kstep, voffB);
        PG8_WAIT_V(6); PG8_BAR;
    }
    for (;;) {
        const bool has_next = S.next(ui + 1, nxt);
        const char* nA = has_next ? (const char*)g.A + (size_t)nxt.pm * tstep : cA; const char* nB = has_next ? (const char*)g.Bt + (size_t)nxt.pn * tstep : cB;
        for (int t = 0; t < nt; t += 2) {
            const bool last = (t == nt - 2);
            const char* a1 = cA + (size_t)(t + 1) * kstep;
            const char* a2 = last ? nA : cA + (size_t)(t + 2) * kstep; const char* b2 = last ? nB : cB + (size_t)(t + 2) * kstep;
            const char* a3 = a2 + kstep; const char* b3 = b2 + kstep;
            if (last && has_next) S.a_ready(nxt);
            if constexpr (SP2) {
            PG8_LDB(B0, 0, 0); PG8_LDB(B1, 0, 1); PG8_SCHED; PG8_LDA(At, 0, 0); PG8_STAGE(PG8_SA(1, 1), a1 + hstep, voffA);
            PG8_WAIT_V(8); PG8_WAIT_L(0); PG8_BAR; PG8_MMA(0, 0, At, B0); PG8_MMA(0, 1, At, B1); PG8_BAR; PG8_SCHED;
            PG8_LDA(At, 0, 1); PG8_STAGE(PG8_SB(0, 0), b2, voffB); PG8_STAGE(PG8_SB(0, 1), b2 + hstep, voffB); PG8_STAGE(PG8_SA(0, 0), a2, voffA);
            PG8_WAIT_V(8); PG8_WAIT_L(0); PG8_BAR; PG8_MMA(1, 0, At, B0); PG8_MMA(1, 1, At, B1); PG8_BAR; PG8_SCHED;
            PG8_LDB(B0, 1, 0); PG8_LDB(B1, 1, 1); PG8_SCHED; PG8_LDA(At, 1, 0); PG8_STAGE(PG8_SA(0, 1), a2 + hstep, voffA);
            PG8_WAIT_V(8); PG8_WAIT_L(0); PG8_BAR; PG8_MMA(0, 0, At, B0); PG8_MMA(0, 1, At, B1); PG8_BAR; PG8_SCHED;
            PG8_LDA(At, 1, 1); PG8_STAGE(PG8_SB(1, 0), b3, voffB); PG8_STAGE(PG8_SB(1, 1), b3 + hstep, voffB); PG8_STAGE(PG8_SA(1, 0), a3, voffA);
            PG8_WAIT_V(8); PG8_WAIT_L(0); PG8_BAR; PG8_MMA(1, 0, At, B0); PG8_MMA(1, 1, At, B1); PG8_BAR; PG8_SCHED;
            } else {
            PG8_LDB(B0, 0, 0); PG8_SCHED; PG8_LDA(At, 0, 0); PG8_STAGE(PG8_SA(1, 1), a1 + hstep, voffA);
            PG8_WAIT_L(8); PG8_BAR; PG8_WAIT_L(0); PG8_MMA(0, 0, At, B0); PG8_BAR; PG8_SCHED;
            PG8_LDB(B1, 0, 1); PG8_STAGE(PG8_SB(0, 0), b2, voffB);
            PG8_BAR; PG8_WAIT_L(0); PG8_MMA(0, 1, At, B1); PG8_BAR;
            PG8_LDA(At, 0, 1); PG8_STAGE(PG8_SA(0, 0), a2, voffA);
            PG8_BAR; PG8_WAIT_L(0); PG8_MMA(1, 0, At, B0); PG8_BAR; PG8_SCHED;
            PG8_STAGE(PG8_SB(0, 1), b2 + hstep, voffB);
            PG8_WAIT_V(6); PG8_BAR; PG8_MMA(1, 1, At, B1); PG8_BAR;
            PG8_LDB(B0, 1, 0); PG8_SCHED; PG8_LDA(At, 1, 0); PG8_STAGE(PG8_SA(0, 1), a2 + hstep, voffA);
            PG8_WAIT_L(8); PG8_BAR; PG8_WAIT_L(0); PG8_MMA(0, 0, At, B0); PG8_BAR; PG8_SCHED;
            PG8_LDB(B1, 1, 1); PG8_STAGE(PG8_SB(1, 0), b3, voffB);
            PG8_BAR; PG8_WAIT_L(0); PG8_MMA(0, 1, At, B1); PG8_BAR;
            PG8_LDA(At, 1, 1); PG8_STAGE(PG8_SA(1, 0), a3, voffA);
            PG8_BAR; PG8_WAIT_L(0); PG8_MMA(1, 0, At, B0); PG8_BAR; PG8_SCHED;
            PG8_STAGE(PG8_SB(1, 1), b3 + hstep, voffB);
            PG8_WAIT_V(6); PG8_BAR; PG8_MMA(1, 1, At, B1); PG8_BAR;
            }
        }
        if constexpr (ALIGN_EPI) { if (wr == 0) PG8_BAR; }
        if constexpr (!Epi::AFTER_DRAIN) { E(acc, cur, wr, wc, fr, fq); S.done(cur); }
        if (!has_next) break;
#pragma unroll
        for (int a = 0; a < 2; ++a)
#pragma unroll
            for (int b = 0; b < 2; ++b)
#pragma unroll
                for (int m = 0; m < 4; ++m)
#pragma unroll
                    for (int n = 0; n < 2; ++n) acc[a][b][m][n] = (f32x4){0.f, 0.f, 0.f, 0.f};
        cur = nxt; cA = nA; cB = nB; ++ui;
        if constexpr (ALIGN_EPI) { if (wr == 1) PG8_BAR; }
    }
    PG8_WAIT_V(0);
    if constexpr (!ALIGN_EPI) { if (wr == 0) PG8_BAR; }
    PG8_BAR;
#undef PG8_SA
#undef PG8_SB
#undef PG8_STAGE
#undef PG8_LDA
#undef PG8_LDB
#undef PG8_MMA
#undef PG8_WAIT_V
#undef PG8_WAIT_L
#undef PG8_BAR
#undef PG8_SCHED
}
}

namespace mla {
constexpr int NW = 8, QBLK = 32, KVBLK = 64;
constexpr float SCALE = 0.07216878364870322f;
constexpr float THR = 8.f;
constexpr int SHM_V = 64 * 128 * 2, SHM_K = 64 * 192 * 2, SHM_ATTN = 2 * SHM_V + 2 * SHM_K + NW * 64 * 4;
constexpr int LDQ = 1536, LDKK = 1536, LDV = 2048, LDO = 1024;
#define SBAR() __builtin_amdgcn_sched_barrier(0)
__device__ __forceinline__ int crow(int r, int hi) { return (r & 3) + 8 * (r >> 2) + 4 * hi; }
__device__ __forceinline__ void partialSM(f32x16& p0, f32x16& p1, float& m_reg, float& mn, float& alpha) {
  constexpr float C = SCALE * 1.4426950408889634f;
  float pmax = p0[0];
#pragma unroll
  for (int r = 1; r < 16; ++r) pmax = fmaxf(pmax, p0[r]);
#pragma unroll
  for (int r = 0; r < 16; ++r) pmax = fmaxf(pmax, p1[r]);
  { auto rr = __builtin_amdgcn_permlane32_swap(__float_as_uint(pmax), __float_as_uint(pmax), false, false);
    pmax = fmaxf(__uint_as_float(rr[0]), __uint_as_float(rr[1])); }
  if (__builtin_expect(__all(pmax - m_reg <= THR / SCALE), 1)) { mn = m_reg; alpha = 1.f; }
  else { mn = fmaxf(m_reg, pmax); alpha = __builtin_amdgcn_exp2f((m_reg - mn) * C); m_reg = mn; }
  float mnC = -mn * C;
#pragma unroll
  for (int r = 0; r < 16; ++r) p0[r] = fmaf(p0[r], C, mnC);
#pragma unroll
  for (int r = 0; r < 16; ++r) p1[r] = fmaf(p1[r], C, mnC);
#pragma unroll
  for (int r = 0; r < 16; ++r) p0[r] = __builtin_amdgcn_exp2f(p0[r]);
}
__device__ __forceinline__ void finishSM(f32x16& p0, f32x16& p1, float alpha, float& l_reg, bf16x8& pa0, bf16x8& pa1, bf16x8& pa2, bf16x8& pa3) {
#pragma unroll
  for (int r = 0; r < 16; ++r) p1[r] = __builtin_amdgcn_exp2f(p1[r]);
  float ps = 0;
#pragma unroll
  for (int r = 0; r < 16; ++r) ps += p0[r];
#pragma unroll
  for (int r = 0; r < 16; ++r) ps += p1[r];
  { auto rr = __builtin_amdgcn_permlane32_swap(__float_as_uint(ps), __float_as_uint(ps), false, false);
    ps = __uint_as_float(rr[0]) + __uint_as_float(rr[1]); }
  l_reg = l_reg * alpha + ps;
#define PK4(P, BASE, OUT) do { unsigned a0 = cvt_pk_bf16(P[BASE + 0], P[BASE + 1]), a1 = cvt_pk_bf16(P[BASE + 2], P[BASE + 3]);   \
    unsigned b0 = cvt_pk_bf16(P[BASE + 4], P[BASE + 5]), b1 = cvt_pk_bf16(P[BASE + 6], P[BASE + 7]);                              \
    auto r0 = __builtin_amdgcn_permlane32_swap(a0, b0, false, false); auto r1 = __builtin_amdgcn_permlane32_swap(a1, b1, false, false); \
    u32x4 w = {r0[0], r1[0], r0[1], r1[1]}; OUT = *reinterpret_cast<bf16x8*>(&w); } while (0)
  PK4(p0, 0, pa0); PK4(p0, 8, pa1); PK4(p1, 0, pa2); PK4(p1, 8, pa3);
#undef PK4
}
__device__ __forceinline__ void qkt(f32x16& p0, f32x16& p1, const char* Ks, const bf16x8* qr, const int* kb4) {
  p0 = f32x16{}; p1 = f32x16{};
#pragma unroll
  for (int d0 = 0; d0 < 12; ++d0) {
    bf16x8 b0 = *reinterpret_cast<const bf16x8*>(Ks + kb4[d0 & 3] + (d0 >> 2) * 128);
    bf16x8 b1 = *reinterpret_cast<const bf16x8*>(Ks + kb4[d0 & 3] + (d0 >> 2) * 128 + 32 * 384);
    p0 = __builtin_amdgcn_mfma_f32_32x32x16_bf16(b0, qr[d0], p0, 0, 0, 0);
    p1 = __builtin_amdgcn_mfma_f32_32x32x16_bf16(b1, qr[d0], p1, 0, 0, 0); }
}
__device__ __forceinline__ int v_st(int k, int c) { const int kk = (k & ~0xC) | ((k & 4) << 1) | ((k & 8) >> 1); return ((kk >> 3) * 4 + (c >> 5)) * 512 + ((kk & 7) * 32 + (c & 31)) * 2; }
__device__ __forceinline__ int v_rd_base(int lane) { return ((lane & 3) << 3) | (((lane >> 2) & 3) << 6) | (((lane >> 4) & 1) << 5) | (((lane >> 5) & 1) << 8); }
constexpr int v_rd_off(int d0, int ks, int half) { return d0 * 512 + ks * 4096 + half * 2048; }
template <int OFF> __device__ __forceinline__ s16x4 tr_read(int vb) {
  s16x4 r; asm volatile("ds_read_b64_tr_b16 %0, %1 offset:%2" : "=&v"(r) : "v"(vb), "i"(OFF) : "memory"); return r;
}
template <int D0> __device__ __forceinline__ void pv_one(f32x16& od, int vb, bf16x8 pa0, bf16x8 pa1, bf16x8 pa2, bf16x8 pa3) {
  const s16x4 l0 = tr_read<v_rd_off(D0, 0, 0)>(vb), h0 = tr_read<v_rd_off(D0, 0, 1)>(vb), l1 = tr_read<v_rd_off(D0, 1, 0)>(vb), h1 = tr_read<v_rd_off(D0, 1, 1)>(vb);
  const s16x4 l2 = tr_read<v_rd_off(D0, 2, 0)>(vb), h2 = tr_read<v_rd_off(D0, 2, 1)>(vb), l3 = tr_read<v_rd_off(D0, 3, 0)>(vb), h3 = tr_read<v_rd_off(D0, 3, 1)>(vb);
  asm volatile("s_waitcnt lgkmcnt(0)" ::: "memory"); SBAR();
#define PK(L, H) (bf16x8){L[0], L[1], L[2], L[3], H[0], H[1], H[2], H[3]}
  od = __builtin_amdgcn_mfma_f32_32x32x16_bf16(pa0, PK(l0, h0), od, 0, 0, 0);
  od = __builtin_amdgcn_mfma_f32_32x32x16_bf16(pa1, PK(l1, h1), od, 0, 0, 0);
  od = __builtin_amdgcn_mfma_f32_32x32x16_bf16(pa2, PK(l2, h2), od, 0, 0, 0);
  od = __builtin_amdgcn_mfma_f32_32x32x16_bf16(pa3, PK(l3, h3), od, 0, 0, 0);
#undef PK
}
__device__ __forceinline__ void pv_d0(f32x16* o, int vb, bf16x8 pa0, bf16x8 pa1, bf16x8 pa2, bf16x8 pa3) {
  pv_one<0>(o[0], vb, pa0, pa1, pa2, pa3); pv_one<1>(o[1], vb, pa0, pa1, pa2, pa3); pv_one<2>(o[2], vb, pa0, pa1, pa2, pa3); pv_one<3>(o[3], vb, pa0, pa1, pa2, pa3);
}

__device__ __forceinline__ void attn_unit(const bf16_t* __restrict__ Qb, const bf16_t* __restrict__ Kh, const bf16_t* __restrict__ Vh,
                                          bf16_t* __restrict__ Ob, int metaRow, int realRow0, char* lds, const int tid) {
  const int wid = tid >> 6, lane = tid & 63, r32 = lane & 31, hi = lane >> 5;
  char* V_lds = lds; char* K_lds = lds + 2 * SHM_V;
  float* ws = (float*)(lds + 2 * SHM_V + 2 * SHM_K) + wid * 64; float* li_l = ws; float* al_l = ws + 32;
  float m_reg = -1e30f, l_reg = 0; f32x16 o[4] = {}; bf16x8 qr[12];
  const bf16_t* Qw = Qb + (long)(wid * QBLK + r32) * LDQ + hi * 8;
#pragma unroll
  for (int d0 = 0; d0 < 12; ++d0) qr[d0] = *reinterpret_cast<const bf16x8*>(Qw + d0 * 16);
  const int sr = tid >> 3, vc = (tid & 7) * 8, vst0 = v_st(sr, vc);
  const int vgo0 = sr * LDV + vc;
  const int kgo0 = sr * LDKK + vc, klo0 = sr * 384 + ((vc * 2) ^ (((sr >> 1) & 7) << 4));
  int kb4[4];
#pragma unroll
  for (int q = 0; q < 4; ++q) kb4[q] = r32 * 384 + ((q * 32 + hi * 16) ^ (((r32 >> 1) & 7) << 4));
  const int vb0 = (int)(uintptr_t)V_lds + v_rd_base(lane);
  bf16x8 vs0, vs1, ks0, ks1, ks2;
#define TROW(t) ((t) == 0 ? (long)metaRow : (long)realRow0 + (long)((t) - 1) * KVBLK)
#define SLOAD(t) do { const long r0_ = TROW(t); const bf16_t* vp_ = Vh + r0_ * LDV + vgo0; const bf16_t* kp_ = Kh + r0_ * LDKK + kgo0; \
    vs0 = *reinterpret_cast<const bf16x8*>(vp_); vs1 = *reinterpret_cast<const bf16x8*>(vp_ + 64); \
    ks0 = *reinterpret_cast<const bf16x8*>(kp_); ks1 = *reinterpret_cast<const bf16x8*>(kp_ + 64); ks2 = *reinterpret_cast<const bf16x8*>(kp_ + 128); } while (0)
#define SWRITE(b) do { *(bf16x8*)(V_lds + (b) * SHM_V + vst0) = vs0; *(bf16x8*)(V_lds + (b) * SHM_V + vst0 + 1024) = vs1; \
    *(bf16x8*)(K_lds + (b) * SHM_K + klo0) = ks0; *(bf16x8*)(K_lds + (b) * SHM_K + klo0 + 128) = ks1; *(bf16x8*)(K_lds + (b) * SHM_K + klo0 + 256) = ks2; } while (0)
#define SWAIT() asm volatile("s_waitcnt vmcnt(0)" ::: "memory")
#define BARL() asm volatile("s_waitcnt lgkmcnt(0)\n\ts_barrier" ::: "memory")
#define RESC(a) do { if (__any((a) < 1.f)) { if (hi == 0) al_l[r32] = (a); asm volatile("s_waitcnt lgkmcnt(0)" ::: "memory"); \
    _Pragma("unroll") for (int d = 0; d < 4; ++d) _Pragma("unroll") for (int r = 0; r < 16; ++r) o[d][r] *= al_l[crow(r, hi)]; } } while (0)
  f32x16 pA0, pA1, pB0, pB1; float mnA, mnB, alA, alB; bf16x8 pa0, pa1, pa2, pa3; constexpr int NT = NCHUNK;
  SLOAD(0); SWAIT(); SWRITE(0); __syncthreads();
  qkt(pA0, pA1, K_lds, qr, kb4);
#pragma unroll
  for (int r = 8; r < 16; ++r) pA0[r] = -1e30f;
#pragma unroll
  for (int r = 0; r < 16; ++r) pA1[r] = -1e30f;
  partialSM(pA0, pA1, m_reg, mnA, alA);
  SLOAD(1); SWAIT(); SWRITE(1); SLOAD(2); BARL();
  for (int j = 1; j + 1 < NT; j += 2) {
    SBAR(); qkt(pB0, pB1, K_lds + SHM_K, qr, kb4);
    finishSM(pA0, pA1, alA, l_reg, pa0, pa1, pa2, pa3); SBAR();
    pv_d0(o, vb0, pa0, pa1, pa2, pa3); partialSM(pB0, pB1, m_reg, mnB, alB);
    BARL(); SWAIT(); SWRITE(0); if (j + 2 < NT) SLOAD(j + 2);
    RESC(alB); BARL();
    SBAR(); qkt(pA0, pA1, K_lds, qr, kb4);
    finishSM(pB0, pB1, alB, l_reg, pa0, pa1, pa2, pa3); SBAR();
    pv_d0(o, vb0 + (int)SHM_V, pa0, pa1, pa2, pa3); partialSM(pA0, pA1, m_reg, mnA, alA);
    BARL(); if (j + 2 < NT) { SWAIT(); SWRITE(1); } if (j + 3 < NT) SLOAD(j + 3);
    RESC(alA); BARL();
  }
  finishSM(pA0, pA1, alA, l_reg, pa0, pa1, pa2, pa3); SBAR();
  pv_d0(o, vb0, pa0, pa1, pa2, pa3);
  if (hi == 0) li_l[r32] = l_reg; asm volatile("s_waitcnt lgkmcnt(0)" ::: "memory");
  float rli[16];
#pragma unroll
  for (int r = 0; r < 16; ++r) rli[r] = __builtin_amdgcn_rcpf(li_l[crow(r, hi)]);
  bf16_t* Ow = Ob + (long)(wid * QBLK) * LDO;
#pragma unroll
  for (int r = 0; r < 16; ++r) { const int orow = crow(r, hi);
#pragma unroll
    for (int d0 = 0; d0 < 4; ++d0) Ow[(long)orow * LDO + d0 * 32 + r32] = f2bf(o[d0][r] * rli[r]); }
  __syncthreads();
#undef TROW
#undef SLOAD
#undef SWRITE
#undef SWAIT
#undef RESC
}


__device__ __forceinline__ void qkt2(f32x16& p0, f32x16& p1, const char* Ks, const bf16x8* qr, const int* kb4) {
#define KLD(d, half) (*reinterpret_cast<const bf16x8*>(Ks + kb4[(d) & 3] + ((d) >> 2) * 128 + (half) * 12288))
  p0 = f32x16{}; p1 = f32x16{};
  bf16x8 a0 = KLD(0, 0), b0 = KLD(0, 1), a1 = KLD(1, 0), b1 = KLD(1, 1), a2, b2;
#define QSTEP(d, A, B, NA, NB) do { if ((d) + 2 < 12) { NA = KLD((d) + 2, 0); NB = KLD((d) + 2, 1); } SBAR(); \
    p0 = __builtin_amdgcn_mfma_f32_32x32x16_bf16(A, qr[d], p0, 0, 0, 0); p1 = __builtin_amdgcn_mfma_f32_32x32x16_bf16(B, qr[d], p1, 0, 0, 0); SBAR(); } while (0)
  QSTEP(0, a0, b0, a2, b2); QSTEP(1, a1, b1, a0, b0); QSTEP(2, a2, b2, a1, b1);
  QSTEP(3, a0, b0, a2, b2); QSTEP(4, a1, b1, a0, b0); QSTEP(5, a2, b2, a1, b1);
  QSTEP(6, a0, b0, a2, b2); QSTEP(7, a1, b1, a0, b0); QSTEP(8, a2, b2, a1, b1);
  QSTEP(9, a0, b0, a2, b2); QSTEP(10, a1, b1, a0, b0); QSTEP(11, a2, b2, a1, b1);
#undef QSTEP
#undef KLD
}
struct VSet { s16x4 l0, h0, l1, h1, l2, h2, l3, h3; };
template <int D0> __device__ __forceinline__ void v_issue(VSet& s, int vb) {
  s.l0 = tr_read<v_rd_off(D0, 0, 0)>(vb); s.h0 = tr_read<v_rd_off(D0, 0, 1)>(vb); s.l1 = tr_read<v_rd_off(D0, 1, 0)>(vb); s.h1 = tr_read<v_rd_off(D0, 1, 1)>(vb);
  s.l2 = tr_read<v_rd_off(D0, 2, 0)>(vb); s.h2 = tr_read<v_rd_off(D0, 2, 1)>(vb); s.l3 = tr_read<v_rd_off(D0, 3, 0)>(vb); s.h3 = tr_read<v_rd_off(D0, 3, 1)>(vb);
}
__device__ __forceinline__ void v_mma(f32x16& od, VSet& s, bf16x8 pa0, bf16x8 pa1, bf16x8 pa2, bf16x8 pa3) {
  asm volatile("" : "+v"(s.l0), "+v"(s.h0), "+v"(s.l1), "+v"(s.h1), "+v"(s.l2), "+v"(s.h2), "+v"(s.l3), "+v"(s.h3));
#define PK(L, H) (bf16x8){L[0], L[1], L[2], L[3], H[0], H[1], H[2], H[3]}
  od = __builtin_amdgcn_mfma_f32_32x32x16_bf16(pa0, PK(s.l0, s.h0), od, 0, 0, 0);
  od = __builtin_amdgcn_mfma_f32_32x32x16_bf16(pa1, PK(s.l1, s.h1), od, 0, 0, 0);
  od = __builtin_amdgcn_mfma_f32_32x32x16_bf16(pa2, PK(s.l2, s.h2), od, 0, 0, 0);
  od = __builtin_amdgcn_mfma_f32_32x32x16_bf16(pa3, PK(s.l3, s.h3), od, 0, 0, 0);
#undef PK
}
__device__ __forceinline__ void pv2(f32x16* o, int vb, bf16x8 pa0, bf16x8 pa1, bf16x8 pa2, bf16x8 pa3) {
  VSet X, Y;
  SBAR(); v_issue<0>(X, vb); v_issue<1>(Y, vb);
  asm volatile("s_waitcnt lgkmcnt(8)" ::: "memory"); SBAR(); v_mma(o[0], X, pa0, pa1, pa2, pa3); SBAR();
  v_issue<2>(X, vb);
  asm volatile("s_waitcnt lgkmcnt(8)" ::: "memory"); SBAR(); v_mma(o[1], Y, pa0, pa1, pa2, pa3); SBAR();
  v_issue<3>(Y, vb);
  asm volatile("s_waitcnt lgkmcnt(8)" ::: "memory"); SBAR(); v_mma(o[2], X, pa0, pa1, pa2, pa3); SBAR();
  asm volatile("s_waitcnt lgkmcnt(0)" ::: "memory"); SBAR(); v_mma(o[3], Y, pa0, pa1, pa2, pa3); SBAR();
}
__device__ __forceinline__ void attn_unit2(const bf16_t* __restrict__ Qb, const bf16_t* __restrict__ Kh, const bf16_t* __restrict__ Vh,
                                           bf16_t* __restrict__ Ob, int metaRow, int realRow0, char* lds, const int tid) {
  const int wid = __builtin_amdgcn_readfirstlane(tid >> 6), lane = tid & 63, r32 = lane & 31, hi = lane >> 5;
  char* V_lds = lds; char* K_lds = lds + 2 * SHM_V;
  float* ws = (float*)(lds + 2 * SHM_V + 2 * SHM_K) + wid * 64; float* li_l = ws; float* al_l = ws + 32;
  float m_reg = -1e30f, l_reg = 0; f32x16 o[4] = {}; bf16x8 qr[12];
  const bf16_t* Qw = Qb + (long)(wid * QBLK + r32) * LDQ + hi * 8;
#pragma unroll
  for (int d0 = 0; d0 < 12; ++d0) qr[d0] = *reinterpret_cast<const bf16x8*>(Qw + d0 * 16);
  const int sr = tid >> 3, vc = (tid & 7) * 8, vst0 = v_st(sr, vc);
  const int vgo0 = sr * LDV + vc;
  const int kgo0 = sr * LDKK + vc, klo0 = sr * 384 + ((vc * 2) ^ (((sr >> 1) & 7) << 4));
  int kb4[4];
#pragma unroll
  for (int q = 0; q < 4; ++q) kb4[q] = r32 * 384 + ((q * 32 + hi * 16) ^ (((r32 >> 1) & 7) << 4));
  const int vb0 = (int)(uintptr_t)V_lds + v_rd_base(lane);
  bf16x8 vs0, vs1, ks0, ks1, ks2;
#define TROW(t) ((t) == 0 ? (long)metaRow : (long)realRow0 + (long)((t) - 1) * KVBLK)
#define SLOAD(t) do { const long r0_ = TROW(t); const bf16_t* vp_ = Vh + r0_ * LDV + vgo0; const bf16_t* kp_ = Kh + r0_ * LDKK + kgo0; \
    vs0 = *reinterpret_cast<const bf16x8*>(vp_); vs1 = *reinterpret_cast<const bf16x8*>(vp_ + 64); \
    ks0 = *reinterpret_cast<const bf16x8*>(kp_); ks1 = *reinterpret_cast<const bf16x8*>(kp_ + 64); ks2 = *reinterpret_cast<const bf16x8*>(kp_ + 128); } while (0)
#define SWRITE(b) do { *(bf16x8*)(V_lds + (b) * SHM_V + vst0) = vs0; *(bf16x8*)(V_lds + (b) * SHM_V + vst0 + 1024) = vs1; \
    *(bf16x8*)(K_lds + (b) * SHM_K + klo0) = ks0; *(bf16x8*)(K_lds + (b) * SHM_K + klo0 + 128) = ks1; *(bf16x8*)(K_lds + (b) * SHM_K + klo0 + 256) = ks2; } while (0)
#define SWAIT() asm volatile("s_waitcnt vmcnt(0)" ::: "memory")
#define BARRIER() asm volatile("s_waitcnt lgkmcnt(0)\n\ts_barrier" ::: "memory")
#define RESC(a) do { if (__any((a) < 1.f)) { if (hi == 0) al_l[r32] = (a); asm volatile("s_waitcnt lgkmcnt(0)" ::: "memory"); \
    _Pragma("unroll") for (int d = 0; d < 4; ++d) _Pragma("unroll") for (int r = 0; r < 16; ++r) o[d][r] *= al_l[crow(r, hi)]; } } while (0)
#define MASK0() do { _Pragma("unroll") for (int r = 8; r < 16; ++r) p0[r] = -1e30f; _Pragma("unroll") for (int r = 0; r < 16; ++r) p1[r] = -1e30f; } while (0)
  f32x16 p0, p1; float mn, al = 1.f; bf16x8 pa0, pa1, pa2, pa3; constexpr int NT = NCHUNK;
  SLOAD(0); SWAIT(); SWRITE(0); BARRIER();
#define S1(t, CUR) do { SBAR(); qkt2(p0, p1, K_lds + (CUR) * SHM_K, qr, kb4); if ((t) == 0) MASK0(); partialSM(p0, p1, m_reg, mn, al); } while (0)
#define S2(t, CUR) do { RESC(al); finishSM(p0, p1, al, l_reg, pa0, pa1, pa2, pa3); SBAR(); pv2(o, vb0 + (CUR) * (int)SHM_V, pa0, pa1, pa2, pa3); } while (0)
  if (wid < 4) {
#define A_TILE(t, CUR) do { S1(t, CUR); BARRIER(); \
      if ((t) + 1 < NT) { SWAIT(); SWRITE((CUR) ^ 1); if ((t) + 2 < NT) SLOAD((t) + 2); } S2(t, CUR); BARRIER(); } while (0)
    SLOAD(1);
    for (int t = 0; t + 1 < NT; t += 2) { A_TILE(t, 0); A_TILE(t + 1, 1); }
    A_TILE(NT - 1, 0);
    BARRIER();
#undef A_TILE
  } else {
    SLOAD(1); BARRIER();
#define B_TILE(t, CUR) do { if ((t) + 1 < NT) { SWAIT(); SWRITE((CUR) ^ 1); if ((t) + 2 < NT) SLOAD((t) + 2); } S1(t, CUR); BARRIER(); \
      S2(t, CUR); BARRIER(); } while (0)
    for (int t = 0; t + 1 < NT; t += 2) { B_TILE(t, 0); B_TILE(t + 1, 1); }
    B_TILE(NT - 1, 0);
#undef B_TILE
  }
  if (hi == 0) li_l[r32] = l_reg; asm volatile("s_waitcnt lgkmcnt(0)" ::: "memory");
  float rli[16];
#pragma unroll
  for (int r = 0; r < 16; ++r) rli[r] = __builtin_amdgcn_rcpf(li_l[crow(r, hi)]);
  bf16_t* Ow = Ob + (long)(wid * QBLK) * LDO;
#pragma unroll
  for (int r = 0; r < 16; ++r) { const int orow = crow(r, hi);
#pragma unroll
    for (int d0 = 0; d0 < 4; ++d0) Ow[(long)orow * LDO + d0 * 32 + r32] = f2bf(o[d0][r] * rli[r]); }
  __syncthreads();
#undef TROW
#undef SLOAD
#undef SWRITE
#undef SWAIT
#undef BARRIER
#undef RESC
#undef MASK0
#undef S1
#undef S2
}
#undef SBAR
}


#define XB_TMO      128
#define XB_XCNT(j)  (256  + 64 * (j))
#define XB_XSUB(j)  (1280 + 64 * (j))
#define XB_XGEN(j)  (2304 + 64 * (j))
#define XB_TOP      3328
#define XB_TOPGEN   3392
#define XCD_BAR_WORDS 3456
#define XB_SPIN_CAP (1u << 18)
__device__ __forceinline__ unsigned xb_ld(unsigned* p)              { return __hip_atomic_load(p, __ATOMIC_RELAXED, __HIP_MEMORY_SCOPE_AGENT); }
__device__ __forceinline__ unsigned xb_add(unsigned* p, unsigned v) { return __hip_atomic_fetch_add(p, v, __ATOMIC_RELAXED, __HIP_MEMORY_SCOPE_AGENT); }
__device__ __forceinline__ unsigned xb_xcc_id() { return (unsigned)__builtin_amdgcn_s_getreg((3 << 11) | 20) & 0xFu; }
#define XB_SPIN(cond, bar) do { unsigned _sp = 0; while (cond) { __builtin_amdgcn_s_sleep(1); \
    if ((++_sp & 255u) == 0u) { if (xb_ld(&(bar)[XB_TMO])) break; if (_sp > XB_SPIN_CAP) { atomicAdd(&(bar)[XB_TMO], 1u); break; } } } } while (0)
struct XcdBarrier { unsigned* bar; unsigned x; volatile LAS unsigned* st; };
__device__ __forceinline__ XcdBarrier xcd_barrier_post(unsigned* bar, volatile LAS unsigned* st) {
    XcdBarrier b; b.bar = bar; b.x = xb_xcc_id(); b.st = st;
    if (threadIdx.x == 0) (void)xb_add(&bar[XB_XCNT(b.x)], 1u);
    return b;
}
__device__ __forceinline__ void xcd_barrier_complete(unsigned* bar, unsigned x, unsigned& nloc, unsigned& nx) {
    const unsigned G = gridDim.x * gridDim.y * gridDim.z;
    unsigned sum, cnt, mine, sp = 0u;
    for (;;) {
        sum = 0u; cnt = 0u; mine = 0u;
#pragma unroll
        for (unsigned j = 0; j < 16; ++j) { const unsigned c = xb_ld(&bar[XB_XCNT(j)]); sum += c; cnt += (c > 0u) ? 1u : 0u; mine = (j == x) ? c : mine; }
        if (sum == G) break;
        __builtin_amdgcn_s_sleep(1);
        if ((++sp & 255u) == 0u) { if (xb_ld(&bar[XB_TMO])) break; if (sp > XB_SPIN_CAP) { atomicAdd(&bar[XB_TMO], 1u); break; } }
    }
    nloc = mine > 0u ? mine : 1u; nx = cnt > 0u ? cnt : 1u;
}
__device__ __forceinline__ void xcd_barrier(const XcdBarrier& b) {
    asm volatile("s_waitcnt vmcnt(0)" ::: "memory");
    __syncthreads();
    if (threadIdx.x == 0) {
        unsigned* bar = b.bar;
        __builtin_amdgcn_s_waitcnt(0);
        unsigned nloc = b.st[0], nx = b.st[1];
        if (nloc == 0u) { xcd_barrier_complete(bar, b.x, nloc, nx); b.st[0] = nloc; b.st[1] = nx; }
        const unsigned old = xb_add(&bar[XB_XSUB(b.x)], 1u);
        const unsigned gen = old / nloc;
        if (old + 1u == (gen + 1u) * nloc) {
            __builtin_amdgcn_fence(__ATOMIC_RELEASE, "agent");
            asm volatile("s_waitcnt vmcnt(0)" ::: "memory");
            const unsigned og = xb_add(&bar[XB_TOP], 1u);
            const unsigned tg = og / nx;
            if (og + 1u == (tg + 1u) * nx) xb_add(&bar[XB_TOPGEN], 1u);
            else XB_SPIN(xb_ld(&bar[XB_TOPGEN]) == tg, bar);
            __builtin_amdgcn_fence(__ATOMIC_ACQUIRE, "agent");
            xb_add(&bar[XB_XGEN(b.x)], 1u);
            asm volatile("s_waitcnt vmcnt(0)" ::: "memory");
        } else {
            XB_SPIN(xb_ld(&bar[XB_XGEN(b.x)]) == gen, bar);
            __builtin_amdgcn_fence(__ATOMIC_ACQUIRE, "agent");
            asm volatile("s_waitcnt vmcnt(0)" ::: "memory");
        }
    }
    __syncthreads();
}

struct Args {
    const float *x, *meta, *mix_g, *w_in, *na_q_g, *na_k_g, *rpb, *meta_bias, *cq_g, *ckv_g, *w_q_up, *w_kv_up, *mq_g, *mk_g, *na_out_g, *mla_out_g, *w_out, *ffn_g, *w_gate, *w_up, *conv_w, *conv_b, *w_down;
    float* out; unsigned char* ws;
};
constexpr int LDS_BYTES = 135168;

__device__ __forceinline__ void tr_item(const float* __restrict__ W, int ldw, int c0, int ncb, int K, bf16_t* __restrict__ WT, int row_off, LAS float* scr, int item, int lane, const float* __restrict__ kgain = nullptr) {
    const int kb = item / ncb, nb = item % ncb, k0 = 64 * kb, n0 = 32 * nb;
    float tv[32];
#pragma unroll
    for (int i = 0; i < 32; ++i) { const int kk = 2 * i + (lane >> 5); tv[i] = W[(size_t)(k0 + kk) * ldw + c0 + n0 + (lane & 31)]; }
    if (kgain) {
#pragma unroll
        for (int i = 0; i < 32; ++i) { const int kk = 2 * i + (lane >> 5); tv[i] *= kgain[k0 + kk]; } }
#pragma unroll
    for (int i = 0; i < 32; ++i) { const int kk = 2 * i + (lane >> 5); scr[kk * 33 + (lane & 31)] = tv[i]; }
    asm volatile("s_waitcnt lgkmcnt(0)" ::: "memory");
    const int c = lane & 7;
#pragma unroll
    for (int j = 0; j < 4; ++j) { const int n = (lane >> 3) + 8 * j; const LAS float* s = scr + (8 * c) * 33 + n;
        u32x4 o; o.x = cvt_pk_bf16(s[0 * 33], s[1 * 33]); o.y = cvt_pk_bf16(s[2 * 33], s[3 * 33]); o.z = cvt_pk_bf16(s[4 * 33], s[5 * 33]); o.w = cvt_pk_bf16(s[6 * 33], s[7 * 33]);
        *(u32x4*)(WT + (size_t)(row_off + n0 + n) * K + k0 + 8 * c) = o; }
    asm volatile("s_waitcnt lgkmcnt(0)" ::: "memory");
}

__device__ __forceinline__ void rms_row_f32(const float* __restrict__ src, const float* __restrict__ gain, bf16_t* __restrict__ dst, int lane) {
    f32x4 v[8]; float s = 0.f;
#pragma unroll
    for (int j = 0; j < 8; ++j) { v[j] = *(const f32x4*)(src + 4 * lane + 256 * j); s += (v[j].x * v[j].x + v[j].y * v[j].y) + (v[j].z * v[j].z + v[j].w * v[j].w); }
    const float rs = __builtin_amdgcn_rsqf(wave_sum(s) * (1.f / DM) + EPS);
#pragma unroll
    for (int j = 0; j < 8; ++j) { const f32x4 g = *(const f32x4*)(gain + 4 * lane + 256 * j); u32x2 w; w.x = cvt_pk_bf16(v[j].x * rs * g.x, v[j].y * rs * g.y); w.y = cvt_pk_bf16(v[j].z * rs * g.z, v[j].w * rs * g.w);
        *(u32x2*)(dst + 4 * lane + 256 * j) = w; }
}

__global__ void __launch_bounds__(512, 2) fwd_kernel(Args P) {
    extern __shared__ __attribute__((aligned(16))) unsigned char lds[];
    cg::grid_group grid = cg::this_grid();
    volatile LAS unsigned* bst = (volatile LAS unsigned*)((LAS unsigned char*)lds + 131072 + 64);
    if (threadIdx.x < 2) bst[threadIdx.x] = 0u;
    __syncthreads();
    const XcdBarrier xbar = xcd_barrier_post((unsigned*)P.ws, bst);
    const int wid0 = __builtin_amdgcn_readfirstlane((int)threadIdx.x >> 6);
    const int G = gridDim.x, NGW = G * 8;
#define CAS __attribute__((address_space(4)))
#define PH_BEGIN const CAS Args* pa_ = (const CAS Args*)__builtin_amdgcn_kernarg_segment_ptr(); asm volatile("" : "+s"(pa_)); const CAS Args& P = *pa_; (void)P;   \
    int tid; asm volatile("v_mbcnt_lo_u32_b32 %0, -1, 0\n\tv_mbcnt_hi_u32_b32 %0, -1, %0" : "=v"(tid)); tid += wid0 * 64;     const int lane = tid & 63, wid = __builtin_amdgcn_readfirstlane(tid >> 6), gw = blockIdx.x * 8 + wid; (void)lane; (void)gw;
    unsigned char* ws = P.ws;
        bf16_t* W1T = (bf16_t*)(ws + WS_W1T); bf16_t* WVT = (bf16_t*)(ws + WS_WVT); bf16_t* WQT = (bf16_t*)(ws + WS_WQT); bf16_t* WKVT = (bf16_t*)(ws + WS_WKVT);
        bf16_t* WOT = (bf16_t*)(ws + WS_WOT); bf16_t* WGT = (bf16_t*)(ws + WS_WGT); bf16_t* WUT = (bf16_t*)(ws + WS_WUT); bf16_t* WDT = (bf16_t*)(ws + WS_WDT);
        bf16_t* HN = (bf16_t*)(ws + WS_HN); bf16_t* PROJ = (bf16_t*)(ws + WS_PROJ); bf16_t* VT = (bf16_t*)(ws + WS_VT); bf16_t* CQN = (bf16_t*)(ws + WS_CQN); bf16_t* CKVN = (bf16_t*)(ws + WS_CKVN);
        bf16_t* QRAW = (bf16_t*)(ws + WS_QRAW); bf16_t* KV = (bf16_t*)(ws + WS_KV); bf16_t* OUTA = (bf16_t*)(ws + WS_OUTA); bf16_t* OUTB = (bf16_t*)(ws + WS_OUTB);
        bf16_t* QP = (bf16_t*)(ws + WS_QP); bf16_t* KP = (bf16_t*)(ws + WS_KP); bf16_t* MIX = (bf16_t*)(ws + WS_MIX); bf16_t* HN2 = (bf16_t*)(ws + WS_HN2);
        bf16_t* GB = (bf16_t*)(ws + WS_G); bf16_t* ACT = (bf16_t*)(ws + WS_ACT);
        float* TAB = (float*)(ws + WS_TAB); float* PART = (float*)(ws + WS_PART);
        float* OA15 = (float*)(ws + WS_SMALL + SM_OA15); float* MIX15 = (float*)(ws + WS_SMALL + SM_MIX15); float* H115 = (float*)(ws + WS_SMALL + SM_H115);
        float* HN215 = (float*)(ws + WS_SMALL + SM_HN215); float* G15 = (float*)(ws + WS_SMALL + SM_G15); float* SSQ = (float*)(ws + WS_SMALL + SM_SSQ); (void)HN215;

        { PH_BEGIN
            LAS float* scr = (LAS float*)((LAS unsigned char*)lds + wid * 16384);
            constexpr int I1 = 32 * 64, I2 = 32 * 32, I3 = 32 * 26, I4 = 8 * 48, I5 = 4 * 64, I6 = 32 * 64, I7 = 32 * 176, I8 = 32 * 176, I9 = 88 * 64;
            constexpr int NIT = I1 + I2 + I3 + I4 + I5 + I6 + I7 + I8 + I9;
            for (int it = gw; it < NIT; it += NGW) {
                int r = it;
                if (r < I1) { tr_item(P.w_in, INC, 0, 64, DM, W1T, 0, scr, r, lane); continue; } r -= I1;
                if (r < I2) { tr_item(P.w_in, INC, 2048, 32, DM, WVT, 0, scr, r, lane); continue; } r -= I2;
                if (r < I3) { tr_item(P.w_in, INC, 3072, 26, DM, W1T, 2048, scr, r, lane); continue; } r -= I3;
                if (r < I4) { tr_item(P.w_q_up, 1536, 0, 48, 512, WQT, 0, scr, r, lane); continue; } r -= I4;
                if (r < I5) { tr_item(P.w_kv_up, 2048, 0, 64, 256, WKVT, 0, scr, r, lane); continue; } r -= I5;
                if (r < I6) { tr_item(P.w_out, DM, 0, 64, DM, WOT, 0, scr, r, lane); continue; } r -= I6;
                if (r < I7) { tr_item(P.w_gate, DFF, 0, 176, DM, WGT, 0, scr, r, lane, P.ffn_g); continue; } r -= I7;
                if (r < I8) { tr_item(P.w_up, DFF, 0, 176, DM, WUT, 0, scr, r, lane, P.ffn_g); continue; } r -= I8;
                tr_item(P.w_down, DM, 0, 64, DFF, WDT, 0, scr, r, lane);
            }
            for (int i = blockIdx.x * 512 + tid; i < NREAL; i += G * 512) SSQ[i] = 0.f;
            { const u32x4 z = {0u, 0u, 0u, 0u};
              for (size_t i = (size_t)blockIdx.x * 512 + tid; i < (size_t)192 * DM / 8; i += (size_t)G * 512) *(u32x4*)(W1T + (size_t)2880 * DM + i * 8) = z;
              for (size_t i = (size_t)blockIdx.x * 512 + tid; i < (size_t)(MP - 32800) * DM / 8; i += (size_t)G * 512) *(u32x4*)(HN + (size_t)32800 * DM + i * 8) = z; }
            for (int row = gw; row < 32800; row += NGW) {
                const float* src = row < NREAL ? P.x + (size_t)row * DM : P.meta + (size_t)((row - MROW0) & 15) * DM;
                rms_row_f32(src, P.mix_g, HN + (size_t)row * DM, lane);
            }
            for (int e = blockIdx.x * 512 + tid; e < LTOT * 32; e += G * 512) {
                const int pos = e >> 5, i = e & 31;
                const double inv = exp2(-(double)i * (13.287712379549449 / 32.0));
                const float a = (float)pos * (float)inv;
                double rev = (double)a * 0.15915494309189535; rev -= rint(rev);
                const float fr = (float)rev;
                TAB[2 * e] = __builtin_amdgcn_cosf(fr); TAB[2 * e + 1] = __builtin_amdgcn_sinf(fr);
            }
        }
        grid.sync();
        { PH_BEGIN pg8::Gemm g = pg8::Gemm{HN, W1T, MP, PJ, DM}; pg8::EpiBf16 E = pg8::EpiBf16{PROJ, PJ, nullptr}; pg8::StaticOrder S; S.init(g.M, g.N, G, (int)blockIdx.x);
          pg8::gemm_phase<pg8::EpiBf16, pg8::StaticOrder, true, true>((LAS unsigned char*)lds, g, S, E, tid); }
        { PH_BEGIN pg8::Gemm g = pg8::Gemm{WVT, HN, 1024, MP, DM}; pg8::EpiBf16 E = pg8::EpiBf16{VT, MP, nullptr}; pg8::StaticOrder S; S.init(g.M, g.N, G, (int)((blockIdx.x + G / 2) % G));
          pg8::gemm_phase<pg8::EpiBf16, pg8::StaticOrder, true, true>((LAS unsigned char*)lds, g, S, E, tid); }
        xcd_barrier(xbar);
        { PH_BEGIN
            for (int row = gw; row < MP; row += NGW) {
                bf16_t* pr = PROJ + (size_t)row * PJ;
#pragma unroll
                for (int i = 0; i < 4; ++i) {
                    const u32x4 v = *(const u32x4*)(pr + 512 * i + 8 * lane);
                    float f0 = bflo(v.x), f1 = bfhi(v.x), f2 = bflo(v.y), f3 = bfhi(v.y), f4 = bflo(v.z), f5 = bfhi(v.z), f6 = bflo(v.w), f7 = bfhi(v.w);
                    float ss = f0 * f0 + f1 * f1 + f2 * f2 + f3 * f3 + f4 * f4 + f5 * f5 + f6 * f6 + f7 * f7;
                    ss += __shfl_xor(ss, 1); ss += __shfl_xor(ss, 2); ss += __shfl_xor(ss, 4); ss += __shfl_xor(ss, 8);
                    const float rs = __builtin_amdgcn_rsqf(ss * (1.f / 128.f) + EPS);
                    const float* gp = (i < 2 ? P.na_q_g : P.na_k_g) + ((8 * lane) & 127);
                    const f32x4 g0 = *(const f32x4*)gp, g1 = *(const f32x4*)(gp + 4);
                    u32x4 w; w.x = cvt_pk_bf16(f0 * rs * g0.x, f1 * rs * g0.y); w.y = cvt_pk_bf16(f2 * rs * g0.z, f3 * rs * g0.w); w.z = cvt_pk_bf16(f4 * rs * g1.x, f5 * rs * g1.y); w.w = cvt_pk_bf16(f6 * rs * g1.z, f7 * rs * g1.w);
                    *(u32x4*)(pr + 512 * i + 8 * lane) = w;
                }
                {
                    const u32x4 v = *(const u32x4*)(pr + 2048 + 8 * lane);
                    float f0 = bflo(v.x), f1 = bfhi(v.x), f2 = bflo(v.y), f3 = bfhi(v.y), f4 = bflo(v.z), f5 = bfhi(v.z), f6 = bflo(v.w), f7 = bfhi(v.w);
                    const float ss = wave_sum(f0 * f0 + f1 * f1 + f2 * f2 + f3 * f3 + f4 * f4 + f5 * f5 + f6 * f6 + f7 * f7);
                    const float rs = __builtin_amdgcn_rsqf(ss * (1.f / 512.f) + EPS);
                    const float* gp = P.cq_g + 8 * lane; const f32x4 g0 = *(const f32x4*)gp, g1 = *(const f32x4*)(gp + 4);
                    u32x4 w; w.x = cvt_pk_bf16(f0 * rs * g0.x, f1 * rs * g0.y); w.y = cvt_pk_bf16(f2 * rs * g0.z, f3 * rs * g0.w); w.z = cvt_pk_bf16(f4 * rs * g1.x, f5 * rs * g1.y); w.w = cvt_pk_bf16(f6 * rs * g1.z, f7 * rs * g1.w);
                    *(u32x4*)(CQN + (size_t)row * 512 + 8 * lane) = w;
                }
                {
                    const u32x4 v = *(const u32x4*)(pr + 2560 + 8 * lane);
                    float f0 = bflo(v.x), f1 = bfhi(v.x), f2 = bflo(v.y), f3 = bfhi(v.y), f4 = bflo(v.z), f5 = bfhi(v.z), f6 = bflo(v.w), f7 = bfhi(v.w);
                    float ss = f0 * f0 + f1 * f1 + f2 * f2 + f3 * f3 + f4 * f4 + f5 * f5 + f6 * f6 + f7 * f7;
                    ss += __shfl_xor(ss, 1); ss += __shfl_xor(ss, 2); ss += __shfl_xor(ss, 4); ss += __shfl_xor(ss, 8); ss += __shfl_xor(ss, 16);
                    const float rs = __builtin_amdgcn_rsqf(ss * (1.f / 256.f) + EPS);
                    const float* gp = P.ckv_g + ((8 * lane) & 255); const f32x4 g0 = *(const f32x4*)gp, g1 = *(const f32x4*)(gp + 4);
                    u32x4 w; w.x = cvt_pk_bf16(f0 * rs * g0.x, f1 * rs * g0.y); w.y = cvt_pk_bf16(f2 * rs * g0.z, f3 * rs * g0.w); w.z = cvt_pk_bf16(f4 * rs * g1.x, f5 * rs * g1.y); w.w = cvt_pk_bf16(f6 * rs * g1.z, f7 * rs * g1.w);
                    if (lane < 32) *(u32x4*)(CKVN + (size_t)row * 256 + 8 * lane) = w;
                }
            }
        }
        xcd_barrier(xbar);
        { PH_BEGIN pg8::Gemm g = pg8::Gemm{CQN, WQT, MP, 1536, 512}; pg8::EpiBf16 E = pg8::EpiBf16{QRAW, 1536, nullptr}; pg8::StaticOrder S; S.init(g.M, g.N, G, (int)blockIdx.x);
          pg8::gemm_phase<pg8::EpiBf16, pg8::StaticOrder, true, true>((LAS unsigned char*)lds, g, S, E, tid); }
        { PH_BEGIN pg8::Gemm g = pg8::Gemm{CKVN, WKVT, MP, 2048, 256}; pg8::EpiBf16 E = pg8::EpiBf16{KV, 2048, nullptr}; pg8::StaticOrder S; S.init(g.M, g.N, G, (int)((blockIdx.x + G / 2) % G));
          pg8::gemm_phase<pg8::EpiBf16, pg8::StaticOrder, true, true>((LAS unsigned char*)lds, g, S, E, tid); }
        { PH_BEGIN
            const int ql = lane & 15, g = lane >> 4, rsel = wid >> 2, j = wid & 3;
            float* rp = (float*)lds + wid * 512;
            char* stg = (char*)lds + 16384;
            int hcur = -1;
            const int xcd = (int)blockIdx.x & 7, cblk = (int)blockIdx.x >> 3;
            const int ktok = tid >> 4, kc = tid & 15, klds = ktok * 256 + 16 * (kc ^ ((((ktok >> 3) & 3) << 2) | (ktok & 3)));
            const int vd = tid >> 3, vc = tid & 7, vlds = vd * 128 + 16 * (vc ^ ((vd >> 1) & 7));
            const int kb = min(max(16 * j - 8, 0), 32);
            const int xh = ((kb >> 3) + (ql >> 2)) & 3, xl = ql & 3;
            const int kbase = (kb + 8 * (ql >> 2) + (ql & 3)) * 256 + 16 * (g ^ xl);
            const int kofs0 = kbase + 64 * (0 ^ xh), kofs1 = kbase + 64 * (1 ^ xh), kofs2 = kbase + 64 * (2 ^ xh), kofs3 = kbase + 64 * (3 ^ xh);
            const int vofs = ql * 128 + 16 * (((kb >> 3) + g) ^ (ql >> 1));
            for (int k = 0;; ++k) {
                int combo, rpair;
                if (G == 256) { if (k >= 8) break; const int lin = k * 32 + cblk; combo = xcd * 2 + (lin >> 7); rpair = lin & 127; }
                else { const int bi = (int)blockIdx.x + k * G; if (bi >= 2048) break; combo = bi >> 7; rpair = bi & 127; }
                const int h = combo & 7, b = combo >> 3, r0 = 2 * rpair, r = r0 + rsel;
                if (h != hcur) { for (int i = lane; i < 465; i += 64) rp[i] = P.rpb[h * 465 + i]; hcur = h; }
                const int u0 = min(max(r0 - 4, 0), 248), rs = min(max(r - 4, 0), 248);
                const size_t tokb = (size_t)b * SEQ, tok_q = tokb + r * 64 + 16 * j;
                const bf16_t* qp = PROJ + (tok_q + ql) * PJ + h * 128 + 8 * g;
                bf16x8 qf[4];
#pragma unroll
                for (int ds = 0; ds < 4; ++ds) qf[ds] = *(const bf16x8*)(qp + 32 * ds);
#define NA_LOADT(s, R0, R1) do { const size_t t0_ = tokb + (size_t)min(u0 + ((s) % 9), 255) * 64; \
                    if ((s) < 9) { const bf16_t* p_ = PROJ + (t0_ + ktok) * PJ + 1024 + h * 128 + kc * 8; R0 = *(const bf16x8*)p_; R1 = *(const bf16x8*)(p_ + (size_t)32 * PJ); } \
                    else { const bf16_t* p_ = VT + (size_t)(h * 128 + vd) * MP + t0_ + vc * 8; R0 = *(const bf16x8*)p_; R1 = *(const bf16x8*)(p_ + (size_t)64 * MP); } } while (0)
#define NA_WRITET(s, R0, R1) do { char* b_ = stg + ((s) & 1) * 16384; \
                    if ((s) < 9) { *(bf16x8*)(b_ + klds) = R0; *(bf16x8*)(b_ + klds + 8192) = R1; } else { *(bf16x8*)(b_ + vlds) = R0; *(bf16x8*)(b_ + vlds + 8192) = R1; } } while (0)
#define NA_BAR() asm volatile("s_waitcnt lgkmcnt(0)\n\ts_barrier" ::: "memory")
                bf16x8 ra0, ra1, rb0, rb1;
                NA_LOADT(0, ra0, ra1); NA_LOADT(1, rb0, rb1);
                f32x4 st[19];
#define NA_SSTEP(s, R0, R1) do { NA_WRITET(s, R0, R1); NA_LOADT((s) + 2, R0, R1); NA_BAR(); \
                    const char* kbuf_ = stg + ((s) & 1) * 16384; \
                    _Pragma("unroll") for (int hh = 0; hh < 2; ++hh) { f32x4 a = {0.f, 0.f, 0.f, 0.f}; \
                        a = __builtin_amdgcn_mfma_f32_16x16x32_bf16(*(const bf16x8*)(kbuf_ + hh * 1024 + kofs0), qf[0], a, 0, 0, 0); \
                        a = __builtin_amdgcn_mfma_f32_16x16x32_bf16(*(const bf16x8*)(kbuf_ + hh * 1024 + kofs1), qf[1], a, 0, 0, 0); \
                        a = __builtin_amdgcn_mfma_f32_16x16x32_bf16(*(const bf16x8*)(kbuf_ + hh * 1024 + kofs2), qf[2], a, 0, 0, 0); \
                        a = __builtin_amdgcn_mfma_f32_16x16x32_bf16(*(const bf16x8*)(kbuf_ + hh * 1024 + kofs3), qf[3], a, 0, 0, 0); \
                        st[2 * (s) + hh] = a; } } while (0)
                NA_SSTEP(0, ra0, ra1); NA_SSTEP(1, rb0, rb1); NA_SSTEP(2, ra0, ra1); NA_SSTEP(3, rb0, rb1); NA_SSTEP(4, ra0, ra1);
                NA_SSTEP(5, rb0, rb1); NA_SSTEP(6, ra0, ra1);
                bf16x8 km[4];
                { const bf16_t* kpm = PROJ + (size_t)(MROW0 + ql) * PJ + 1024 + h * 128 + 8 * g;
#pragma unroll
                  for (int ds = 0; ds < 4; ++ds) km[ds] = *(const bf16x8*)(kpm + 32 * ds); }
                NA_SSTEP(7, rb0, rb1); NA_SSTEP(8, ra0, ra1);
                { f32x4 a = {0.f, 0.f, 0.f, 0.f};
#pragma unroll
                  for (int ds = 0; ds < 4; ++ds) a = __builtin_amdgcn_mfma_f32_16x16x32_bf16(km[ds], qf[ds], a, 0, 0, 0);
                  st[18] = a; }
                const int c = 16 * j + ql, cs = min(max(c - 8, 0), 48);
                constexpr float SC = 0.08838834764831845f;
                float mx = -1e30f;
#pragma unroll
                for (int t = 0; t < 18; ++t) {
                    const int kr = u0 + (t >> 1); const bool rowok = (kr >= rs) && (kr < rs + 8);
                    const int dr = min(max(kr - r + 7, 0), 14);
#pragma unroll
                    for (int e = 0; e < 4; ++e) {
                        const int kcol = kb + 8 * g + 4 * (t & 1) + e; const bool valid = rowok && (kcol >= cs) && (kcol < cs + 16);
                        const int dc = min(max(kcol - c + 15, 0), 30);
                        float sv = (st[t][e] * SC + rp[dr * 31 + dc]) * LOG2E; sv = valid ? sv : -1e30f; st[t][e] = sv; mx = fmaxf(mx, sv);
                    }
                }
#pragma unroll
                for (int e = 0; e < 4; ++e) { const float sv = (st[18][e] * SC + P.meta_bias[h * 16 + 4 * g + e]) * LOG2E; st[18][e] = sv; mx = fmaxf(mx, sv); }
                mx = fmaxf(mx, __shfl_xor(mx, 16)); mx = fmaxf(mx, __shfl_xor(mx, 32));
                float l = 0.f;
#pragma unroll
                for (int t = 0; t < 19; ++t)
#pragma unroll
                    for (int e = 0; e < 4; ++e) { const float p = __builtin_amdgcn_exp2f(st[t][e] - mx); st[t][e] = p; l += p; }
                l += __shfl_xor(l, 16); l += __shfl_xor(l, 32);
                f32x4 o[8];
#pragma unroll
                for (int dg = 0; dg < 8; ++dg) o[dg] = (f32x4){0.f, 0.f, 0.f, 0.f};
#define NA_VSTEP(s, R0, R1) do { NA_WRITET(s, R0, R1); if ((s) + 2 < 18) NA_LOADT((s) + 2, R0, R1); NA_BAR(); \
                    const char* vbuf_ = stg + ((s) & 1) * 16384 + vofs; constexpr int i_ = (s) - 9; \
                    u32x4 pw; pw.x = cvt_pk_bf16(st[2 * i_][0], st[2 * i_][1]); pw.y = cvt_pk_bf16(st[2 * i_][2], st[2 * i_][3]); pw.z = cvt_pk_bf16(st[2 * i_ + 1][0], st[2 * i_ + 1][1]); pw.w = cvt_pk_bf16(st[2 * i_ + 1][2], st[2 * i_ + 1][3]); \
                    const bf16x8 pa = __builtin_bit_cast(bf16x8, pw); \
                    _Pragma("unroll") for (int dg = 0; dg < 8; ++dg) o[dg] = __builtin_amdgcn_mfma_f32_16x16x32_bf16(pa, *(const bf16x8*)(vbuf_ + dg * 2048), o[dg], 0, 0, 0); } while (0)
                NA_VSTEP(9, rb0, rb1); NA_VSTEP(10, ra0, ra1); NA_VSTEP(11, rb0, rb1); NA_VSTEP(12, ra0, ra1); NA_VSTEP(13, rb0, rb1);
                NA_VSTEP(14, ra0, ra1); NA_VSTEP(15, rb0, rb1);
                u32x2 vmf[8];
                { const bf16_t* vm = VT + (size_t)(h * 128 + ql) * MP + MROW0 + 4 * g;
#pragma unroll
                  for (int dg = 0; dg < 8; ++dg) vmf[dg] = *(const u32x2*)(vm + (size_t)(16 * dg) * MP); }
                NA_VSTEP(16, ra0, ra1); NA_VSTEP(17, rb0, rb1);
                {   u32x4 pw; pw.x = cvt_pk_bf16(st[18][0], st[18][1]); pw.y = cvt_pk_bf16(st[18][2], st[18][3]); pw.z = 0u; pw.w = 0u;
                    const bf16x8 pa = __builtin_bit_cast(bf16x8, pw);
#pragma unroll
                    for (int dg = 0; dg < 8; ++dg) { const u32x4 bw = {vmf[dg].x, vmf[dg].y, 0u, 0u};
                        o[dg] = __builtin_amdgcn_mfma_f32_16x16x32_bf16(pa, __builtin_bit_cast(bf16x8, bw), o[dg], 0, 0, 0); }
                }
#undef NA_LOADT
#undef NA_WRITET
#undef NA_BAR
#undef NA_SSTEP
#undef NA_VSTEP
                const float inv = __builtin_amdgcn_rcpf(l);
                float il[4];
#pragma unroll
                for (int e = 0; e < 4; ++e) il[e] = __shfl(inv, 4 * g + e);
#pragma unroll
                for (int e = 0; e < 4; ++e) { bf16_t* op = OUTA + (tok_q + 4 * g + e) * 1024 + h * 128 + ql;
#pragma unroll
                    for (int dg = 0; dg < 8; ++dg) op[16 * dg] = f2bf(o[dg][e] * il[e]); }
            }
            __syncthreads();
            if (gw < 8) {
                const int h = gw;
                const bf16_t* qp = PROJ + (size_t)(MROW0 + ql) * PJ + h * 128 + 8 * g; const bf16_t* kp = qp + 1024;
                f32x4 a = {0.f, 0.f, 0.f, 0.f};
#pragma unroll
                for (int ds = 0; ds < 4; ++ds) a = __builtin_amdgcn_mfma_f32_16x16x32_bf16(*(const bf16x8*)(kp + 32 * ds), *(const bf16x8*)(qp + 32 * ds), a, 0, 0, 0);
                float mx = -1e30f;
#pragma unroll
                for (int e = 0; e < 4; ++e) { a[e] = (a[e] * 0.08838834764831845f + P.meta_bias[h * 16 + 4 * g + e]) * LOG2E; mx = fmaxf(mx, a[e]); }
                mx = fmaxf(mx, __shfl_xor(mx, 16)); mx = fmaxf(mx, __shfl_xor(mx, 32));
                float l = 0.f;
#pragma unroll
                for (int e = 0; e < 4; ++e) { a[e] = __builtin_amdgcn_exp2f(a[e] - mx); l += a[e]; }
                l += __shfl_xor(l, 16); l += __shfl_xor(l, 32);
                u32x4 pw; pw.x = cvt_pk_bf16(a[0], a[1]); pw.y = cvt_pk_bf16(a[2], a[3]); pw.z = 0u; pw.w = 0u;
                const bf16x8 pa = __builtin_bit_cast(bf16x8, pw);
                const bf16_t* vm = VT + (size_t)(h * 128 + ql) * MP + MROW0 + 4 * g;
                const float inv15 = __shfl(__builtin_amdgcn_rcpf(l), 15);
#pragma unroll
                for (int dg = 0; dg < 8; ++dg) { const u32x2 lo = *(const u32x2*)(vm + (size_t)(16 * dg) * MP); const u32x4 bw = {lo.x, lo.y, 0u, 0u};
                    f32x4 o = {0.f, 0.f, 0.f, 0.f}; o = __builtin_amdgcn_mfma_f32_16x16x32_bf16(pa, __builtin_bit_cast(bf16x8, bw), o, 0, 0, 0);
                    if (g == 3) OA15[h * 128 + 16 * dg + ql] = o[3] * inv15; }
            }
        }
        xcd_barrier(xbar);
        { PH_BEGIN
            const int h = lane >> 3, sub = lane & 7;
            for (int row = gw; row < MP; row += NGW) {
                const int pos = row < NREAL ? 16 + (row & (SEQ - 1)) : ((row - MROW0) & 15);
                const float* tb = TAB + ((size_t)pos * 32 + 8 * (sub & 3)) * 2;
                const f32x4 t0 = *(const f32x4*)tb, t1 = *(const f32x4*)(tb + 4), t2 = *(const f32x4*)(tb + 8), t3 = *(const f32x4*)(tb + 12);
#pragma unroll
                for (int which = 0; which < 2; ++which) {
                    const bf16_t* np = which == 0 ? QRAW + (size_t)row * 1536 + h * 192 + 16 * sub : KV + (size_t)row * 2048 + h * 256 + 16 * sub;
                    const bf16_t* rpp = which == 0 ? QRAW + (size_t)row * 1536 + h * 192 + 128 + 8 * sub : PROJ + (size_t)row * PJ + 2816 + 8 * sub;
                    const float* gn = which == 0 ? P.mq_g : P.mk_g;
                    bf16_t* dst = (which == 0 ? QP : KP) + (size_t)row * 1536 + h * 192;
                    const u32x4 a = *(const u32x4*)np, bq = *(const u32x4*)(np + 8), c = *(const u32x4*)rpp;
                    float n0 = bflo(a.x), n1 = bfhi(a.x), n2 = bflo(a.y), n3 = bfhi(a.y), n4 = bflo(a.z), n5 = bfhi(a.z), n6 = bflo(a.w), n7 = bfhi(a.w);
                    float m0 = bflo(bq.x), m1 = bfhi(bq.x), m2 = bflo(bq.y), m3 = bfhi(bq.y), m4 = bflo(bq.z), m5 = bfhi(bq.z), m6 = bflo(bq.w), m7 = bfhi(bq.w);
                    float r0 = bflo(c.x), r1 = bfhi(c.x), r2 = bflo(c.y), r3 = bfhi(c.y), r4 = bflo(c.z), r5 = bfhi(c.z), r6 = bflo(c.w), r7 = bfhi(c.w);
                    float ss = n0 * n0 + n1 * n1 + n2 * n2 + n3 * n3 + n4 * n4 + n5 * n5 + n6 * n6 + n7 * n7 + m0 * m0 + m1 * m1 + m2 * m2 + m3 * m3 + m4 * m4 + m5 * m5 + m6 * m6 + m7 * m7
                             + r0 * r0 + r1 * r1 + r2 * r2 + r3 * r3 + r4 * r4 + r5 * r5 + r6 * r6 + r7 * r7;
                    ss += __shfl_xor(ss, 1); ss += __shfl_xor(ss, 2); ss += __shfl_xor(ss, 4);
                    const float rs = __builtin_amdgcn_rsqf(ss * (1.f / 192.f) + EPS);
                    const f32x4 ga = *(const f32x4*)(gn + 16 * sub), gb = *(const f32x4*)(gn + 16 * sub + 4), gc = *(const f32x4*)(gn + 16 * sub + 8), gd = *(const f32x4*)(gn + 16 * sub + 12);
                    const f32x4 ge = *(const f32x4*)(gn + 128 + 8 * sub), gf = *(const f32x4*)(gn + 128 + 8 * sub + 4);
                    u32x4 w;
                    w.x = cvt_pk_bf16(n0 * rs * ga.x, n1 * rs * ga.y); w.y = cvt_pk_bf16(n2 * rs * ga.z, n3 * rs * ga.w); w.z = cvt_pk_bf16(n4 * rs * gb.x, n5 * rs * gb.y); w.w = cvt_pk_bf16(n6 * rs * gb.z, n7 * rs * gb.w);
                    *(u32x4*)(dst + 16 * sub) = w;
                    w.x = cvt_pk_bf16(m0 * rs * gc.x, m1 * rs * gc.y); w.y = cvt_pk_bf16(m2 * rs * gc.z, m3 * rs * gc.w); w.z = cvt_pk_bf16(m4 * rs * gd.x, m5 * rs * gd.y); w.w = cvt_pk_bf16(m6 * rs * gd.z, m7 * rs * gd.w);
                    *(u32x4*)(dst + 16 * sub + 8) = w;
                    const float y0 = r0 * rs * ge.x, y1 = r1 * rs * ge.y, y2 = r2 * rs * ge.z, y3 = r3 * rs * ge.w, y4 = r4 * rs * gf.x, y5 = r5 * rs * gf.y, y6 = r6 * rs * gf.z, y7 = r7 * rs * gf.w;
                    const float z0 = __shfl_xor(y0, 4), z1 = __shfl_xor(y1, 4), z2 = __shfl_xor(y2, 4), z3 = __shfl_xor(y3, 4), z4 = __shfl_xor(y4, 4), z5 = __shfl_xor(y5, 4), z6 = __shfl_xor(y6, 4), z7 = __shfl_xor(y7, 4);
                    const float sg = (sub < 4) ? -1.f : 1.f;
                    w.x = cvt_pk_bf16(y0 * t0.x + sg * z0 * t0.y, y1 * t0.z + sg * z1 * t0.w); w.y = cvt_pk_bf16(y2 * t1.x + sg * z2 * t1.y, y3 * t1.z + sg * z3 * t1.w);
                    w.z = cvt_pk_bf16(y4 * t2.x + sg * z4 * t2.y, y5 * t2.z + sg * z5 * t2.w); w.w = cvt_pk_bf16(y6 * t3.x + sg * z6 * t3.y, y7 * t3.z + sg * z7 * t3.w);
                    *(u32x4*)(dst + 128 + 8 * sub) = w;
                }
            }
        }
        xcd_barrier(xbar);
        { PH_BEGIN
            for (int it = gw; it < 16 * NCHUNK; it += NGW) {
                const int bh = it / NCHUNK, c = it % NCHUNK, b = bh >> 3, h = bh & 7;
                const size_t rowbase = (c == 0) ? (size_t)(MROW0 + 16 * b) : (size_t)b * SEQ + (size_t)(c - 1) * 64;
                const bf16_t* q = QP + (size_t)(MROW0 + 16 * b + 15) * 1536 + h * 192; const bf16_t* k = KP + (rowbase + lane) * 1536 + h * 192;
                float s = 0.f;
#pragma unroll 4
                for (int ch = 0; ch < 24; ++ch) s += dot8(*(const u32x4*)(q + ch * 8), *(const u32x4*)(k + ch * 8));
                s *= mla::SCALE * LOG2E; if (c == 0 && lane >= 16) s = -1e30f;
                const float m = wave_max(s); const float p = __builtin_amdgcn_exp2f(s - m); const float l = wave_sum(p);
                const bf16_t* vp = KV + rowbase * 2048 + h * 256 + 128 + 2 * lane;
                float o0 = 0.f, o1 = 0.f;
#pragma unroll 8
                for (int key = 0; key < 64; ++key) { const float pk = __shfl(p, key); const unsigned u = *(const unsigned*)(vp + (size_t)key * 2048); o0 += pk * bflo(u); o1 += pk * bfhi(u); }
                float* pt = PART + (size_t)it * PARTW;
                if (lane == 0) { pt[0] = m; pt[1] = l; }
                pt[4 + 2 * lane] = o0; pt[5 + 2 * lane] = o1;
            }
            __syncthreads();
            const int xcd = blockIdx.x & 7, idx = blockIdx.x >> 3, nper = G >> 3;
            for (int i = 0;; ++i) {
                int u;
                if ((G & 7) == 0 && nper == 32) { const int slot = i * 8 + xcd; if (slot >= 32) break; u = (slot >> 1) * 64 + (slot & 1) * 32 + idx; }
                else { u = blockIdx.x + i * G; if (u >= 1024) break; }
                const int bh = u >> 6, qb = u & 63, b = bh >> 3, h = bh & 7;
                const size_t q0 = (size_t)b * SEQ + (size_t)qb * 256;
                int tid_u = tid; asm volatile("" : "+v"(tid_u));
                mla::attn_unit2(QP + q0 * 1536 + h * 192, KP + h * 192, KV + h * 256 + 128, OUTB + q0 * 1024 + h * 128, MROW0 + 16 * b, b * SEQ, (char*)lds, tid_u);
            }
        }
        xcd_barrier(xbar);
        { PH_BEGIN
            const int nw9 = (G > 1) ? (G - 1) * 8 : 8;
            if ((int)blockIdx.x < G - 1 || G == 1)
            for (int row = gw; row < NREAL; row += nw9) {
#pragma unroll
                for (int which = 0; which < 2; ++which) {
                    const bf16_t* src = (which == 0 ? OUTA : OUTB) + (size_t)row * 1024 + 16 * lane; const float* gn = (which == 0 ? P.na_out_g : P.mla_out_g) + 16 * lane;
                    const u32x4 a = *(const u32x4*)src, bq = *(const u32x4*)(src + 8);
                    float n0 = bflo(a.x), n1 = bfhi(a.x), n2 = bflo(a.y), n3 = bfhi(a.y), n4 = bflo(a.z), n5 = bfhi(a.z), n6 = bflo(a.w), n7 = bfhi(a.w);
                    float m0 = bflo(bq.x), m1 = bfhi(bq.x), m2 = bflo(bq.y), m3 = bfhi(bq.y), m4 = bflo(bq.z), m5 = bfhi(bq.z), m6 = bflo(bq.w), m7 = bfhi(bq.w);
                    const float ss = wave_sum(n0 * n0 + n1 * n1 + n2 * n2 + n3 * n3 + n4 * n4 + n5 * n5 + n6 * n6 + n7 * n7 + m0 * m0 + m1 * m1 + m2 * m2 + m3 * m3 + m4 * m4 + m5 * m5 + m6 * m6 + m7 * m7);
                    const float rs = __builtin_amdgcn_rsqf(ss * (1.f / 1024.f) + EPS);
                    const f32x4 ga = *(const f32x4*)gn, gb = *(const f32x4*)(gn + 4), gc = *(const f32x4*)(gn + 8), gd = *(const f32x4*)(gn + 12);
                    bf16_t* dst = MIX + (size_t)row * DM + which * 1024 + 16 * lane; u32x4 w;
                    w.x = cvt_pk_bf16(n0 * rs * ga.x, n1 * rs * ga.y); w.y = cvt_pk_bf16(n2 * rs * ga.z, n3 * rs * ga.w); w.z = cvt_pk_bf16(n4 * rs * gb.x, n5 * rs * gb.y); w.w = cvt_pk_bf16(n6 * rs * gb.z, n7 * rs * gb.w);
                    *(u32x4*)dst = w;
                    w.x = cvt_pk_bf16(m0 * rs * gc.x, m1 * rs * gc.y); w.y = cvt_pk_bf16(m2 * rs * gc.z, m3 * rs * gc.w); w.z = cvt_pk_bf16(m4 * rs * gd.x, m5 * rs * gd.y); w.w = cvt_pk_bf16(m6 * rs * gd.z, m7 * rs * gd.w);
                    *(u32x4*)(dst + 8) = w;
                }
            }
            if ((int)blockIdx.x == G - 1) {
                float* sh = (float*)lds;
                __syncthreads();
                for (int bh = wid; bh < 16; bh += 8) {
                    const float* pt = PART + (size_t)bh * NCHUNK * PARTW;
                    float mm = -1e30f;
                    for (int c = lane; c < NCHUNK; c += 64) mm = fmaxf(mm, pt[(size_t)c * PARTW]);
                    mm = wave_max(mm);
                    float L = 0.f, o0 = 0.f, o1 = 0.f;
                    for (int c = 0; c < NCHUNK; ++c) { const float* pc = pt + (size_t)c * PARTW; const float w = __builtin_amdgcn_exp2f(pc[0] - mm); L += w * pc[1]; o0 += w * pc[4 + 2 * lane]; o1 += w * pc[5 + 2 * lane]; }
                    const float inv = 1.f / L;
                    sh[bh * 128 + 2 * lane] = bfround(o0 * inv); sh[bh * 128 + 2 * lane + 1] = bfround(o1 * inv);
                }
                __syncthreads();
                if (wid < 2) {
                    const int b = wid; float sa = 0.f, sb = 0.f;
#pragma unroll
                    for (int e = 0; e < 16; ++e) { const float va = bfround(OA15[16 * lane + e]), vb = sh[b * 1024 + 16 * lane + e]; sa += va * va; sb += vb * vb; }
                    const float ra = __builtin_amdgcn_rsqf(wave_sum(sa) * (1.f / 1024.f) + EPS), rb = __builtin_amdgcn_rsqf(wave_sum(sb) * (1.f / 1024.f) + EPS);
#pragma unroll
                    for (int e = 0; e < 16; ++e) { const int i = 16 * lane + e;
                        MIX15[b * DM + i] = bfround(bfround(OA15[i]) * ra * P.na_out_g[i]); MIX15[b * DM + 1024 + i] = bfround(sh[b * 1024 + i] * rb * P.mla_out_g[i]); }
                }
                __syncthreads();
            }
        }
        xcd_barrier(xbar);
        { PH_BEGIN pg8::Gemm g = pg8::Gemm{MIX, WOT, NREAL, DM, DM}; pg8::EpiResSsq E = pg8::EpiResSsq{P.x, P.out, HN2, SSQ, DM}; pg8::StaticOrder S; S.init(g.M, g.N, G, (int)blockIdx.x);
          pg8::gemm_phase<pg8::EpiResSsq, pg8::StaticOrder, false, true>((LAS unsigned char*)lds, g, S, E, tid); }
        { PH_BEGIN
            {
                for (int n = gw; n < DM; n += NGW) {
                    const bf16_t* w = WOT + (size_t)n * DM; float a0 = 0.f, a1 = 0.f;
#pragma unroll
                    for (int i = 0; i < 4; ++i) { const int k = 8 * lane + 512 * i; const u32x4 wv = *(const u32x4*)(w + k);
                        const f32x4 x0 = *(const f32x4*)(MIX15 + k), x1 = *(const f32x4*)(MIX15 + k + 4), y0 = *(const f32x4*)(MIX15 + DM + k), y1 = *(const f32x4*)(MIX15 + DM + k + 4);
                        const float w0 = bflo(wv.x), w1 = bfhi(wv.x), w2 = bflo(wv.y), w3 = bfhi(wv.y), w4 = bflo(wv.z), w5 = bfhi(wv.z), w6 = bflo(wv.w), w7 = bfhi(wv.w);
                        a0 += w0 * x0.x + w1 * x0.y + w2 * x0.z + w3 * x0.w + w4 * x1.x + w5 * x1.y + w6 * x1.z + w7 * x1.w;
                        a1 += w0 * y0.x + w1 * y0.y + w2 * y0.z + w3 * y0.w + w4 * y1.x + w5 * y1.y + w6 * y1.z + w7 * y1.w; }
                    a0 = wave_sum(a0); a1 = wave_sum(a1);
                    if (lane == 0) { const float mb = P.meta[15 * DM + n]; H115[n] = mb + a0; H115[DM + n] = mb + a1; }
                }
            }
        }
        xcd_barrier(xbar);
        { PH_BEGIN
            for (int row = gw; row < NREAL; row += NGW) {
                const bf16_t* src = HN2 + (size_t)row * DM + 8 * lane; float ss = 0.f;
#pragma unroll
                for (int i = 0; i < 4; ++i) { const u32x4 v = *(const u32x4*)(src + 512 * i);
                    const float f0 = bflo(v.x), f1 = bfhi(v.x), f2 = bflo(v.y), f3 = bfhi(v.y), f4 = bflo(v.z), f5 = bfhi(v.z), f6 = bflo(v.w), f7 = bfhi(v.w);
                    ss += f0 * f0 + f1 * f1 + f2 * f2 + f3 * f3 + f4 * f4 + f5 * f5 + f6 * f6 + f7 * f7; }
                ss = wave_sum(ss);
                if (lane == 0) SSQ[row] = ss;
            }
        }
        xcd_barrier(xbar);
        { PH_BEGIN pg8::Gemm g = pg8::Gemm{HN2, WGT, NREAL, DFF, DM}; pg8::EpiBf16 E = pg8::EpiBf16{GB, DFF, SSQ}; pg8::StaticOrder S; S.init(g.M, g.N, G, (int)blockIdx.x);
          pg8::gemm_phase<pg8::EpiBf16, pg8::StaticOrder, true, true>((LAS unsigned char*)lds, g, S, E, tid); }
        { PH_BEGIN
            {
                for (int n = gw; n < DFF; n += NGW) {
                    const bf16_t* w = WGT + (size_t)n * DM; float a0 = 0.f, a1 = 0.f, s0 = 0.f, s1 = 0.f;
#pragma unroll
                    for (int i = 0; i < 4; ++i) { const int k = 8 * lane + 512 * i; const u32x4 wv = *(const u32x4*)(w + k);
                        const f32x4 x0 = *(const f32x4*)(H115 + k), x1 = *(const f32x4*)(H115 + k + 4), y0 = *(const f32x4*)(H115 + DM + k), y1 = *(const f32x4*)(H115 + DM + k + 4);
                        const float w0 = bflo(wv.x), w1 = bfhi(wv.x), w2 = bflo(wv.y), w3 = bfhi(wv.y), w4 = bflo(wv.z), w5 = bfhi(wv.z), w6 = bflo(wv.w), w7 = bfhi(wv.w);
                        a0 += w0 * x0.x + w1 * x0.y + w2 * x0.z + w3 * x0.w + w4 * x1.x + w5 * x1.y + w6 * x1.z + w7 * x1.w;
                        a1 += w0 * y0.x + w1 * y0.y + w2 * y0.z + w3 * y0.w + w4 * y1.x + w5 * y1.y + w6 * y1.z + w7 * y1.w;
                        s0 += x0.x * x0.x + x0.y * x0.y + x0.z * x0.z + x0.w * x0.w + x1.x * x1.x + x1.y * x1.y + x1.z * x1.z + x1.w * x1.w;
                        s1 += y0.x * y0.x + y0.y * y0.y + y0.z * y0.z + y0.w * y0.w + y1.x * y1.x + y1.y * y1.y + y1.z * y1.z + y1.w * y1.w; }
                    a0 = wave_sum(a0) * __builtin_amdgcn_rsqf(wave_sum(s0) * (1.f / DM) + EPS); a1 = wave_sum(a1) * __builtin_amdgcn_rsqf(wave_sum(s1) * (1.f / DM) + EPS);
                    if (lane == 0) { G15[n] = a0; G15[DFF + n] = a1; }
                }
            }
        }
        xcd_barrier(xbar);
        { PH_BEGIN pg8::Gemm g{HN2, WUT, NREAL, DFF, DM}; pg8::EpiConvGlu E{GB, ACT, DFF, P.conv_w, P.conv_b, G15, SSQ}; pg8::StaticOrder S; S.init(g.M, g.N, G, (int)blockIdx.x);
          pg8::gemm_phase<pg8::EpiConvGlu, pg8::StaticOrder, true, true>((LAS unsigned char*)lds, g, S, E, tid); }
        xcd_barrier(xbar);
        { PH_BEGIN pg8::Gemm g = pg8::Gemm{ACT, WDT, NREAL, DM, DFF}; pg8::EpiResF32 E = pg8::EpiResF32{P.out, P.out, DM}; pg8::StaticOrder S; S.init(g.M, g.N, G, (int)blockIdx.x);
          pg8::gemm_phase<pg8::EpiResF32, pg8::StaticOrder, true, true>((LAS unsigned char*)lds, g, S, E, tid); }
}

extern "C" void kernel_launch(void* const* d_in, const int* in_sizes, int n_in, void* d_out, int out_size, void* d_ws, size_t ws_size, hipStream_t stream) {
    static int grid = 0;
    if (grid == 0) {
        if (n_in != 23 || in_sizes[0] != NREAL * DM || out_size != NREAL * DM || ws_size < WS_END) {
            fprintf(stderr, "kernel_launch: unexpected shapes: n_in %d in0 %d out %d ws %zu (need %zu)\n", n_in, n_in > 0 ? in_sizes[0] : -1, out_size, ws_size, (size_t)WS_END); grid = -1; return; }
        int dev = 0, cus = 0, per_cu = 0;
        hipGetDevice(&dev); hipDeviceGetAttribute(&cus, hipDeviceAttributeMultiprocessorCount, dev);
        if (hipFuncSetAttribute((const void*)fwd_kernel, hipFuncAttributeMaxDynamicSharedMemorySize, LDS_BYTES) != hipSuccess) { fprintf(stderr, "kernel_launch: hipFuncSetAttribute failed\n"); grid = -1; return; }
        if (hipOccupancyMaxActiveBlocksPerMultiprocessor(&per_cu, (const void*)fwd_kernel, 512, LDS_BYTES) != hipSuccess || per_cu < 1) { fprintf(stderr, "kernel_launch: occupancy query gave %d\n", per_cu); per_cu = 1; }
        (void)hipGetLastError();
        grid = cus * per_cu;
    }
    if (grid < 0) return;
    Args a{};
    const float** ap = (const float**)&a;
    for (int i = 0; i < 23; ++i) ap[i] = (const float*)d_in[i];
    a.out = (float*)d_out; a.ws = (unsigned char*)d_ws;
    if (hipMemsetAsync(d_ws, 0, 16384, stream) != hipSuccess) { fprintf(stderr, "kernel_launch: memset failed\n"); return; }
    void* args[] = {&a};
    hipError_t e = hipLaunchCooperativeKernel((const void*)fwd_kernel, dim3(grid), dim3(512), args, LDS_BYTES, stream);
    if (e != hipSuccess) fprintf(stderr, "cooperative launch failed: %s (grid %d)\n", hipGetErrorString(e), grid);
}
```

```cpp
#include <hip/hip_runtime.h>
#include <hip/hip_cooperative_groups.h>
#include <cstdio>
#include <cstdint>
namespace cg = cooperative_groups;

#define LAS __attribute__((address_space(3)))
typedef unsigned short bf16_t;
typedef short bf16x8 __attribute__((ext_vector_type(8)));
typedef short s16x4 __attribute__((ext_vector_type(4)));
typedef float f32x4 __attribute__((ext_vector_type(4)));
typedef float f32x16 __attribute__((ext_vector_type(16)));
typedef unsigned u32x4 __attribute__((ext_vector_type(4)));
typedef unsigned u32x2 __attribute__((ext_vector_type(2)));

constexpr int DM = 2048, SEQ = 16384, NREAL = 32768, MROW0 = 32768, MP = 33024, DFF = 5632, INC = 3904, LTOT = 16400;
constexpr float EPS = 1e-6f, LOG2E = 1.4426950408889634f;
constexpr int PJ = 3072;
constexpr int NCHUNK = 257;
constexpr int PARTW = 132;

constexpr size_t MiB = 1u << 20;
constexpr size_t WS_TAB = 1 * MiB, WS_PART = 6 * MiB, WS_SMALL = 9 * MiB;
constexpr size_t SM_OA15 = 0, SM_MIX15 = 8192, SM_H115 = 32768, SM_HN215 = 65536, SM_G15 = 131072, SM_SSQ = 262144;
constexpr size_t WS_W1T = 16 * MiB, WS_WVT = 28 * MiB, WS_WQT = 32 * MiB, WS_WKVT = 34 * MiB, WS_WOT = 36 * MiB, WS_WGT = 44 * MiB, WS_WUT = 66 * MiB, WS_WDT = 88 * MiB;
constexpr size_t WS_HN = 112 * MiB, WS_PROJ = 241 * MiB, WS_VT = 435 * MiB, WS_CQN = 500 * MiB, WS_CKVN = 533 * MiB, WS_QRAW = 550 * MiB, WS_KV = 647 * MiB;
constexpr size_t WS_OUTA = 776 * MiB, WS_OUTB = 840 * MiB, WS_QP = 112 * MiB, WS_KP = 435 * MiB, WS_MIX = 112 * MiB, WS_HN2 = 816 * MiB, WS_G = 112 * MiB, WS_ACT = 464 * MiB;
constexpr size_t WS_END = 944 * MiB;

__device__ __forceinline__ unsigned cvt_pk_bf16(float lo, float hi) { unsigned r; asm volatile("v_cvt_pk_bf16_f32 %0, %1, %2" : "=v"(r) : "v"(lo), "v"(hi)); return r; }
__device__ __forceinline__ float bflo(unsigned u) { return __uint_as_float(u << 16); }
__device__ __forceinline__ float bfhi(unsigned u) { return __uint_as_float(u & 0xffff0000u); }
__device__ __forceinline__ unsigned short f2bf(float f) { unsigned u = __float_as_uint(f); return (unsigned short)((u + 0x7fffu + ((u >> 16) & 1u)) >> 16); }
__device__ __forceinline__ float bfround(float f) { return __uint_as_float(((unsigned)f2bf(f)) << 16); }
__device__ __forceinline__ float wave_sum(float v) {
#pragma unroll
    for (int o = 1; o < 64; o <<= 1) v += __shfl_xor(v, o);
    return v;
}
__device__ __forceinline__ float wave_max(float v) {
#pragma unroll
    for (int o = 1; o < 64; o <<= 1) v = fmaxf(v, __shfl_xor(v, o));
    return v;
}
__device__ __forceinline__ float dot8(u32x4 a, u32x4 b) {
    return bflo(a.x) * bflo(b.x) + bfhi(a.x) * bfhi(b.x) + bflo(a.y) * bflo(b.y) + bfhi(a.y) * bfhi(b.y)
         + bflo(a.z) * bflo(b.z) + bfhi(a.z) * bfhi(b.z) + bflo(a.w) * bflo(b.w) + bfhi(a.w) * bfhi(b.w);
}

namespace pg8 {
#define PG8_LAS __attribute__((address_space(3)))
constexpr int BM = 256, BK = 64, HALF = 128, HTB = HALF * BK * 2, STAGE_BYTES = 8 * HTB, NXCD = 8, WGM = 8;
__host__ __device__ __forceinline__ int lds_byte(int r, int c) { const int st = (r >> 4) * 2 + (c >> 5), rr = r & 15, cc = c & 31, ob = rr * 64 + cc * 2; return st * 1024 + (ob ^ (((ob >> 9) & 1) << 5)); }
__host__ __device__ __forceinline__ void stage_rc(int b, int& R, int& C) { const int st = b / 1024, sb = b % 1024, swz = sb ^ (((sb >> 9) & 1) << 5); R = (st >> 1) * 16 + swz / 64; C = (st & 1) * 32 + (swz % 64) / 2; }
__host__ __device__ __forceinline__ int perm32(int rho) { const int n = rho >> 4, i = rho & 15; return 8 * (i >> 2) + 4 * n + (i & 3); }
struct Unit { int pm, pn; };
struct Gemm { const bf16_t* A; const bf16_t* Bt; int M, N, K; };
struct StaticOrder {
    int nM, nN, nwg, G, c;
    __host__ __device__ void init(int M, int N, int G_, int c_) { nM = M / BM; nN = N / BM; nwg = nM * nN; G = G_; c = c_; }
    __host__ __device__ bool next(int i, Unit& u) const {
        const long L = (long)i * G + c; if (L >= nwg) return false;
        int wgid = (int)L; { const int q = nwg / NXCD, r = nwg % NXCD, xcd = wgid % NXCD, off = wgid / NXCD; wgid = (xcd < r ? xcd * (q + 1) : r * (q + 1) + (xcd - r) * q) + off; }
        const int nig = WGM * nN, gid = wgid / nig, fm = gid * WGM, gsz = (nM - fm) < WGM ? (nM - fm) : WGM;
        u.pm = fm + ((wgid % nig) % gsz); u.pn = (wgid % nig) / gsz; return true;
    }
    __device__ __forceinline__ void a_ready(const Unit&) const {}
    __device__ __forceinline__ void done(const Unit&) const {}
};
struct EpiBf16 {
    static constexpr bool PERM = true, AFTER_DRAIN = false;
    bf16_t* O; int ldc; const float* ssq;
    __device__ __forceinline__ void operator()(const f32x4 (&acc)[2][2][4][2], const Unit& u, int wr, int wc, int fr, int fq) const {
        const int row0 = u.pm * BM + wr * 64 + fr; const int col0 = u.pn * BM + wc * 32 + 8 * fq;
#pragma unroll
        for (int ai = 0; ai < 2; ++ai)
#pragma unroll
            for (int m = 0; m < 4; ++m) { bf16_t* rowp = O + (size_t)(row0 + ai * HALF + m * 16) * ldc + col0;
                const float rsc = ssq ? __builtin_amdgcn_rsqf(ssq[row0 + ai * HALF + m * 16] * (1.f / DM) + EPS) : 1.f;
#pragma unroll
                for (int bj = 0; bj < 2; ++bj) { const f32x4 v0 = acc[ai][bj][m][0] * rsc, v1 = acc[ai][bj][m][1] * rsc;
                    u32x4 w; w.x = cvt_pk_bf16(v0[0], v0[1]); w.y = cvt_pk_bf16(v0[2], v0[3]); w.z = cvt_pk_bf16(v1[0], v1[1]); w.w = cvt_pk_bf16(v1[2], v1[3]);
                    *(u32x4*)(rowp + bj * HALF) = w; } }
    }
};
struct EpiResF32 {
    static constexpr bool PERM = true, AFTER_DRAIN = false;
    const float* base; float* out; int ldc;
    __device__ __forceinline__ void operator()(const f32x4 (&acc)[2][2][4][2], const Unit& u, int wr, int wc, int fr, int fq) const {
        const int row0 = u.pm * BM + wr * 64 + fr; const int col0 = u.pn * BM + wc * 32 + 8 * fq;
#pragma unroll
        for (int ai = 0; ai < 2; ++ai)
#pragma unroll
            for (int m = 0; m < 4; ++m) { const size_t off = (size_t)(row0 + ai * HALF + m * 16) * ldc + col0;
#pragma unroll
                for (int bj = 0; bj < 2; ++bj) {
                    const f32x4 o0 = *(const f32x4*)(base + off + bj * HALF) + acc[ai][bj][m][0], o1 = *(const f32x4*)(base + off + bj * HALF + 4) + acc[ai][bj][m][1];
                    *(f32x4*)(out + off + bj * HALF) = o0; *(f32x4*)(out + off + bj * HALF + 4) = o1; }
                asm volatile("" ::: "memory"); }
    }
};
struct EpiResSsq {
    static constexpr bool PERM = true, AFTER_DRAIN = false;
    const float* base; float* out; bf16_t* xb; float* ssq; int ldc;
    __device__ __forceinline__ void operator()(const f32x4 (&acc)[2][2][4][2], const Unit& u, int wr, int wc, int fr, int fq) const {
        const int row0 = u.pm * BM + wr * 64 + fr; const int col0 = u.pn * BM + wc * 32 + 8 * fq;
#pragma unroll
        for (int ai = 0; ai < 2; ++ai)
#pragma unroll
            for (int m = 0; m < 4; ++m) { const int row = row0 + ai * HALF + m * 16; const size_t off = (size_t)row * ldc + col0; float sq = 0.f;
#pragma unroll
                for (int bj = 0; bj < 2; ++bj) {
                    const f32x4 o0 = *(const f32x4*)(base + off + bj * HALF) + acc[ai][bj][m][0], o1 = *(const f32x4*)(base + off + bj * HALF + 4) + acc[ai][bj][m][1];
                    *(f32x4*)(out + off + bj * HALF) = o0; *(f32x4*)(out + off + bj * HALF + 4) = o1;
                    u32x4 w; w.x = cvt_pk_bf16(o0[0], o0[1]); w.y = cvt_pk_bf16(o0[2], o0[3]); w.z = cvt_pk_bf16(o1[0], o1[1]); w.w = cvt_pk_bf16(o1[2], o1[3]);
                    *(u32x4*)(xb + off + bj * HALF) = w;
                    sq += (o0[0] * o0[0] + o0[1] * o0[1]) + (o0[2] * o0[2] + o0[3] * o0[3]) + (o1[0] * o1[0] + o1[1] * o1[1]) + (o1[2] * o1[2] + o1[3] * o1[3]); }
                (void)sq; (void)fq;
                asm volatile("" ::: "memory"); }
    }
};
struct EpiConvGlu {
    static constexpr bool PERM = true, AFTER_DRAIN = false;
    const bf16_t* Gt; bf16_t* O; int ldc; const float* cw; const float* cb; const float* g15; const float* ssq;
    __device__ __forceinline__ void operator()(const f32x4 (&acc)[2][2][4][2], const Unit& u, int wr, int wc, int fr, int fq) const {
        const int row0 = u.pm * BM + wr * 64 + fr; const int col0 = u.pn * BM + wc * 32 + 8 * fq;
#pragma unroll
        for (int bj = 0; bj < 2; ++bj) {
            const int col = col0 + bj * HALF;
            const f32x4 w0a = *(const f32x4*)(cw + col), w0b = *(const f32x4*)(cw + col + 4);
            const f32x4 w1a = *(const f32x4*)(cw + DFF + col), w1b = *(const f32x4*)(cw + DFF + col + 4);
            const f32x4 w2a = *(const f32x4*)(cw + 2 * DFF + col), w2b = *(const f32x4*)(cw + 2 * DFF + col + 4);
            const f32x4 cba = *(const f32x4*)(cb + col), cbb = *(const f32x4*)(cb + col + 4);
#pragma unroll
            for (int ai = 0; ai < 2; ++ai)
#pragma unroll
                for (int m = 0; m < 4; ++m) {
                    const int row = row0 + ai * HALF + m * 16; const int t = row & (SEQ - 1), b = row >> 14;
                    const bf16_t* gp = Gt + (size_t)row * ldc + col; const float rsc = __builtin_amdgcn_rsqf(ssq[row] * (1.f / DM) + EPS);
                    const u32x4 gc = *(const u32x4*)gp;
                    f32x4 pa, pb, na, nb;
                    if (t == 0) { pa = *(const f32x4*)(g15 + b * DFF + col); pb = *(const f32x4*)(g15 + b * DFF + col + 4); }
                    else { const u32x4 gq = *(const u32x4*)(gp - ldc); pa = (f32x4){bflo(gq.x), bfhi(gq.x), bflo(gq.y), bfhi(gq.y)}; pb = (f32x4){bflo(gq.z), bfhi(gq.z), bflo(gq.w), bfhi(gq.w)}; }
                    if (t == SEQ - 1) { na = (f32x4){0.f, 0.f, 0.f, 0.f}; nb = na; }
                    else { const u32x4 gq = *(const u32x4*)(gp + ldc); na = (f32x4){bflo(gq.x), bfhi(gq.x), bflo(gq.y), bfhi(gq.y)}; nb = (f32x4){bflo(gq.z), bfhi(gq.z), bflo(gq.w), bfhi(gq.w)}; }
                    const f32x4 ca = (f32x4){bflo(gc.x), bfhi(gc.x), bflo(gc.y), bfhi(gc.y)}, cbv = (f32x4){bflo(gc.z), bfhi(gc.z), bflo(gc.w), bfhi(gc.w)};
                    f32x4 ra, rb;
#pragma unroll
                    for (int e = 0; e < 4; ++e) {
                        const float xa = __builtin_fmaf(w2a[e], na[e], __builtin_fmaf(w1a[e], ca[e], __builtin_fmaf(w0a[e], pa[e], cba[e])));
                        const float xb = __builtin_fmaf(w2b[e], nb[e], __builtin_fmaf(w1b[e], cbv[e], __builtin_fmaf(w0b[e], pb[e], cbb[e])));
                        ra[e] = (xa * __builtin_amdgcn_rcpf(1.f + __builtin_amdgcn_exp2f(xa * -LOG2E))) * (acc[ai][bj][m][0][e] * rsc);
                        rb[e] = (xb * __builtin_amdgcn_rcpf(1.f + __builtin_amdgcn_exp2f(xb * -LOG2E))) * (acc[ai][bj][m][1][e] * rsc); }
                    u32x4 w; w.x = cvt_pk_bf16(ra[0], ra[1]); w.y = cvt_pk_bf16(ra[2], ra[3]); w.z = cvt_pk_bf16(rb[0], rb[1]); w.w = cvt_pk_bf16(rb[2], rb[3]);
                    *(u32x4*)(O + (size_t)row * ldc + col) = w;
                }
        }
    }
};

template <class Epi, class Sched, bool ALIGN_EPI = false, bool SP2 = false>
__device__ __forceinline__ void gemm_phase(PG8_LAS unsigned char* lds, const Gemm g, const Sched& S, const Epi& E, const int tid) {
    const int wid = __builtin_amdgcn_readfirstlane(tid >> 6), lane = tid & 63, wr = wid >> 2, wc = wid & 3, fr = lane & 15, fq = lane >> 4;
    const int K = g.K, nt = K / BK;
    unsigned voffA[2], voffB[2];
#pragma unroll
    for (int i = 0; i < 2; ++i) { int R, C; stage_rc(tid * 16 + i * 8192, R, C); const int Rb = Epi::PERM ? ((R & ~31) + perm32(R & 31)) : R;
        voffA[i] = (unsigned)(R * K + C) * 2u; voffB[i] = (unsigned)(Rb * K + C) * 2u; }
    const size_t kstep = (size_t)(BK * 2);
    const size_t hstep = (size_t)HALF * K * 2;
    const size_t tstep = 2 * hstep;
    const unsigned ldsw = (unsigned)wid * 1024u;
    const int aoff = lds_byte(wr * 64 + fr, fq * 8), boff = lds_byte(wc * 32 + fr, fq * 8);
#define PG8_SA(b, h) (((b) * 2 + (h)) * HTB)
#define PG8_SB(b, h) ((4 + (b) * 2 + (h)) * HTB)
#define PG8_STAGE(bufoff, gbase, voff) do { _Pragma("unroll") for (int _i = 0; _i < 2; ++_i) \
        __builtin_amdgcn_global_load_lds((const unsigned*)((const char*)(gbase) + (voff)[_i]), (PG8_LAS unsigned*)(lds + (bufoff) + ldsw + _i * 8192), 16, 0, 0); } while (0)
#define PG8_LDA(dst, b, h) do { _Pragma("unroll") for (int m = 0; m < 4; ++m) _Pragma("unroll") for (int k = 0; k < 2; ++k) dst[m][k] = *(const PG8_LAS bf16x8*)(lds + PG8_SA(b, h) + aoff + m * 2048 + k * 1024); } while (0)
#define PG8_LDB(dst, b, h) do { _Pragma("unroll") for (int n = 0; n < 2; ++n) _Pragma("unroll") for (int k = 0; k < 2; ++k) dst[n][k] = *(const PG8_LAS bf16x8*)(lds + PG8_SB(b, h) + boff + n * 2048 + k * 1024); } while (0)
#define PG8_MMA(ai, bj, At, Bt) do { __builtin_amdgcn_s_setprio(1); _Pragma("unroll") for (int m = 0; m < 4; ++m) _Pragma("unroll") for (int n = 0; n < 2; ++n) _Pragma("unroll") for (int k = 0; k < 2; ++k) \
        acc[ai][bj][m][n] = __builtin_amdgcn_mfma_f32_16x16x32_bf16(Bt[n][k], At[m][k], acc[ai][bj][m][n], 0, 0, 0); __builtin_amdgcn_s_setprio(0); } while (0)
#define PG8_WAIT_V(n) asm volatile("s_waitcnt vmcnt(" #n ")" ::: "memory")
#define PG8_WAIT_L(n) asm volatile("s_waitcnt lgkmcnt(" #n ")" ::: "memory")
#define PG8_BAR __builtin_amdgcn_s_barrier()
#define PG8_SCHED __builtin_amdgcn_sched_barrier(0)
    Unit cur, nxt; int ui = 0;
    if (!S.next(0, cur)) return;
    f32x4 acc[2][2][4][2];
#pragma unroll
    for (int a = 0; a < 2; ++a)
#pragma unroll
        for (int b = 0; b < 2; ++b)
#pragma unroll
            for (int m = 0; m < 4; ++m)
#pragma unroll
                for (int n = 0; n < 2; ++n) acc[a][b][m][n] = (f32x4){0.f, 0.f, 0.f, 0.f};
    bf16x8 At[4][2], B0[2][2], B1[2][2];
    const char* cA = (const char*)g.A + (size_t)cur.pm * tstep; const char* cB = (const char*)g.Bt + (size_t)cur.pn * tstep;
    S.a_ready(cur);
    if constexpr (SP2) {
        PG8_STAGE(PG8_SB(0, 0), cB, voffB); PG8_STAGE(PG8_SB(0, 1), cB + hstep, voffB); PG8_STAGE(PG8_SA(0, 0), cA, voffA); PG8_STAGE(PG8_SA(0, 1), cA + hstep, voffA);
        if (wr == 1) PG8_BAR;
        PG8_WAIT_V(2); PG8_BAR;
        PG8_STAGE(PG8_SB(1, 0), cB + kstep, voffB); PG8_STAGE(PG8_SA(1, 0), cA + kstep, voffA); PG8_STAGE(PG8_SB(1, 1), cB + hstep + kstep, voffB);
        PG8_WAIT_V(6); PG8_BAR;
    } else {
        PG8_STAGE(PG8_SB(0, 0), cB, voffB); PG8_STAGE(PG8_SA(0, 0), cA, voffA); PG8_STAGE(PG8_SB(0, 1), cB + hstep, voffB); PG8_STAGE(PG8_SA(0, 1), cA + hstep, voffA);
        if (wr == 1) PG8_BAR;
        PG8_WAIT_V(4); PG8_BAR;
        PG8_STAGE(PG8_SB(1, 0), cB + kstep, voffB); PG8_STAGE(PG8_SA(1, 0), cA + kstep, voffA); PG8_STAGE(PG8_SB(1, 1), cB + hstep + kstep, voffB);
        PG8_WAIT_V(6); PG8_BAR;
    }
    for (;;) {
        const bool has_next = S.next(ui + 1, nxt);
        const char* nA = has_next ? (const char*)g.A + (size_t)nxt.pm * tstep : cA; const char* nB = has_next ? (const char*)g.Bt + (size_t)nxt.pn * tstep : cB;
        for (int t = 0; t < nt; t += 2) {
            const bool last = (t == nt - 2);
            const char* a1 = cA + (size_t)(t + 1) * kstep;
            const char* a2 = last ? nA : cA + (size_t)(t + 2) * kstep; const char* b2 = last ? nB : cB + (size_t)(t + 2) * kstep;
            const char* a3 = a2 + kstep; const char* b3 = b2 + kstep;
            if (last && has_next) S.a_ready(nxt);
            if constexpr (SP2) {
            PG8_LDB(B0, 0, 0); PG8_LDB(B1, 0, 1); PG8_SCHED; PG8_LDA(At, 0, 0); PG8_STAGE(PG8_SA(1, 1), a1 + hstep, voffA);
            PG8_WAIT_V(8); PG8_WAIT_L(0); PG8_BAR; PG8_MMA(0, 0, At, B0); PG8_MMA(0, 1, At, B1); PG8_BAR; PG8_SCHED;
            PG8_LDA(At, 0, 1); PG8_STAGE(PG8_SB(0, 0), b2, voffB); PG8_STAGE(PG8_SB(0, 1), b2 + hstep, voffB); PG8_STAGE(PG8_SA(0, 0), a2, voffA);
            PG8_WAIT_V(8); PG8_WAIT_L(0); PG8_BAR; PG8_MMA(1, 0, At, B0); PG8_MMA(1, 1, At, B1); PG8_BAR; PG8_SCHED;
            PG8_LDB(B0, 1, 0); PG8_LDB(B1, 1, 1); PG8_SCHED; PG8_LDA(At, 1, 0); PG8_STAGE(PG8_SA(0, 1), a2 + hstep, voffA);
            PG8_WAIT_V(8); PG8_WAIT_L(0); PG8_BAR; PG8_MMA(0, 0, At, B0); PG8_MMA(0, 1, At, B1); PG8_BAR; PG8_SCHED;
            PG8_LDA(At, 1, 1); PG8_STAGE(PG8_SB(1, 0), b3, voffB); PG8_STAGE(PG8_SB(1, 1), b3 + hstep, voffB); PG8_STAGE(PG8_SA(1, 0), a3, voffA);
            PG8_WAIT_V(8); PG8_WAIT_L(0); PG8_BAR; PG8_MMA(1, 0, At, B0); PG8_MMA(1, 1, At, B1); PG8_BAR; PG8_SCHED;
            } else {
            PG8_LDB(B0, 0, 0); PG8_SCHED; PG8_LDA(At, 0, 0); PG8_STAGE(PG8_SA(1, 1), a1 + hstep, voffA);
            PG8_WAIT_L(8); PG8_BAR; PG8_WAIT_L(0); PG8_MMA(0, 0, At, B0); PG8_BAR; PG8_SCHED;
            PG8_LDB(B1, 0, 1); PG8_STAGE(PG8_SB(0, 0), b2, voffB);
            PG8_BAR; PG8_WAIT_L(0); PG8_MMA(0, 1, At, B1); PG8_BAR;
            PG8_LDA(At, 0, 1); PG8_STAGE(PG8_SA(0, 0), a2, voffA);
            PG8_BAR; PG8_WAIT_L(0); PG8_MMA(1, 0, At, B0); PG8_BAR; PG8_SCHED;
            PG8_STAGE(PG8_SB(0, 1), b2 + hstep, voffB);
            PG8_WAIT_V(6); PG8_BAR; PG8_MMA(1, 1, At, B1); PG8_BAR;
            PG8_LDB(B0, 1, 0); PG8_SCHED; PG8_LDA(At, 1, 0); PG8_STAGE(PG8_SA(0, 1), a2 + hstep, voffA);
            PG8_WAIT_L(8); PG8_BAR; PG8_WAIT_L(0); PG8_MMA(0, 0, At, B0); PG8_BAR; PG8_SCHED;
            PG8_LDB(B1, 1, 1); PG8_STAGE(PG8_SB(1, 0), b3, voffB);
            PG8_BAR; PG8_WAIT_L(0); PG8_MMA(0, 1, At, B1); PG8_BAR;
            PG8_LDA(At, 1, 1); PG8_STAGE(PG8_SA(1, 0), a3, voffA);
            PG8_BAR; PG8_WAIT_L(0); PG8_MMA(1, 0, At, B0); PG8_BAR; PG8_SCHED;
            PG8_STAGE(PG8_SB(1, 1), b3 + hstep, voffB);
            PG8_WAIT_V(6); PG8_BAR; PG8_MMA(1, 1, At, B1); PG8_BAR;
            }
        }
        if constexpr (ALIGN_EPI) { if (wr == 0) PG8_BAR; }
        if constexpr (!Epi::AFTER_DRAIN) { E(acc, cur, wr, wc, fr, fq); S.done(cur); }
        if (!has_next) break;
#pragma unroll
        for (int a = 0; a < 2; ++a)
#pragma unroll
            for (int b = 0; b < 2; ++b)
#pragma unroll
                for (int m = 0; m < 4; ++m)
#pragma unroll
                    for (int n = 0; n < 2; ++n) acc[a][b][m][n] = (f32x4){0.f, 0.f, 0.f, 0.f};
        cur = nxt; cA = nA; cB = nB; ++ui;
        if constexpr (ALIGN_EPI) { if (wr == 1) PG8_BAR; }
    }
    PG8_WAIT_V(0);
    if constexpr (!ALIGN_EPI) { if (wr == 0) PG8_BAR; }
    PG8_BAR;
#undef PG8_SA
#undef PG8_SB
#undef PG8_STAGE
#undef PG8_LDA
#undef PG8_LDB
#undef PG8_MMA
#undef PG8_WAIT_V
#undef PG8_WAIT_L
#undef PG8_BAR
#undef PG8_SCHED
}
}

namespace mla {
constexpr int NW = 8, QBLK = 32, KVBLK = 64;
constexpr float SCALE = 0.07216878364870322f;
constexpr float THR = 8.f;
constexpr int SHM_V = 64 * 128 * 2, SHM_K = 64 * 192 * 2, SHM_ATTN = 2 * SHM_V + 2 * SHM_K + NW * 64 * 4;
constexpr int LDQ = 1536, LDKK = 1536, LDV = 2048, LDO = 1024;
#define SBAR() __builtin_amdgcn_sched_barrier(0)
__device__ __forceinline__ int crow(int r, int hi) { return (r & 3) + 8 * (r >> 2) + 4 * hi; }
__device__ __forceinline__ void partialSM(f32x16& p0, f32x16& p1, float& m_reg, float& mn, float& alpha) {
  constexpr float C = SCALE * 1.4426950408889634f;
  float pmax = p0[0];
#pragma unroll
  for (int r = 1; r < 16; ++r) pmax = fmaxf(pmax, p0[r]);
#pragma unroll
  for (int r = 0; r < 16; ++r) pmax = fmaxf(pmax, p1[r]);
  { auto rr = __builtin_amdgcn_permlane32_swap(__float_as_uint(pmax), __float_as_uint(pmax), false, false);
    pmax = fmaxf(__uint_as_float(rr[0]), __uint_as_float(rr[1])); }
  if (__builtin_expect(__all(pmax - m_reg <= THR / SCALE), 1)) { mn = m_reg; alpha = 1.f; }
  else { mn = fmaxf(m_reg, pmax); alpha = __builtin_amdgcn_exp2f((m_reg - mn) * C); m_reg = mn; }
  float mnC = -mn * C;
#pragma unroll
  for (int r = 0; r < 16; ++r) p0[r] = fmaf(p0[r], C, mnC);
#pragma unroll
  for (int r = 0; r < 16; ++r) p1[r] = fmaf(p1[r], C, mnC);
#pragma unroll
  for (int r = 0; r < 16; ++r) p0[r] = __builtin_amdgcn_exp2f(p0[r]);
}
__device__ __forceinline__ void finishSM(f32x16& p0, f32x16& p1, float alpha, float& l_reg, bf16x8& pa0, bf16x8& pa1, bf16x8& pa2, bf16x8& pa3) {
#pragma unroll
  for (int r = 0; r < 16; ++r) p1[r] = __builtin_amdgcn_exp2f(p1[r]);
  float ps = 0;
#pragma unroll
  for (int r = 0; r < 16; ++r) ps += p0[r];
#pragma unroll
  for (int r = 0; r < 16; ++r) ps += p1[r];
  { auto rr = __builtin_amdgcn_permlane32_swap(__float_as_uint(ps), __float_as_uint(ps), false, false);
    ps = __uint_as_float(rr[0]) + __uint_as_float(rr[1]); }
  l_reg = l_reg * alpha + ps;
#define PK4(P, BASE, OUT) do { unsigned a0 = cvt_pk_bf16(P[BASE + 0], P[BASE + 1]), a1 = cvt_pk_bf16(P[BASE + 2], P[BASE + 3]);   \
    unsigned b0 = cvt_pk_bf16(P[BASE + 4], P[BASE + 5]), b1 = cvt_pk_bf16(P[BASE + 6], P[BASE + 7]);                              \
    auto r0 = __builtin_amdgcn_permlane32_swap(a0, b0, false, false); auto r1 = __builtin_amdgcn_permlane32_swap(a1, b1, false, false); \
    u32x4 w = {r0[0], r1[0], r0[1], r1[1]}; OUT = *reinterpret_cast<bf16x8*>(&w); } while (0)
  PK4(p0, 0, pa0); PK4(p0, 8, pa1); PK4(p1, 0, pa2); PK4(p1, 8, pa3);
#undef PK4
}
__device__ __forceinline__ void qkt(f32x16& p0, f32x16& p1, const char* Ks, const bf16x8* qr, const int* kb4) {
  p0 = f32x16{}; p1 = f32x16{};
#pragma unroll
  for (int d0 = 0; d0 < 12; ++d0) {
    bf16x8 b0 = *reinterpret_cast<const bf16x8*>(Ks + kb4[d0 & 3] + (d0 >> 2) * 128);
    bf16x8 b1 = *reinterpret_cast<const bf16x8*>(Ks + kb4[d0 & 3] + (d0 >> 2) * 128 + 32 * 384);
    p0 = __builtin_amdgcn_mfma_f32_32x32x16_bf16(b0, qr[d0], p0, 0, 0, 0);
    p1 = __builtin_amdgcn_mfma_f32_32x32x16_bf16(b1, qr[d0], p1, 0, 0, 0); }
}
__device__ __forceinline__ int v_st(int k, int c) { const int kk = (k & ~0xC) | ((k & 4) << 1) | ((k & 8) >> 1); return ((kk >> 3) * 4 + (c >> 5)) * 512 + ((kk & 7) * 32 + (c & 31)) * 2; }
__device__ __forceinline__ int v_rd_base(int lane) { return ((lane & 3) << 3) | (((lane >> 2) & 3) << 6) | (((lane >> 4) & 1) << 5) | (((lane >> 5) & 1) << 8); }
constexpr int v_rd_off(int d0, int ks, int half) { return d0 * 512 + ks * 4096 + half * 2048; }
template <int OFF> __device__ __forceinline__ s16x4 tr_read(int vb) {
  s16x4 r; asm volatile("ds_read_b64_tr_b16 %0, %1 offset:%2" : "=&v"(r) : "v"(vb), "i"(OFF) : "memory"); return r;
}
template <int D0> __device__ __forceinline__ void pv_one(f32x16& od, int vb, bf16x8 pa0, bf16x8 pa1, bf16x8 pa2, bf16x8 pa3) {
  const s16x4 l0 = tr_read<v_rd_off(D0, 0, 0)>(vb), h0 = tr_read<v_rd_off(D0, 0, 1)>(vb), l1 = tr_read<v_rd_off(D0, 1, 0)>(vb), h1 = tr_read<v_rd_off(D0, 1, 1)>(vb);
  const s16x4 l2 = tr_read<v_rd_off(D0, 2, 0)>(vb), h2 = tr_read<v_rd_off(D0, 2, 1)>(vb), l3 = tr_read<v_rd_off(D0, 3, 0)>(vb), h3 = tr_read<v_rd_off(D0, 3, 1)>(vb);
  asm volatile("s_waitcnt lgkmcnt(0)" ::: "memory"); SBAR();
#define PK(L, H) (bf16x8){L[0], L[1], L[2], L[3], H[0], H[1], H[2], H[3]}
  od = __builtin_amdgcn_mfma_f32_32x32x16_bf16(pa0, PK(l0, h0), od, 0, 0, 0);
  od = __builtin_amdgcn_mfma_f32_32x32x16_bf16(pa1, PK(l1, h1), od, 0, 0, 0);
  od = __builtin_amdgcn_mfma_f32_32x32x16_bf16(pa2, PK(l2, h2), od, 0, 0, 0);
  od = __builtin_amdgcn_mfma_f32_32x32x16_bf16(pa3, PK(l3, h3), od, 0, 0, 0);
#undef PK
}
__device__ __forceinline__ void pv_d0(f32x16* o, int vb, bf16x8 pa0, bf16x8 pa1, bf16x8 pa2, bf16x8 pa3) {
  pv_one<0>(o[0], vb, pa0, pa1, pa2, pa3); pv_one<1>(o[1], vb, pa0, pa1, pa2, pa3); pv_one<2>(o[2], vb, pa0, pa1, pa2, pa3); pv_one<3>(o[3], vb, pa0, pa1, pa2, pa3);
}

__device__ __forceinline__ void attn_unit(const bf16_t* __restrict__ Qb, const bf16_t* __restrict__ Kh, const bf16_t* __restrict__ Vh,
                                          bf16_t* __restrict__ Ob, int metaRow, int realRow0, char* lds, const int tid) {
  const int wid = tid >> 6, lane = tid & 63, r32 = lane & 31, hi = lane >> 5;
  char* V_lds = lds; char* K_lds = lds + 2 * SHM_V;
  float* ws = (float*)(lds + 2 * SHM_V + 2 * SHM_K) + wid * 64; float* li_l = ws; float* al_l = ws + 32;
  float m_reg = -1e30f, l_reg = 0; f32x16 o[4] = {}; bf16x8 qr[12];
  const bf16_t* Qw = Qb + (long)(wid * QBLK + r32) * LDQ + hi * 8;
#pragma unroll
  for (int d0 = 0; d0 < 12; ++d0) qr[d0] = *reinterpret_cast<const bf16x8*>(Qw + d0 * 16);
  const int sr = tid >> 3, vc = (tid & 7) * 8, vst0 = v_st(sr, vc);
  const int vgo0 = sr * LDV + vc;
  const int kgo0 = sr * LDKK + vc, klo0 = sr * 384 + ((vc * 2) ^ (((sr >> 1) & 7) << 4));
  int kb4[4];
#pragma unroll
  for (int q = 0; q < 4; ++q) kb4[q] = r32 * 384 + ((q * 32 + hi * 16) ^ (((r32 >> 1) & 7) << 4));
  const int vb0 = (int)(uintptr_t)V_lds + v_rd_base(lane);
  bf16x8 vs0, vs1, ks0, ks1, ks2;
#define TROW(t) ((t) == 0 ? (long)metaRow : (long)realRow0 + (long)((t) - 1) * KVBLK)
#define SLOAD(t) do { const long r0_ = TROW(t); const bf16_t* vp_ = Vh + r0_ * LDV + vgo0; const bf16_t* kp_ = Kh + r0_ * LDKK + kgo0; \
    vs0 = *reinterpret_cast<const bf16x8*>(vp_); vs1 = *reinterpret_cast<const bf16x8*>(vp_ + 64); \
    ks0 = *reinterpret_cast<const bf16x8*>(kp_); ks1 = *reinterpret_cast<const bf16x8*>(kp_ + 64); ks2 = *reinterpret_cast<const bf16x8*>(kp_ + 128); } while (0)
#define SWRITE(b) do { *(bf16x8*)(V_lds + (b) * SHM_V + vst0) = vs0; *(bf16x8*)(V_lds + (b) * SHM_V + vst0 + 1024) = vs1; \
    *(bf16x8*)(K_lds + (b) * SHM_K + klo0) = ks0; *(bf16x8*)(K_lds + (b) * SHM_K + klo0 + 128) = ks1; *(bf16x8*)(K_lds + (b) * SHM_K + klo0 + 256) = ks2; } while (0)
#define SWAIT() asm volatile("s_waitcnt vmcnt(0)" ::: "memory")
#define BARL() asm volatile("s_waitcnt lgkmcnt(0)\n\ts_barrier" ::: "memory")
#define RESC(a) do { if (__any((a) < 1.f)) { if (hi == 0) al_l[r32] = (a); asm volatile("s_waitcnt lgkmcnt(0)" ::: "memory"); \
    _Pragma("unroll") for (int d = 0; d < 4; ++d) _Pragma("unroll") for (int r = 0; r < 16; ++r) o[d][r] *= al_l[crow(r, hi)]; } } while (0)
  f32x16 pA0, pA1, pB0, pB1; float mnA, mnB, alA, alB; bf16x8 pa0, pa1, pa2, pa3; constexpr int NT = NCHUNK;
  SLOAD(0); SWAIT(); SWRITE(0); __syncthreads();
  qkt(pA0, pA1, K_lds, qr, kb4);
#pragma unroll
  for (int r = 8; r < 16; ++r) pA0[r] = -1e30f;
#pragma unroll
  for (int r = 0; r < 16; ++r) pA1[r] = -1e30f;
  partialSM(pA0, pA1, m_reg, mnA, alA);
  SLOAD(1); SWAIT(); SWRITE(1); SLOAD(2); BARL();
  for (int j = 1; j + 1 < NT; j += 2) {
    SBAR(); qkt(pB0, pB1, K_lds + SHM_K, qr, kb4);
    finishSM(pA0, pA1, alA, l_reg, pa0, pa1, pa2, pa3); SBAR();
    pv_d0(o, vb0, pa0, pa1, pa2, pa3); partialSM(pB0, pB1, m_reg, mnB, alB);
    BARL(); SWAIT(); SWRITE(0); if (j + 2 < NT) SLOAD(j + 2);
    RESC(alB); BARL();
    SBAR(); qkt(pA0, pA1, K_lds, qr, kb4);
    finishSM(pB0, pB1, alB, l_reg, pa0, pa1, pa2, pa3); SBAR();
    pv_d0(o, vb0 + (int)SHM_V, pa0, pa1, pa2, pa3); partialSM(pA0, pA1, m_reg, mnA, alA);
    BARL(); if (j + 2 < NT) { SWAIT(); SWRITE(1); } if (j + 3 < NT) SLOAD(j + 3);
    RESC(alA); BARL();
  }
  finishSM(pA0, pA1, alA, l_reg, pa0, pa1, pa2, pa3); SBAR();
  pv_d0(o, vb0, pa0, pa1, pa2, pa3);
  if (hi == 0) li_l[r32] = l_reg; asm volatile("s_waitcnt lgkmcnt(0)" ::: "memory");
  float rli[16];
#pragma unroll
  for (int r = 0; r < 16; ++r) rli[r] = __builtin_amdgcn_rcpf(li_l[crow(r, hi)]);
  bf16_t* Ow = Ob + (long)(wid * QBLK) * LDO;
#pragma unroll
  for (int r = 0; r < 16; ++r) { const int orow = crow(r, hi);
#pragma unroll
    for (int d0 = 0; d0 < 4; ++d0) Ow[(long)orow * LDO + d0 * 32 + r32] = f2bf(o[d0][r] * rli[r]); }
  __syncthreads();
#undef TROW
#undef SLOAD
#undef SWRITE
#undef SWAIT
#undef RESC
}


__device__ __forceinline__ void qkt2(f32x16& p0, f32x16& p1, const char* Ks, const bf16x8* qr, const int* kb4) {
#define KLD(d, half) (*reinterpret_cast<const bf16x8*>(Ks + kb4[(d) & 3] + ((d) >> 2) * 128 + (half) * 12288))
  p0 = f32x16{}; p1 = f32x16{};
  bf16x8 a0 = KLD(0, 0), b0 = KLD(0, 1), a1 = KLD(1, 0), b1 = KLD(1, 1), a2, b2;
#define QSTEP(d, A, B, NA, NB) do { if ((d) + 2 < 12) { NA = KLD((d) + 2, 0); NB = KLD((d) + 2, 1); } SBAR(); \
    p0 = __builtin_amdgcn_mfma_f32_32x32x16_bf16(A, qr[d], p0, 0, 0, 0); p1 = __builtin_amdgcn_mfma_f32_32x32x16_bf16(B, qr[d], p1, 0, 0, 0); SBAR(); } while (0)
  QSTEP(0, a0, b0, a2, b2); QSTEP(1, a1, b1, a0, b0); QSTEP(2, a2, b2, a1, b1);
  QSTEP(3, a0, b0, a2, b2); QSTEP(4, a1, b1, a0, b0); QSTEP(5, a2, b2, a1, b1);
  QSTEP(6, a0, b0, a2, b2); QSTEP(7, a1, b1, a0, b0); QSTEP(8, a2, b2, a1, b1);
  QSTEP(9, a0, b0, a2, b2); QSTEP(10, a1, b1, a0, b0); QSTEP(11, a2, b2, a1, b1);
#undef QSTEP
#undef KLD
}
struct VSet { s16x4 l0, h0, l1, h1, l2, h2, l3, h3; };
template <int D0> __device__ __forceinline__ void v_issue(VSet& s, int vb) {
  s.l0 = tr_read<v_rd_off(D0, 0, 0)>(vb); s.h0 = tr_read<v_rd_off(D0, 0, 1)>(vb); s.l1 = tr_read<v_rd_off(D0, 1, 0)>(vb); s.h1 = tr_read<v_rd_off(D0, 1, 1)>(vb);
  s.l2 = tr_read<v_rd_off(D0, 2, 0)>(vb); s.h2 = tr_read<v_rd_off(D0, 2, 1)>(vb); s.l3 = tr_read<v_rd_off(D0, 3, 0)>(vb); s.h3 = tr_read<v_rd_off(D0, 3, 1)>(vb);
}
__device__ __forceinline__ void v_mma(f32x16& od, VSet& s, bf16x8 pa0, bf16x8 pa1, bf16x8 pa2, bf16x8 pa3) {
  asm volatile("" : "+v"(s.l0), "+v"(s.h0), "+v"(s.l1), "+v"(s.h1), "+v"(s.l2), "+v"(s.h2), "+v"(s.l3), "+v"(s.h3));
#define PK(L, H) (bf16x8){L[0], L[1], L[2], L[3], H[0], H[1], H[2], H[3]}
  od = __builtin_amdgcn_mfma_f32_32x32x16_bf16(pa0, PK(s.l0, s.h0), od, 0, 0, 0);
  od = __builtin_amdgcn_mfma_f32_32x32x16_bf16(pa1, PK(s.l1, s.h1), od, 0, 0, 0);
  od = __builtin_amdgcn_mfma_f32_32x32x16_bf16(pa2, PK(s.l2, s.h2), od, 0, 0, 0);
  od = __builtin_amdgcn_mfma_f32_32x32x16_bf16(pa3, PK(s.l3, s.h3), od, 0, 0, 0);
#undef PK
}
__device__ __forceinline__ void pv2(f32x16* o, int vb, bf16x8 pa0, bf16x8 pa1, bf16x8 pa2, bf16x8 pa3) {
  VSet X, Y;
  SBAR(); v_issue<0>(X, vb); v_issue<1>(Y, vb);
  asm volatile("s_waitcnt lgkmcnt(8)" ::: "memory"); SBAR(); v_mma(o[0], X, pa0, pa1, pa2, pa3); SBAR();
  v_issue<2>(X, vb);
  asm volatile("s_waitcnt lgkmcnt(8)" ::: "memory"); SBAR(); v_mma(o[1], Y, pa0, pa1, pa2, pa3); SBAR();
  v_issue<3>(Y, vb);
  asm volatile("s_waitcnt lgkmcnt(8)" ::: "memory"); SBAR(); v_mma(o[2], X, pa0, pa1, pa2, pa3); SBAR();
  asm volatile("s_waitcnt lgkmcnt(0)" ::: "memory"); SBAR(); v_mma(o[3], Y, pa0, pa1, pa2, pa3); SBAR();
}
__device__ __forceinline__ void attn_unit2(const bf16_t* __restrict__ Qb, const bf16_t* __restrict__ Kh, const bf16_t* __restrict__ Vh,
                                           bf16_t* __restrict__ Ob, int metaRow, int realRow0, char* lds, const int tid) {
  const int wid = __builtin_amdgcn_readfirstlane(tid >> 6), lane = tid & 63, r32 = lane & 31, hi = lane >> 5;
  char* V_lds = lds; char* K_lds = lds + 2 * SHM_V;
  float* ws = (float*)(lds + 2 * SHM_V + 2 * SHM_K) + wid * 64; float* li_l = ws; float* al_l = ws + 32;
  float m_reg = -1e30f, l_reg = 0; f32x16 o[4] = {}; bf16x8 qr[12];
  const bf16_t* Qw = Qb + (long)(wid * QBLK + r32) * LDQ + hi * 8;
#pragma unroll
  for (int d0 = 0; d0 < 12; ++d0) qr[d0] = *reinterpret_cast<const bf16x8*>(Qw + d0 * 16);
  const int sr = tid >> 3, vc = (tid & 7) * 8, vst0 = v_st(sr, vc);
  const int vgo0 = sr * LDV + vc;
  const int kgo0 = sr * LDKK + vc, klo0 = sr * 384 + ((vc * 2) ^ (((sr >> 1) & 7) << 4));
  int kb4[4];
#pragma unroll
  for (int q = 0; q < 4; ++q) kb4[q] = r32 * 384 + ((q * 32 + hi * 16) ^ (((r32 >> 1) & 7) << 4));
  const int vb0 = (int)(uintptr_t)V_lds + v_rd_base(lane);
  bf16x8 vs0, vs1, ks0, ks1, ks2;
#define TROW(t) ((t) == 0 ? (long)metaRow : (long)realRow0 + (long)((t) - 1) * KVBLK)
#define SLOAD(t) do { const long r0_ = TROW(t); const bf16_t* vp_ = Vh + r0_ * LDV + vgo0; const bf16_t* kp_ = Kh + r0_ * LDKK + kgo0; \
    vs0 = *reinterpret_cast<const bf16x8*>(vp_); vs1 = *reinterpret_cast<const bf16x8*>(vp_ + 64); \
    ks0 = *reinterpret_cast<const bf16x8*>(kp_); ks1 = *reinterpret_cast<const bf16x8*>(kp_ + 64); ks2 = *reinterpret_cast<const bf16x8*>(kp_ + 128); } while (0)
#define SWRITE(b) do { *(bf16x8*)(V_lds + (b) * SHM_V + vst0) = vs0; *(bf16x8*)(V_lds + (b) * SHM_V + vst0 + 1024) = vs1; \
    *(bf16x8*)(K_lds + (b) * SHM_K + klo0) = ks0; *(bf16x8*)(K_lds + (b) * SHM_K + klo0 + 128) = ks1; *(bf16x8*)(K_lds + (b) * SHM_K + klo0 + 256) = ks2; } while (0)
#define SWAIT() asm volatile("s_waitcnt vmcnt(0)" ::: "memory")
#define BARRIER() asm volatile("s_waitcnt lgkmcnt(0)\n\ts_barrier" ::: "memory")
#define RESC(a) do { if (__any((a) < 1.f)) { if (hi == 0) al_l[r32] = (a); asm volatile("s_waitcnt lgkmcnt(0)" ::: "memory"); \
    _Pragma("unroll") for (int d = 0; d < 4; ++d) _Pragma("unroll") for (int r = 0; r < 16; ++r) o[d][r] *= al_l[crow(r, hi)]; } } while (0)
#define MASK0() do { _Pragma("unroll") for (int r = 8; r < 16; ++r) p0[r] = -1e30f; _Pragma("unroll") for (int r = 0; r < 16; ++r) p1[r] = -1e30f; } while (0)
  f32x16 p0, p1; float mn, al = 1.f; bf16x8 pa0, pa1, pa2, pa3; constexpr int NT = NCHUNK;
  SLOAD(0); SWAIT(); SWRITE(0); BARRIER();
#define S1(t, CUR) do { SBAR(); qkt2(p0, p1, K_lds + (CUR) * SHM_K, qr, kb4); if ((t) == 0) MASK0(); partialSM(p0, p1, m_reg, mn, al); } while (0)
#define S2(t, CUR) do { RESC(al); finishSM(p0, p1, al, l_reg, pa0, pa1, pa2, pa3); SBAR(); pv2(o, vb0 + (CUR) * (int)SHM_V, pa0, pa1, pa2, pa3); } while (0)
  if (wid < 4) {
#define A_TILE(t, CUR) do { S1(t, CUR); BARRIER(); \
      if ((t) + 1 < NT) { SWAIT(); SWRITE((CUR) ^ 1); if ((t) + 2 < NT) SLOAD((t) + 2); } S2(t, CUR); BARRIER(); } while (0)
    SLOAD(1);
    for (int t = 0; t + 1 < NT; t += 2) { A_TILE(t, 0); A_TILE(t + 1, 1); }
    A_TILE(NT - 1, 0);
    BARRIER();
#undef A_TILE
  } else {
    SLOAD(1); BARRIER();
#define B_TILE(t, CUR) do { if ((t) + 1 < NT) { SWAIT(); SWRITE((CUR) ^ 1); if ((t) + 2 < NT) SLOAD((t) + 2); } S1(t, CUR); BARRIER(); \
      S2(t, CUR); BARRIER(); } while (0)
    for (int t = 0; t + 1 < NT; t += 2) { B_TILE(t, 0); B_TILE(t + 1, 1); }
    B_TILE(NT - 1, 0);
#undef B_TILE
  }
  if (hi == 0) li_l[r32] = l_reg; asm volatile("s_waitcnt lgkmcnt(0)" ::: "memory");
  float rli[16];
#pragma unroll
  for (int r = 0; r < 16; ++r) rli[r] = __builtin_amdgcn_rcpf(li_l[crow(r, hi)]);
  bf16_t* Ow = Ob + (long)(wid * QBLK) * LDO;
#pragma unroll
  for (int r = 0; r < 16; ++r) { const int orow = crow(r, hi);
#pragma unroll
    for (int d0 = 0; d0 < 4; ++d0) Ow[(long)orow * LDO + d0 * 32 + r32] = f2bf(o[d0][r] * rli[r]); }
  __syncthreads();
#undef TROW
#undef SLOAD
#undef SWRITE
#undef SWAIT
#undef BARRIER
#undef RESC
#undef MASK0
#undef S1
#undef S2
}
#undef SBAR
}


#define XB_TMO      128
#define XB_XCNT(j)  (256  + 64 * (j))
#define XB_XSUB(j)  (1280 + 64 * (j))
#define XB_XGEN(j)  (2304 + 64 * (j))
#define XB_TOP      3328
#define XB_TOPGEN   3392
#define XCD_BAR_WORDS 3456
#define XB_SPIN_CAP (1u << 18)
__device__ __forceinline__ unsigned xb_ld(unsigned* p)              { return __hip_atomic_load(p, __ATOMIC_RELAXED, __HIP_MEMORY_SCOPE_AGENT); }
__device__ __forceinline__ unsigned xb_add(unsigned* p, unsigned v) { return __hip_atomic_fetch_add(p, v, __ATOMIC_RELAXED, __HIP_MEMORY_SCOPE_AGENT); }
__device__ __forceinline__ unsigned xb_xcc_id() { return (unsigned)__builtin_amdgcn_s_getreg((3 << 11) | 20) & 0xFu; }
#define XB_SPIN(cond, bar) do { unsigned _sp = 0; while (cond) { __builtin_amdgcn_s_sleep(1); \
    if ((++_sp & 255u) == 0u) { if (xb_ld(&(bar)[XB_TMO])) break; if (_sp > XB_SPIN_CAP) { atomicAdd(&(bar)[XB_TMO], 1u); break; } } } } while (0)
struct XcdBarrier { unsigned* bar; unsigned x; volatile LAS unsigned* st; };
__device__ __forceinline__ XcdBarrier xcd_barrier_post(unsigned* bar, volatile LAS unsigned* st) {
    XcdBarrier b; b.bar = bar; b.x = xb_xcc_id(); b.st = st;
    if (threadIdx.x == 0) (void)xb_add(&bar[XB_XCNT(b.x)], 1u);
    return b;
}
__device__ __forceinline__ void xcd_barrier_complete(unsigned* bar, unsigned x, unsigned& nloc, unsigned& nx) {
    const unsigned G = gridDim.x * gridDim.y * gridDim.z;
    unsigned sum, cnt, mine, sp = 0u;
    for (;;) {
        sum = 0u; cnt = 0u; mine = 0u;
#pragma unroll
        for (unsigned j = 0; j < 16; ++j) { const unsigned c = xb_ld(&bar[XB_XCNT(j)]); sum += c; cnt += (c > 0u) ? 1u : 0u; mine = (j == x) ? c : mine; }
        if (sum == G) break;
        __builtin_amdgcn_s_sleep(1);
        if ((++sp & 255u) == 0u) { if (xb_ld(&bar[XB_TMO])) break; if (sp > XB_SPIN_CAP) { atomicAdd(&bar[XB_TMO], 1u); break; } }
    }
    nloc = mine > 0u ? mine : 1u; nx = cnt > 0u ? cnt : 1u;
}
__device__ __forceinline__ void xcd_barrier(const XcdBarrier& b) {
    asm volatile("s_waitcnt vmcnt(0)" ::: "memory");
    __syncthreads();
    if (threadIdx.x == 0) {
        unsigned* bar = b.bar;
        __builtin_amdgcn_s_waitcnt(0);
        unsigned nloc = b.st[0], nx = b.st[1];
        if (nloc == 0u) { xcd_barrier_complete(bar, b.x, nloc, nx); b.st[0] = nloc; b.st[1] = nx; }
        const unsigned old = xb_add(&bar[XB_XSUB(b.x)], 1u);
        const unsigned gen = old / nloc;
        if (old + 1u == (gen + 1u) * nloc) {
            __builtin_amdgcn_fence(__ATOMIC_RELEASE, "agent");
            asm volatile("s_waitcnt vmcnt(0)" ::: "memory");
            const unsigned og = xb_add(&bar[XB_TOP], 1u);
            const unsigned tg = og / nx;
            if (og + 1u == (tg + 1u) * nx) xb_add(&bar[XB_TOPGEN], 1u);
            else XB_SPIN(xb_ld(&bar[XB_TOPGEN]) == tg, bar);
            __builtin_amdgcn_fence(__ATOMIC_ACQUIRE, "agent");
            xb_add(&bar[XB_XGEN(b.x)], 1u);
            asm volatile("s_waitcnt vmcnt(0)" ::: "memory");
        } else {
            XB_SPIN(xb_ld(&bar[XB_XGEN(b.x)]) == gen, bar);
            __builtin_amdgcn_fence(__ATOMIC_ACQUIRE, "agent");
            asm volatile("s_waitcnt vmcnt(0)" ::: "memory");
        }
    }
    __syncthreads();
}

struct Args {
    const float *x, *meta, *mix_g, *w_in, *na_q_g, *na_k_g, *rpb, *meta_bias, *cq_g, *ckv_g, *w_q_up, *w_kv_up, *mq_g, *mk_g, *na_out_g, *mla_out_g, *w_out, *ffn_g, *w_gate, *w_up, *conv_w, *conv_b, *w_down;
    float* out; unsigned char* ws;
};
constexpr int LDS_BYTES = 135168;

__device__ __forceinline__ void tr_item(const float* __restrict__ W, int ldw, int c0, int ncb, int K, bf16_t* __restrict__ WT, int row_off, LAS float* scr, int item, int lane, const float* __restrict__ kgain = nullptr) {
    const int kb = item / ncb, nb = item % ncb, k0 = 64 * kb, n0 = 32 * nb;
    float tv[32];
#pragma unroll
    for (int i = 0; i < 32; ++i) { const int kk = 2 * i + (lane >> 5); tv[i] = W[(size_t)(k0 + kk) * ldw + c0 + n0 + (lane & 31)]; }
    if (kgain) {
#pragma unroll
        for (int i = 0; i < 32; ++i) { const int kk = 2 * i + (lane >> 5); tv[i] *= kgain[k0 + kk]; } }
#pragma unroll
    for (int i = 0; i < 32; ++i) { const int kk = 2 * i + (lane >> 5); scr[kk * 33 + (lane & 31)] = tv[i]; }
    asm volatile("s_waitcnt lgkmcnt(0)" ::: "memory");
    const int c = lane & 7;
#pragma unroll
    for (int j = 0; j < 4; ++j) { const int n = (lane >> 3) + 8 * j; const LAS float* s = scr + (8 * c) * 33 + n;
        u32x4 o; o.x = cvt_pk_bf16(s[0 * 33], s[1 * 33]); o.y = cvt_pk_bf16(s[2 * 33], s[3 * 33]); o.z = cvt_pk_bf16(s[4 * 33], s[5 * 33]); o.w = cvt_pk_bf16(s[6 * 33], s[7 * 33]);
        *(u32x4*)(WT + (size_t)(row_off + n0 + n) * K + k0 + 8 * c) = o; }
    asm volatile("s_waitcnt lgkmcnt(0)" ::: "memory");
}

__device__ __forceinline__ void rms_row_f32(const float* __restrict__ src, const float* __restrict__ gain, bf16_t* __restrict__ dst, int lane) {
    f32x4 v[8]; float s = 0.f;
#pragma unroll
    for (int j = 0; j < 8; ++j) { v[j] = *(const f32x4*)(src + 4 * lane + 256 * j); s += (v[j].x * v[j].x + v[j].y * v[j].y) + (v[j].z * v[j].z + v[j].w * v[j].w); }
    const float rs = __builtin_amdgcn_rsqf(wave_sum(s) * (1.f / DM) + EPS);
#pragma unroll
    for (int j = 0; j < 8; ++j) { const f32x4 g = *(const f32x4*)(gain + 4 * lane + 256 * j); u32x2 w; w.x = cvt_pk_bf16(v[j].x * rs * g.x, v[j].y * rs * g.y); w.y = cvt_pk_bf16(v[j].z * rs * g.z, v[j].w * rs * g.w);
        *(u32x2*)(dst + 4 * lane + 256 * j) = w; }
}

__device__ __forceinline__ void na_norm_q(bf16x8 (&qf)[4], const float* __restrict__ gq, int g) {
    float f[4][8]; float ss = 0.f;
#pragma unroll
    for (int ds = 0; ds < 4; ++ds) { const u32x4 v = __builtin_bit_cast(u32x4, qf[ds]);
        f[ds][0] = bflo(v.x); f[ds][1] = bfhi(v.x); f[ds][2] = bflo(v.y); f[ds][3] = bfhi(v.y); f[ds][4] = bflo(v.z); f[ds][5] = bfhi(v.z); f[ds][6] = bflo(v.w); f[ds][7] = bfhi(v.w);
#pragma unroll
        for (int e = 0; e < 8; ++e) ss += f[ds][e] * f[ds][e]; }
    ss += __shfl_xor(ss, 16); ss += __shfl_xor(ss, 32);
    const float rs = __builtin_amdgcn_rsqf(ss * (1.f / 128.f) + EPS);
#pragma unroll
    for (int ds = 0; ds < 4; ++ds) { const f32x4 g0 = *(const f32x4*)(gq + 32 * ds + 8 * g), g1 = *(const f32x4*)(gq + 32 * ds + 8 * g + 4);
        u32x4 w; w.x = cvt_pk_bf16(f[ds][0] * rs * g0.x, f[ds][1] * rs * g0.y); w.y = cvt_pk_bf16(f[ds][2] * rs * g0.z, f[ds][3] * rs * g0.w);
        w.z = cvt_pk_bf16(f[ds][4] * rs * g1.x, f[ds][5] * rs * g1.y); w.w = cvt_pk_bf16(f[ds][6] * rs * g1.z, f[ds][7] * rs * g1.w);
        qf[ds] = __builtin_bit_cast(bf16x8, w); }
}

__global__ void __launch_bounds__(512, 2) fwd_kernel(Args P) {
    extern __shared__ __attribute__((aligned(16))) unsigned char lds[];
    cg::grid_group grid = cg::this_grid();
    volatile LAS unsigned* bst = (volatile LAS unsigned*)((LAS unsigned char*)lds + 131072 + 64);
    if (threadIdx.x < 2) bst[threadIdx.x] = 0u;
    __syncthreads();
    const XcdBarrier xbar = xcd_barrier_post((unsigned*)P.ws, bst);
    const int wid0 = __builtin_amdgcn_readfirstlane((int)threadIdx.x >> 6);
    const int G = gridDim.x, NGW = G * 8;
#define CAS __attribute__((address_space(4)))
#define PH_BEGIN const CAS Args* pa_ = (const CAS Args*)__builtin_amdgcn_kernarg_segment_ptr(); asm volatile("" : "+s"(pa_)); const CAS Args& P = *pa_; (void)P;   \
    int tid; asm volatile("v_mbcnt_lo_u32_b32 %0, -1, 0\n\tv_mbcnt_hi_u32_b32 %0, -1, %0" : "=v"(tid)); tid += wid0 * 64;     const int lane = tid & 63, wid = __builtin_amdgcn_readfirstlane(tid >> 6), gw = blockIdx.x * 8 + wid; (void)lane; (void)gw;
    unsigned char* ws = P.ws;
        bf16_t* W1T = (bf16_t*)(ws + WS_W1T); bf16_t* WVT = (bf16_t*)(ws + WS_WVT); bf16_t* WQT = (bf16_t*)(ws + WS_WQT); bf16_t* WKVT = (bf16_t*)(ws + WS_WKVT);
        bf16_t* WOT = (bf16_t*)(ws + WS_WOT); bf16_t* WGT = (bf16_t*)(ws + WS_WGT); bf16_t* WUT = (bf16_t*)(ws + WS_WUT); bf16_t* WDT = (bf16_t*)(ws + WS_WDT);
        bf16_t* HN = (bf16_t*)(ws + WS_HN); bf16_t* PROJ = (bf16_t*)(ws + WS_PROJ); bf16_t* VT = (bf16_t*)(ws + WS_VT); bf16_t* CQN = (bf16_t*)(ws + WS_CQN); bf16_t* CKVN = (bf16_t*)(ws + WS_CKVN);
        bf16_t* QRAW = (bf16_t*)(ws + WS_QRAW); bf16_t* KV = (bf16_t*)(ws + WS_KV); bf16_t* OUTA = (bf16_t*)(ws + WS_OUTA); bf16_t* OUTB = (bf16_t*)(ws + WS_OUTB);
        bf16_t* QP = (bf16_t*)(ws + WS_QP); bf16_t* KP = (bf16_t*)(ws + WS_KP); bf16_t* MIX = (bf16_t*)(ws + WS_MIX); bf16_t* HN2 = (bf16_t*)(ws + WS_HN2);
        bf16_t* GB = (bf16_t*)(ws + WS_G); bf16_t* ACT = (bf16_t*)(ws + WS_ACT);
        float* TAB = (float*)(ws + WS_TAB); float* PART = (float*)(ws + WS_PART);
        float* OA15 = (float*)(ws + WS_SMALL + SM_OA15); float* MIX15 = (float*)(ws + WS_SMALL + SM_MIX15); float* H115 = (float*)(ws + WS_SMALL + SM_H115);
        float* HN215 = (float*)(ws + WS_SMALL + SM_HN215); float* G15 = (float*)(ws + WS_SMALL + SM_G15); float* SSQ = (float*)(ws + WS_SMALL + SM_SSQ); (void)HN215;

        { PH_BEGIN
            LAS float* scr = (LAS float*)((LAS unsigned char*)lds + wid * 16384);
            constexpr int I1 = 32 * 64, I2 = 32 * 32, I3 = 32 * 26, I4 = 8 * 48, I5 = 4 * 64, I6 = 32 * 64, I7 = 32 * 176, I8 = 32 * 176, I9 = 88 * 64;
            constexpr int NIT = I1 + I2 + I3 + I4 + I5 + I6 + I7 + I8 + I9;
            for (int it = gw; it < NIT; it += NGW) {
                int r = it;
                if (r < I1) { tr_item(P.w_in, INC, 0, 64, DM, W1T, 0, scr, r, lane); continue; } r -= I1;
                if (r < I2) { tr_item(P.w_in, INC, 2048, 32, DM, WVT, 0, scr, r, lane); continue; } r -= I2;
                if (r < I3) { tr_item(P.w_in, INC, 3072, 26, DM, W1T, 2048, scr, r, lane); continue; } r -= I3;
                if (r < I4) { tr_item(P.w_q_up, 1536, 0, 48, 512, WQT, 0, scr, r, lane); continue; } r -= I4;
                if (r < I5) { tr_item(P.w_kv_up, 2048, 0, 64, 256, WKVT, 0, scr, r, lane); continue; } r -= I5;
                if (r < I6) { tr_item(P.w_out, DM, 0, 64, DM, WOT, 0, scr, r, lane); continue; } r -= I6;
                if (r < I7) { tr_item(P.w_gate, DFF, 0, 176, DM, WGT, 0, scr, r, lane, P.ffn_g); continue; } r -= I7;
                if (r < I8) { tr_item(P.w_up, DFF, 0, 176, DM, WUT, 0, scr, r, lane, P.ffn_g); continue; } r -= I8;
                tr_item(P.w_down, DM, 0, 64, DFF, WDT, 0, scr, r, lane);
            }
            for (int i = blockIdx.x * 512 + tid; i < NREAL; i += G * 512) SSQ[i] = 0.f;
            { const u32x4 z = {0u, 0u, 0u, 0u};
              for (size_t i = (size_t)blockIdx.x * 512 + tid; i < (size_t)192 * DM / 8; i += (size_t)G * 512) *(u32x4*)(W1T + (size_t)2880 * DM + i * 8) = z;
              for (size_t i = (size_t)blockIdx.x * 512 + tid; i < (size_t)(MP - 32800) * DM / 8; i += (size_t)G * 512) *(u32x4*)(HN + (size_t)32800 * DM + i * 8) = z; }
            for (int row = gw; row < 32800; row += NGW) {
                const float* src = row < NREAL ? P.x + (size_t)row * DM : P.meta + (size_t)((row - MROW0) & 15) * DM;
                rms_row_f32(src, P.mix_g, HN + (size_t)row * DM, lane);
            }
            for (int e = blockIdx.x * 512 + tid; e < LTOT * 32; e += G * 512) {
                const int pos = e >> 5, i = e & 31;
                const double inv = exp2(-(double)i * (13.287712379549449 / 32.0));
                const float a = (float)pos * (float)inv;
                double rev = (double)a * 0.15915494309189535; rev -= rint(rev);
                const float fr = (float)rev;
                TAB[2 * e] = __builtin_amdgcn_cosf(fr); TAB[2 * e + 1] = __builtin_amdgcn_sinf(fr);
            }
        }
        grid.sync();
        { PH_BEGIN pg8::Gemm g = pg8::Gemm{HN, W1T, MP, PJ, DM}; pg8::EpiBf16 E = pg8::EpiBf16{PROJ, PJ, nullptr}; pg8::StaticOrder S; S.init(g.M, g.N, G, (int)blockIdx.x);
          pg8::gemm_phase<pg8::EpiBf16, pg8::StaticOrder, true, true>((LAS unsigned char*)lds, g, S, E, tid); }
        { PH_BEGIN pg8::Gemm g = pg8::Gemm{WVT, HN, 1024, MP, DM}; pg8::EpiBf16 E = pg8::EpiBf16{VT, MP, nullptr}; pg8::StaticOrder S; S.init(g.M, g.N, G, (int)((blockIdx.x + G / 2) % G));
          pg8::gemm_phase<pg8::EpiBf16, pg8::StaticOrder, true, true>((LAS unsigned char*)lds, g, S, E, tid); }
        xcd_barrier(xbar);
        { PH_BEGIN
            for (int row = gw; row < MP; row += NGW) {
                bf16_t* pr = PROJ + (size_t)row * PJ;
#pragma unroll
                for (int i = 2; i < 4; ++i) {
                    const u32x4 v = *(const u32x4*)(pr + 512 * i + 8 * lane);
                    float f0 = bflo(v.x), f1 = bfhi(v.x), f2 = bflo(v.y), f3 = bfhi(v.y), f4 = bflo(v.z), f5 = bfhi(v.z), f6 = bflo(v.w), f7 = bfhi(v.w);
                    float ss = f0 * f0 + f1 * f1 + f2 * f2 + f3 * f3 + f4 * f4 + f5 * f5 + f6 * f6 + f7 * f7;
                    ss += __shfl_xor(ss, 1); ss += __shfl_xor(ss, 2); ss += __shfl_xor(ss, 4); ss += __shfl_xor(ss, 8);
                    const float rs = __builtin_amdgcn_rsqf(ss * (1.f / 128.f) + EPS);
                    const float* gp = (i < 2 ? P.na_q_g : P.na_k_g) + ((8 * lane) & 127);
                    const f32x4 g0 = *(const f32x4*)gp, g1 = *(const f32x4*)(gp + 4);
                    u32x4 w; w.x = cvt_pk_bf16(f0 * rs * g0.x, f1 * rs * g0.y); w.y = cvt_pk_bf16(f2 * rs * g0.z, f3 * rs * g0.w); w.z = cvt_pk_bf16(f4 * rs * g1.x, f5 * rs * g1.y); w.w = cvt_pk_bf16(f6 * rs * g1.z, f7 * rs * g1.w);
                    *(u32x4*)(pr + 512 * i + 8 * lane) = w;
                }
                {
                    const u32x4 v = *(const u32x4*)(pr + 2048 + 8 * lane);
                    float f0 = bflo(v.x), f1 = bfhi(v.x), f2 = bflo(v.y), f3 = bfhi(v.y), f4 = bflo(v.z), f5 = bfhi(v.z), f6 = bflo(v.w), f7 = bfhi(v.w);
                    const float ss = wave_sum(f0 * f0 + f1 * f1 + f2 * f2 + f3 * f3 + f4 * f4 + f5 * f5 + f6 * f6 + f7 * f7);
                    const float rs = __builtin_amdgcn_rsqf(ss * (1.f / 512.f) + EPS);
                    const float* gp = P.cq_g + 8 * lane; const f32x4 g0 = *(const f32x4*)gp, g1 = *(const f32x4*)(gp + 4);
                    u32x4 w; w.x = cvt_pk_bf16(f0 * rs * g0.x, f1 * rs * g0.y); w.y = cvt_pk_bf16(f2 * rs * g0.z, f3 * rs * g0.w); w.z = cvt_pk_bf16(f4 * rs * g1.x, f5 * rs * g1.y); w.w = cvt_pk_bf16(f6 * rs * g1.z, f7 * rs * g1.w);
                    *(u32x4*)(CQN + (size_t)row * 512 + 8 * lane) = w;
                }
                {
                    const u32x4 v = *(const u32x4*)(pr + 2560 + 8 * lane);
                    float f0 = bflo(v.x), f1 = bfhi(v.x), f2 = bflo(v.y), f3 = bfhi(v.y), f4 = bflo(v.z), f5 = bfhi(v.z), f6 = bflo(v.w), f7 = bfhi(v.w);
                    float ss = f0 * f0 + f1 * f1 + f2 * f2 + f3 * f3 + f4 * f4 + f5 * f5 + f6 * f6 + f7 * f7;
                    ss += __shfl_xor(ss, 1); ss += __shfl_xor(ss, 2); ss += __shfl_xor(ss, 4); ss += __shfl_xor(ss, 8); ss += __shfl_xor(ss, 16);
                    const float rs = __builtin_amdgcn_rsqf(ss * (1.f / 256.f) + EPS);
                    const float* gp = P.ckv_g + ((8 * lane) & 255); const f32x4 g0 = *(const f32x4*)gp, g1 = *(const f32x4*)(gp + 4);
                    u32x4 w; w.x = cvt_pk_bf16(f0 * rs * g0.x, f1 * rs * g0.y); w.y = cvt_pk_bf16(f2 * rs * g0.z, f3 * rs * g0.w); w.z = cvt_pk_bf16(f4 * rs * g1.x, f5 * rs * g1.y); w.w = cvt_pk_bf16(f6 * rs * g1.z, f7 * rs * g1.w);
                    if (lane < 32) *(u32x4*)(CKVN + (size_t)row * 256 + 8 * lane) = w;
                }
            }
        }
        xcd_barrier(xbar);
        { PH_BEGIN pg8::Gemm g = pg8::Gemm{CQN, WQT, MP, 1536, 512}; pg8::EpiBf16 E = pg8::EpiBf16{QRAW, 1536, nullptr}; pg8::StaticOrder S; S.init(g.M, g.N, G, (int)blockIdx.x);
          pg8::gemm_phase<pg8::EpiBf16, pg8::StaticOrder, true, true>((LAS unsigned char*)lds, g, S, E, tid); }
        { PH_BEGIN pg8::Gemm g = pg8::Gemm{CKVN, WKVT, MP, 2048, 256}; pg8::EpiBf16 E = pg8::EpiBf16{KV, 2048, nullptr}; pg8::StaticOrder S; S.init(g.M, g.N, G, (int)((blockIdx.x + G / 2) % G));
          pg8::gemm_phase<pg8::EpiBf16, pg8::StaticOrder, true, true>((LAS unsigned char*)lds, g, S, E, tid); }
        { PH_BEGIN
            const int ql = lane & 15, g = lane >> 4, rsel = wid >> 2, j = wid & 3;
            float* rp = (float*)lds + wid * 512;
            char* stg = (char*)lds + 16384;
            int hcur = -1;
            const int xcd = (int)blockIdx.x & 7, cblk = (int)blockIdx.x >> 3;
            const int ktok = tid >> 4, kc = tid & 15, klds = ktok * 256 + 16 * (kc ^ ((((ktok >> 3) & 3) << 2) | (ktok & 3)));
            const int vd = tid >> 3, vc = tid & 7, vlds = vd * 128 + 16 * (vc ^ ((vd >> 1) & 7));
            const int kb = min(max(16 * j - 8, 0), 32);
            const int xh = ((kb >> 3) + (ql >> 2)) & 3, xl = ql & 3;
            const int kbase = (kb + 8 * (ql >> 2) + (ql & 3)) * 256 + 16 * (g ^ xl);
            const int kofs0 = kbase + 64 * (0 ^ xh), kofs1 = kbase + 64 * (1 ^ xh), kofs2 = kbase + 64 * (2 ^ xh), kofs3 = kbase + 64 * (3 ^ xh);
            const int vofs = ql * 128 + 16 * (((kb >> 3) + g) ^ (ql >> 1));
            for (int k = 0;; ++k) {
                int combo, rpair;
                if (G == 256) { if (k >= 8) break; const int lin = k * 32 + cblk; combo = xcd * 2 + (lin >> 7); rpair = lin & 127; }
                else { const int bi = (int)blockIdx.x + k * G; if (bi >= 2048) break; combo = bi >> 7; rpair = bi & 127; }
                const int h = combo & 7, b = combo >> 3, r0 = 2 * rpair, r = r0 + rsel;
                if (h != hcur) { for (int i = lane; i < 465; i += 64) rp[i] = P.rpb[h * 465 + i]; hcur = h; }
                const int u0 = min(max(r0 - 4, 0), 248), rs = min(max(r - 4, 0), 248);
                const size_t tokb = (size_t)b * SEQ, tok_q = tokb + r * 64 + 16 * j;
                const bf16_t* qp = PROJ + (tok_q + ql) * PJ + h * 128 + 8 * g;
                bf16x8 qf[4];
#pragma unroll
                for (int ds = 0; ds < 4; ++ds) qf[ds] = *(const bf16x8*)(qp + 32 * ds);
                na_norm_q(qf, P.na_q_g, g);
#define NA_LOADT(s, R0, R1) do { const size_t t0_ = tokb + (size_t)min(u0 + ((s) % 9), 255) * 64; \
                    if ((s) < 9) { const bf16_t* p_ = PROJ + (t0_ + ktok) * PJ + 1024 + h * 128 + kc * 8; R0 = *(const bf16x8*)p_; R1 = *(const bf16x8*)(p_ + (size_t)32 * PJ); } \
                    else { const bf16_t* p_ = VT + (size_t)(h * 128 + vd) * MP + t0_ + vc * 8; R0 = *(const bf16x8*)p_; R1 = *(const bf16x8*)(p_ + (size_t)64 * MP); } } while (0)
#define NA_WRITET(s, R0, R1) do { char* b_ = stg + ((s) & 1) * 16384; \
                    if ((s) < 9) { *(bf16x8*)(b_ + klds) = R0; *(bf16x8*)(b_ + klds + 8192) = R1; } else { *(bf16x8*)(b_ + vlds) = R0; *(bf16x8*)(b_ + vlds + 8192) = R1; } } while (0)
#define NA_BAR() asm volatile("s_waitcnt lgkmcnt(0)\n\ts_barrier" ::: "memory")
                bf16x8 ra0, ra1, rb0, rb1;
                NA_LOADT(0, ra0, ra1); NA_LOADT(1, rb0, rb1);
                f32x4 st[19];
#define NA_SSTEP(s, R0, R1) do { NA_WRITET(s, R0, R1); NA_LOADT((s) + 2, R0, R1); NA_BAR(); \
                    const char* kbuf_ = stg + ((s) & 1) * 16384; \
                    _Pragma("unroll") for (int hh = 0; hh < 2; ++hh) { f32x4 a = {0.f, 0.f, 0.f, 0.f}; \
                        a = __builtin_amdgcn_mfma_f32_16x16x32_bf16(*(const bf16x8*)(kbuf_ + hh * 1024 + kofs0), qf[0], a, 0, 0, 0); \
                        a = __builtin_amdgcn_mfma_f32_16x16x32_bf16(*(const bf16x8*)(kbuf_ + hh * 1024 + kofs1), qf[1], a, 0, 0, 0); \
                        a = __builtin_amdgcn_mfma_f32_16x16x32_bf16(*(const bf16x8*)(kbuf_ + hh * 1024 + kofs2), qf[2], a, 0, 0, 0); \
                        a = __builtin_amdgcn_mfma_f32_16x16x32_bf16(*(const bf16x8*)(kbuf_ + hh * 1024 + kofs3), qf[3], a, 0, 0, 0); \
                        st[2 * (s) + hh] = a; } } while (0)
                NA_SSTEP(0, ra0, ra1); NA_SSTEP(1, rb0, rb1); NA_SSTEP(2, ra0, ra1); NA_SSTEP(3, rb0, rb1); NA_SSTEP(4, ra0, ra1);
                NA_SSTEP(5, rb0, rb1); NA_SSTEP(6, ra0, ra1);
                bf16x8 km[4];
                { const bf16_t* kpm = PROJ + (size_t)(MROW0 + ql) * PJ + 1024 + h * 128 + 8 * g;
#pragma unroll
                  for (int ds = 0; ds < 4; ++ds) km[ds] = *(const bf16x8*)(kpm + 32 * ds); }
                NA_SSTEP(7, rb0, rb1); NA_SSTEP(8, ra0, ra1);
                { f32x4 a = {0.f, 0.f, 0.f, 0.f};
#pragma unroll
                  for (int ds = 0; ds < 4; ++ds) a = __builtin_amdgcn_mfma_f32_16x16x32_bf16(km[ds], qf[ds], a, 0, 0, 0);
                  st[18] = a; }
                const int c = 16 * j + ql, cs = min(max(c - 8, 0), 48);
                constexpr float SC = 0.08838834764831845f;
                float mx = -1e30f;
#pragma unroll
                for (int t = 0; t < 18; ++t) {
                    const int kr = u0 + (t >> 1); const bool rowok = (kr >= rs) && (kr < rs + 8);
                    const int dr = min(max(kr - r + 7, 0), 14);
#pragma unroll
                    for (int e = 0; e < 4; ++e) {
                        const int kcol = kb + 8 * g + 4 * (t & 1) + e; const bool valid = rowok && (kcol >= cs) && (kcol < cs + 16);
                        const int dc = min(max(kcol - c + 15, 0), 30);
                        float sv = (st[t][e] * SC + rp[dr * 31 + dc]) * LOG2E; sv = valid ? sv : -1e30f; st[t][e] = sv; mx = fmaxf(mx, sv);
                    }
                }
#pragma unroll
                for (int e = 0; e < 4; ++e) { const float sv = (st[18][e] * SC + P.meta_bias[h * 16 + 4 * g + e]) * LOG2E; st[18][e] = sv; mx = fmaxf(mx, sv); }
                mx = fmaxf(mx, __shfl_xor(mx, 16)); mx = fmaxf(mx, __shfl_xor(mx, 32));
                float l = 0.f;
#pragma unroll
                for (int t = 0; t < 19; ++t)
#pragma unroll
                    for (int e = 0; e < 4; ++e) { const float p = __builtin_amdgcn_exp2f(st[t][e] - mx); st[t][e] = p; l += p; }
                l += __shfl_xor(l, 16); l += __shfl_xor(l, 32);
                f32x4 o[8];
#pragma unroll
                for (int dg = 0; dg < 8; ++dg) o[dg] = (f32x4){0.f, 0.f, 0.f, 0.f};
#define NA_VSTEP(s, R0, R1) do { NA_WRITET(s, R0, R1); if ((s) + 2 < 18) NA_LOADT((s) + 2, R0, R1); NA_BAR(); \
                    const char* vbuf_ = stg + ((s) & 1) * 16384 + vofs; constexpr int i_ = (s) - 9; \
                    u32x4 pw; pw.x = cvt_pk_bf16(st[2 * i_][0], st[2 * i_][1]); pw.y = cvt_pk_bf16(st[2 * i_][2], st[2 * i_][3]); pw.z = cvt_pk_bf16(st[2 * i_ + 1][0], st[2 * i_ + 1][1]); pw.w = cvt_pk_bf16(st[2 * i_ + 1][2], st[2 * i_ + 1][3]); \
                    const bf16x8 pa = __builtin_bit_cast(bf16x8, pw); \
                    _Pragma("unroll") for (int dg = 0; dg < 8; ++dg) o[dg] = __builtin_amdgcn_mfma_f32_16x16x32_bf16(pa, *(const bf16x8*)(vbuf_ + dg * 2048), o[dg], 0, 0, 0); } while (0)
                NA_VSTEP(9, rb0, rb1); NA_VSTEP(10, ra0, ra1); NA_VSTEP(11, rb0, rb1); NA_VSTEP(12, ra0, ra1); NA_VSTEP(13, rb0, rb1);
                NA_VSTEP(14, ra0, ra1); NA_VSTEP(15, rb0, rb1);
                u32x2 vmf[8];
                { const bf16_t* vm = VT + (size_t)(h * 128 + ql) * MP + MROW0 + 4 * g;
#pragma unroll
                  for (int dg = 0; dg < 8; ++dg) vmf[dg] = *(const u32x2*)(vm + (size_t)(16 * dg) * MP); }
                NA_VSTEP(16, ra0, ra1); NA_VSTEP(17, rb0, rb1);
                {   u32x4 pw; pw.x = cvt_pk_bf16(st[18][0], st[18][1]); pw.y = cvt_pk_bf16(st[18][2], st[18][3]); pw.z = 0u; pw.w = 0u;
                    const bf16x8 pa = __builtin_bit_cast(bf16x8, pw);
#pragma unroll
                    for (int dg = 0; dg < 8; ++dg) { const u32x4 bw = {vmf[dg].x, vmf[dg].y, 0u, 0u};
                        o[dg] = __builtin_amdgcn_mfma_f32_16x16x32_bf16(pa, __builtin_bit_cast(bf16x8, bw), o[dg], 0, 0, 0); }
                }
#undef NA_LOADT
#undef NA_WRITET
#undef NA_BAR
#undef NA_SSTEP
#undef NA_VSTEP
                const float inv = __builtin_amdgcn_rcpf(l);
                float il[4];
#pragma unroll
                for (int e = 0; e < 4; ++e) il[e] = __shfl(inv, 4 * g + e);
#pragma unroll
                for (int e = 0; e < 4; ++e) { bf16_t* op = OUTA + (tok_q + 4 * g + e) * 1024 + h * 128 + ql;
#pragma unroll
                    for (int dg = 0; dg < 8; ++dg) op[16 * dg] = f2bf(o[dg][e] * il[e]); }
            }
            __syncthreads();
            if (gw < 8) {
                const int h = gw;
                const bf16_t* qp = PROJ + (size_t)(MROW0 + ql) * PJ + h * 128 + 8 * g; const bf16_t* kp = qp + 1024;
                bf16x8 qm[4];
#pragma unroll
                for (int ds = 0; ds < 4; ++ds) qm[ds] = *(const bf16x8*)(qp + 32 * ds);
                na_norm_q(qm, P.na_q_g, g);
                f32x4 a = {0.f, 0.f, 0.f, 0.f};
#pragma unroll
                for (int ds = 0; ds < 4; ++ds) a = __builtin_amdgcn_mfma_f32_16x16x32_bf16(*(const bf16x8*)(kp + 32 * ds), qm[ds], a, 0, 0, 0);
                float mx = -1e30f;
#pragma unroll
                for (int e = 0; e < 4; ++e) { a[e] = (a[e] * 0.08838834764831845f + P.meta_bias[h * 16 + 4 * g + e]) * LOG2E; mx = fmaxf(mx, a[e]); }
                mx = fmaxf(mx, __shfl_xor(mx, 16)); mx = fmaxf(mx, __shfl_xor(mx, 32));
                float l = 0.f;
#pragma unroll
                for (int e = 0; e < 4; ++e) { a[e] = __builtin_amdgcn_exp2f(a[e] - mx); l += a[e]; }
                l += __shfl_xor(l, 16); l += __shfl_xor(l, 32);
                u32x4 pw; pw.x = cvt_pk_bf16(a[0], a[1]); pw.y = cvt_pk_bf16(a[2], a[3]); pw.z = 0u; pw.w = 0u;
                const bf16x8 pa = __builtin_bit_cast(bf16x8, pw);
                const bf16_t* vm = VT + (size_t)(h * 128 + ql) * MP + MROW0 + 4 * g;
                const float inv15 = __shfl(__builtin_amdgcn_rcpf(l), 15);
#pragma unroll
                for (int dg = 0; dg < 8; ++dg) { const u32x2 lo = *(const u32x2*)(vm + (size_t)(16 * dg) * MP); const u32x4 bw = {lo.x, lo.y, 0u, 0u};
                    f32x4 o = {0.f, 0.f, 0.f, 0.f}; o = __builtin_amdgcn_mfma_f32_16x16x32_bf16(pa, __builtin_bit_cast(bf16x8, bw), o, 0, 0, 0);
                    if (g == 3) OA15[h * 128 + 16 * dg + ql] = o[3] * inv15; }
            }
        }
        xcd_barrier(xbar);
        { PH_BEGIN
            const int h = lane >> 3, sub = lane & 7;
            for (int row = gw; row < MP; row += NGW) {
                const int pos = row < NREAL ? 16 + (row & (SEQ - 1)) : ((row - MROW0) & 15);
                const float* tb = TAB + ((size_t)pos * 32 + 8 * (sub & 3)) * 2;
                const f32x4 t0 = *(const f32x4*)tb, t1 = *(const f32x4*)(tb + 4), t2 = *(const f32x4*)(tb + 8), t3 = *(const f32x4*)(tb + 12);
#pragma unroll
                for (int which = 0; which < 2; ++which) {
                    const bf16_t* np = which == 0 ? QRAW + (size_t)row * 1536 + h * 192 + 16 * sub : KV + (size_t)row * 2048 + h * 256 + 16 * sub;
                    const bf16_t* rpp = which == 0 ? QRAW + (size_t)row * 1536 + h * 192 + 128 + 8 * sub : PROJ + (size_t)row * PJ + 2816 + 8 * sub;
                    const float* gn = which == 0 ? P.mq_g : P.mk_g;
                    bf16_t* dst = (which == 0 ? QP : KP) + (size_t)row * 1536 + h * 192;
                    const u32x4 a = *(const u32x4*)np, bq = *(const u32x4*)(np + 8), c = *(const u32x4*)rpp;
                    float n0 = bflo(a.x), n1 = bfhi(a.x), n2 = bflo(a.y), n3 = bfhi(a.y), n4 = bflo(a.z), n5 = bfhi(a.z), n6 = bflo(a.w), n7 = bfhi(a.w);
                    float m0 = bflo(bq.x), m1 = bfhi(bq.x), m2 = bflo(bq.y), m3 = bfhi(bq.y), m4 = bflo(bq.z), m5 = bfhi(bq.z), m6 = bflo(bq.w), m7 = bfhi(bq.w);
                    float r0 = bflo(c.x), r1 = bfhi(c.x), r2 = bflo(c.y), r3 = bfhi(c.y), r4 = bflo(c.z), r5 = bfhi(c.z), r6 = bflo(c.w), r7 = bfhi(c.w);
                    float ss = n0 * n0 + n1 * n1 + n2 * n2 + n3 * n3 + n4 * n4 + n5 * n5 + n6 * n6 + n7 * n7 + m0 * m0 + m1 * m1 + m2 * m2 + m3 * m3 + m4 * m4 + m5 * m5 + m6 * m6 + m7 * m7
                             + r0 * r0 + r1 * r1 + r2 * r2 + r3 * r3 + r4 * r4 + r5 * r5 + r6 * r6 + r7 * r7;
                    ss += __shfl_xor(ss, 1); ss += __shfl_xor(ss, 2); ss += __shfl_xor(ss, 4);
                    const float rs = __builtin_amdgcn_rsqf(ss * (1.f / 192.f) + EPS);
                    const f32x4 ga = *(const f32x4*)(gn + 16 * sub), gb = *(const f32x4*)(gn + 16 * sub + 4), gc = *(const f32x4*)(gn + 16 * sub + 8), gd = *(const f32x4*)(gn + 16 * sub + 12);
                    const f32x4 ge = *(const f32x4*)(gn + 128 + 8 * sub), gf = *(const f32x4*)(gn + 128 + 8 * sub + 4);
                    u32x4 w;
                    w.x = cvt_pk_bf16(n0 * rs * ga.x, n1 * rs * ga.y); w.y = cvt_pk_bf16(n2 * rs * ga.z, n3 * rs * ga.w); w.z = cvt_pk_bf16(n4 * rs * gb.x, n5 * rs * gb.y); w.w = cvt_pk_bf16(n6 * rs * gb.z, n7 * rs * gb.w);
                    *(u32x4*)(dst + 16 * sub) = w;
                    w.x = cvt_pk_bf16(m0 * rs * gc.x, m1 * rs * gc.y); w.y = cvt_pk_bf16(m2 * rs * gc.z, m3 * rs * gc.w); w.z = cvt_pk_bf16(m4 * rs * gd.x, m5 * rs * gd.y); w.w = cvt_pk_bf16(m6 * rs * gd.z, m7 * rs * gd.w);
                    *(u32x4*)(dst + 16 * sub + 8) = w;
                    const float y0 = r0 * rs * ge.x, y1 = r1 * rs * ge.y, y2 = r2 * rs * ge.z, y3 = r3 * rs * ge.w, y4 = r4 * rs * gf.x, y5 = r5 * rs * gf.y, y6 = r6 * rs * gf.z, y7 = r7 * rs * gf.w;
                    const float z0 = __shfl_xor(y0, 4), z1 = __shfl_xor(y1, 4), z2 = __shfl_xor(y2, 4), z3 = __shfl_xor(y3, 4), z4 = __shfl_xor(y4, 4), z5 = __shfl_xor(y5, 4), z6 = __shfl_xor(y6, 4), z7 = __shfl_xor(y7, 4);
                    const float sg = (sub < 4) ? -1.f : 1.f;
                    w.x = cvt_pk_bf16(y0 * t0.x + sg * z0 * t0.y, y1 * t0.z + sg * z1 * t0.w); w.y = cvt_pk_bf16(y2 * t1.x + sg * z2 * t1.y, y3 * t1.z + sg * z3 * t1.w);
                    w.z = cvt_pk_bf16(y4 * t2.x + sg * z4 * t2.y, y5 * t2.z + sg * z5 * t2.w); w.w = cvt_pk_bf16(y6 * t3.x + sg * z6 * t3.y, y7 * t3.z + sg * z7 * t3.w);
                    *(u32x4*)(dst + 128 + 8 * sub) = w;
                }
            }
        }
        xcd_barrier(xbar);
        { PH_BEGIN
            for (int it = gw; it < 16 * NCHUNK; it += NGW) {
                const int bh = it / NCHUNK, c = it % NCHUNK, b = bh >> 3, h = bh & 7;
                const size_t rowbase = (c == 0) ? (size_t)(MROW0 + 16 * b) : (size_t)b * SEQ + (size_t)(c - 1) * 64;
                const bf16_t* q = QP + (size_t)(MROW0 + 16 * b + 15) * 1536 + h * 192; const bf16_t* k = KP + (rowbase + lane) * 1536 + h * 192;
                float s = 0.f;
#pragma unroll 4
                for (int ch = 0; ch < 24; ++ch) s += dot8(*(const u32x4*)(q + ch * 8), *(const u32x4*)(k + ch * 8));
                s *= mla::SCALE * LOG2E; if (c == 0 && lane >= 16) s = -1e30f;
                const float m = wave_max(s); const float p = __builtin_amdgcn_exp2f(s - m); const float l = wave_sum(p);
                const bf16_t* vp = KV + rowbase * 2048 + h * 256 + 128 + 2 * lane;
                float o0 = 0.f, o1 = 0.f;
#pragma unroll 8
                for (int key = 0; key < 64; ++key) { const float pk = __shfl(p, key); const unsigned u = *(const unsigned*)(vp + (size_t)key * 2048); o0 += pk * bflo(u); o1 += pk * bfhi(u); }
                float* pt = PART + (size_t)it * PARTW;
                if (lane == 0) { pt[0] = m; pt[1] = l; }
                pt[4 + 2 * lane] = o0; pt[5 + 2 * lane] = o1;
            }
            __syncthreads();
            const int xcd = blockIdx.x & 7, idx = blockIdx.x >> 3, nper = G >> 3;
            for (int i = 0;; ++i) {
                int u;
                if ((G & 7) == 0 && nper == 32) { const int slot = i * 8 + xcd; if (slot >= 32) break; u = (slot >> 1) * 64 + (slot & 1) * 32 + idx; }
                else { u = blockIdx.x + i * G; if (u >= 1024) break; }
                const int bh = u >> 6, qb = u & 63, b = bh >> 3, h = bh & 7;
                const size_t q0 = (size_t)b * SEQ + (size_t)qb * 256;
                int tid_u = tid; asm volatile("" : "+v"(tid_u));
                mla::attn_unit2(QP + q0 * 1536 + h * 192, KP + h * 192, KV + h * 256 + 128, OUTB + q0 * 1024 + h * 128, MROW0 + 16 * b, b * SEQ, (char*)lds, tid_u);
            }
        }
        xcd_barrier(xbar);
        { PH_BEGIN
            const int nw9 = (G > 1) ? (G - 1) * 8 : 8;
            if ((int)blockIdx.x < G - 1 || G == 1)
            for (int row = gw; row < NREAL; row += nw9) {
#pragma unroll
                for (int which = 0; which < 2; ++which) {
                    const bf16_t* src = (which == 0 ? OUTA : OUTB) + (size_t)row * 1024 + 16 * lane; const float* gn = (which == 0 ? P.na_out_g : P.mla_out_g) + 16 * lane;
                    const u32x4 a = *(const u32x4*)src, bq = *(const u32x4*)(src + 8);
                    float n0 = bflo(a.x), n1 = bfhi(a.x), n2 = bflo(a.y), n3 = bfhi(a.y), n4 = bflo(a.z), n5 = bfhi(a.z), n6 = bflo(a.w), n7 = bfhi(a.w);
                    float m0 = bflo(bq.x), m1 = bfhi(bq.x), m2 = bflo(bq.y), m3 = bfhi(bq.y), m4 = bflo(bq.z), m5 = bfhi(bq.z), m6 = bflo(bq.w), m7 = bfhi(bq.w);
                    const float ss = wave_sum(n0 * n0 + n1 * n1 + n2 * n2 + n3 * n3 + n4 * n4 + n5 * n5 + n6 * n6 + n7 * n7 + m0 * m0 + m1 * m1 + m2 * m2 + m3 * m3 + m4 * m4 + m5 * m5 + m6 * m6 + m7 * m7);
                    const float rs = __builtin_amdgcn_rsqf(ss * (1.f / 1024.f) + EPS);
                    const f32x4 ga = *(const f32x4*)gn, gb = *(const f32x4*)(gn + 4), gc = *(const f32x4*)(gn + 8), gd = *(const f32x4*)(gn + 12);
                    bf16_t* dst = MIX + (size_t)row * DM + which * 1024 + 16 * lane; u32x4 w;
                    w.x = cvt_pk_bf16(n0 * rs * ga.x, n1 * rs * ga.y); w.y = cvt_pk_bf16(n2 * rs * ga.z, n3 * rs * ga.w); w.z = cvt_pk_bf16(n4 * rs * gb.x, n5 * rs * gb.y); w.w = cvt_pk_bf16(n6 * rs * gb.z, n7 * rs * gb.w);
                    *(u32x4*)dst = w;
                    w.x = cvt_pk_bf16(m0 * rs * gc.x, m1 * rs * gc.y); w.y = cvt_pk_bf16(m2 * rs * gc.z, m3 * rs * gc.w); w.z = cvt_pk_bf16(m4 * rs * gd.x, m5 * rs * gd.y); w.w = cvt_pk_bf16(m6 * rs * gd.z, m7 * rs * gd.w);
                    *(u32x4*)(dst + 8) = w;
                }
            }
            if ((int)blockIdx.x == G - 1) {
                float* sh = (float*)lds;
                __syncthreads();
                for (int bh = wid; bh < 16; bh += 8) {
                    const float* pt = PART + (size_t)bh * NCHUNK * PARTW;
                    float mm = -1e30f;
                    for (int c = lane; c < NCHUNK; c += 64) mm = fmaxf(mm, pt[(size_t)c * PARTW]);
                    mm = wave_max(mm);
                    float L = 0.f, o0 = 0.f, o1 = 0.f;
                    for (int c = 0; c < NCHUNK; ++c) { const float* pc = pt + (size_t)c * PARTW; const float w = __builtin_amdgcn_exp2f(pc[0] - mm); L += w * pc[1]; o0 += w * pc[4 + 2 * lane]; o1 += w * pc[5 + 2 * lane]; }
                    const float inv = 1.f / L;
                    sh[bh * 128 + 2 * lane] = bfround(o0 * inv); sh[bh * 128 + 2 * lane + 1] = bfround(o1 * inv);
                }
                __syncthreads();
                if (wid < 2) {
                    const int b = wid; float sa = 0.f, sb = 0.f;
#pragma unroll
                    for (int e = 0; e < 16; ++e) { const float va = bfround(OA15[16 * lane + e]), vb = sh[b * 1024 + 16 * lane + e]; sa += va * va; sb += vb * vb; }
                    const float ra = __builtin_amdgcn_rsqf(wave_sum(sa) * (1.f / 1024.f) + EPS), rb = __builtin_amdgcn_rsqf(wave_sum(sb) * (1.f / 1024.f) + EPS);
#pragma unroll
                    for (int e = 0; e < 16; ++e) { const int i = 16 * lane + e;
                        MIX15[b * DM + i] = bfround(bfround(OA15[i]) * ra * P.na_out_g[i]); MIX15[b * DM + 1024 + i] = bfround(sh[b * 1024 + i] * rb * P.mla_out_g[i]); }
                }
                __syncthreads();
            }
        }
        xcd_barrier(xbar);
        { PH_BEGIN pg8::Gemm g = pg8::Gemm{MIX, WOT, NREAL, DM, DM}; pg8::EpiResSsq E = pg8::EpiResSsq{P.x, P.out, HN2, SSQ, DM}; pg8::StaticOrder S; S.init(g.M, g.N, G, (int)blockIdx.x);
          pg8::gemm_phase<pg8::EpiResSsq, pg8::StaticOrder, false, true>((LAS unsigned char*)lds, g, S, E, tid); }
        { PH_BEGIN
            {
                for (int n = gw; n < DM; n += NGW) {
                    const bf16_t* w = WOT + (size_t)n * DM; float a0 = 0.f, a1 = 0.f;
#pragma unroll
                    for (int i = 0; i < 4; ++i) { const int k = 8 * lane + 512 * i; const u32x4 wv = *(const u32x4*)(w + k);
                        const f32x4 x0 = *(const f32x4*)(MIX15 + k), x1 = *(const f32x4*)(MIX15 + k + 4), y0 = *(const f32x4*)(MIX15 + DM + k), y1 = *(const f32x4*)(MIX15 + DM + k + 4);
                        const float w0 = bflo(wv.x), w1 = bfhi(wv.x), w2 = bflo(wv.y), w3 = bfhi(wv.y), w4 = bflo(wv.z), w5 = bfhi(wv.z), w6 = bflo(wv.w), w7 = bfhi(wv.w);
                        a0 += w0 * x0.x + w1 * x0.y + w2 * x0.z + w3 * x0.w + w4 * x1.x + w5 * x1.y + w6 * x1.z + w7 * x1.w;
                        a1 += w0 * y0.x + w1 * y0.y + w2 * y0.z + w3 * y0.w + w4 * y1.x + w5 * y1.y + w6 * y1.z + w7 * y1.w; }
                    a0 = wave_sum(a0); a1 = wave_sum(a1);
                    if (lane == 0) { const float mb = P.meta[15 * DM + n]; H115[n] = mb + a0; H115[DM + n] = mb + a1; }
                }
            }
        }
        xcd_barrier(xbar);
        { PH_BEGIN
            for (int row = gw; row < NREAL; row += NGW) {
                const bf16_t* src = HN2 + (size_t)row * DM + 8 * lane; float ss = 0.f;
#pragma unroll
                for (int i = 0; i < 4; ++i) { const u32x4 v = *(const u32x4*)(src + 512 * i);
                    const float f0 = bflo(v.x), f1 = bfhi(v.x), f2 = bflo(v.y), f3 = bfhi(v.y), f4 = bflo(v.z), f5 = bfhi(v.z), f6 = bflo(v.w), f7 = bfhi(v.w);
                    ss += f0 * f0 + f1 * f1 + f2 * f2 + f3 * f3 + f4 * f4 + f5 * f5 + f6 * f6 + f7 * f7; }
                ss = wave_sum(ss);
                if (lane == 0) SSQ[row] = ss;
            }
        }
        xcd_barrier(xbar);
        { PH_BEGIN pg8::Gemm g = pg8::Gemm{HN2, WGT, NREAL, DFF, DM}; pg8::EpiBf16 E = pg8::EpiBf16{GB, DFF, SSQ}; pg8::StaticOrder S; S.init(g.M, g.N, G, (int)blockIdx.x);
          pg8::gemm_phase<pg8::EpiBf16, pg8::StaticOrder, true, true>((LAS unsigned char*)lds, g, S, E, tid); }
        { PH_BEGIN
            {
                for (int n = gw; n < DFF; n += NGW) {
                    const bf16_t* w = WGT + (size_t)n * DM; float a0 = 0.f, a1 = 0.f, s0 = 0.f, s1 = 0.f;
#pragma unroll
                    for (int i = 0; i < 4; ++i) { const int k = 8 * lane + 512 * i; const u32x4 wv = *(const u32x4*)(w + k);
                        const f32x4 x0 = *(const f32x4*)(H115 + k), x1 = *(const f32x4*)(H115 + k + 4), y0 = *(const f32x4*)(H115 + DM + k), y1 = *(const f32x4*)(H115 + DM + k + 4);
                        const float w0 = bflo(wv.x), w1 = bfhi(wv.x), w2 = bflo(wv.y), w3 = bfhi(wv.y), w4 = bflo(wv.z), w5 = bfhi(wv.z), w6 = bflo(wv.w), w7 = bfhi(wv.w);
                        a0 += w0 * x0.x + w1 * x0.y + w2 * x0.z + w3 * x0.w + w4 * x1.x + w5 * x1.y + w6 * x1.z + w7 * x1.w;
                        a1 += w0 * y0.x + w1 * y0.y + w2 * y0.z + w3 * y0.w + w4 * y1.x + w5 * y1.y + w6 * y1.z + w7 * y1.w;
                        s0 += x0.x * x0.x + x0.y * x0.y + x0.z * x0.z + x0.w * x0.w + x1.x * x1.x + x1.y * x1.y + x1.z * x1.z + x1.w * x1.w;
                        s1 += y0.x * y0.x + y0.y * y0.y + y0.z * y0.z + y0.w * y0.w + y1.x * y1.x + y1.y * y1.y + y1.z * y1.z + y1.w * y1.w; }
                    a0 = wave_sum(a0) * __builtin_amdgcn_rsqf(wave_sum(s0) * (1.f / DM) + EPS); a1 = wave_sum(a1) * __builtin_amdgcn_rsqf(wave_sum(s1) * (1.f / DM) + EPS);
                    if (lane == 0) { G15[n] = a0; G15[DFF + n] = a1; }
                }
            }
        }
        xcd_barrier(xbar);
        { PH_BEGIN pg8::Gemm g{HN2, WUT, NREAL, DFF, DM}; pg8::EpiConvGlu E{GB, ACT, DFF, P.conv_w, P.conv_b, G15, SSQ}; pg8::StaticOrder S; S.init(g.M, g.N, G, (int)blockIdx.x);
          pg8::gemm_phase<pg8::EpiConvGlu, pg8::StaticOrder, true, true>((LAS unsigned char*)lds, g, S, E, tid); }
        xcd_barrier(xbar);
        { PH_BEGIN pg8::Gemm g = pg8::Gemm{ACT, WDT, NREAL, DM, DFF}; pg8::EpiResF32 E = pg8::EpiResF32{P.out, P.out, DM}; pg8::StaticOrder S; S.init(g.M, g.N, G, (int)blockIdx.x);
          pg8::gemm_phase<pg8::EpiResF32, pg8::StaticOrder, true, true>((LAS unsigned char*)lds, g, S, E, tid); }
}

extern "C" void kernel_launch(void* const* d_in, const int* in_sizes, int n_in, void* d_out, int out_size, void* d_ws, size_t ws_size, hipStream_t stream) {
    static int grid = 0;
    if (grid == 0) {
        if (n_in != 23 || in_sizes[0] != NREAL * DM || out_size != NREAL * DM || ws_size < WS_END) {
            fprintf(stderr, "kernel_launch: unexpected shapes: n_in %d in0 %d out %d ws %zu (need %zu)\n", n_in, n_in > 0 ? in_sizes[0] : -1, out_size, ws_size, (size_t)WS_END); grid = -1; return; }
        int dev = 0, cus = 0, per_cu = 0;
        hipGetDevice(&dev); hipDeviceGetAttribute(&cus, hipDeviceAttributeMultiprocessorCount, dev);
        if (hipFuncSetAttribute((const void*)fwd_kernel, hipFuncAttributeMaxDynamicSharedMemorySize, LDS_BYTES) != hipSuccess) { fprintf(stderr, "kernel_launch: hipFuncSetAttribute failed\n"); grid = -1; return; }
        if (hipOccupancyMaxActiveBlocksPerMultiprocessor(&per_cu, (const void*)fwd_kernel, 512, LDS_BYTES) != hipSuccess || per_cu < 1) { fprintf(stderr, "kernel_launch: occupancy query gave %d\n", per_cu); per_cu = 1; }
        (void)hipGetLastError();
        grid = cus * per_cu;
    }
    if (grid < 0) return;
    Args a{};
    const float** ap = (const float**)&a;
    for (int i = 0; i < 23; ++i) ap[i] = (const float*)d_in[i];
    a.out = (float*)d_out; a.ws = (unsigned char*)d_ws;
    if (hipMemsetAsync(d_ws, 0, 16384, stream) != hipSuccess) { fprintf(stderr, "kernel_launch: memset failed\n"); return; }
    void* args[] = {&a};
    hipError_t e = hipLaunchCooperativeKernel((const void*)fwd_kernel, dim3(grid), dim3(512), args, LDS_BYTES, stream);
    if (e != hipSuccess) fprintf(stderr, "cooperative launch failed: %s (grid %d)\n", hipGetErrorString(e), grid);
}
```

```cpp
#include <hip/hip_runtime.h>
#include <hip/hip_cooperative_groups.h>
#include <cstdio>
#include <cstdint>
namespace cg = cooperative_groups;

#define LAS __attribute__((address_space(3)))
typedef unsigned short bf16_t;
typedef short bf16x8 __attribute__((ext_vector_type(8)));
typedef short s16x4 __attribute__((ext_vector_type(4)));
typedef float f32x4 __attribute__((ext_vector_type(4)));
typedef float f32x16 __attribute__((ext_vector_type(16)));
typedef unsigned u32x4 __attribute__((ext_vector_type(4)));
typedef unsigned u32x2 __attribute__((ext_vector_type(2)));

constexpr int DM = 2048, SEQ = 16384, NREAL = 32768, MROW0 = 32768, MP = 33024, DFF = 5632, INC = 3904, LTOT = 16400;
constexpr float EPS = 1e-6f, LOG2E = 1.4426950408889634f;
constexpr int PJ = 3072;
constexpr int NCHUNK = 257;
constexpr int PARTW = 132;

constexpr size_t MiB = 1u << 20;
constexpr size_t WS_TAB = 1 * MiB, WS_PART = 6 * MiB, WS_SMALL = 9 * MiB;
constexpr size_t SM_OA15 = 0, SM_MIX15 = 8192, SM_H115 = 32768, SM_HN215 = 65536, SM_G15 = 131072, SM_SSQ = 262144;
constexpr size_t WS_W1T = 16 * MiB, WS_WVT = 28 * MiB, WS_WQT = 32 * MiB, WS_WKVT = 34 * MiB, WS_WOT = 36 * MiB, WS_WGT = 44 * MiB, WS_WUT = 66 * MiB, WS_WDT = 88 * MiB;
constexpr size_t WS_HN = 112 * MiB, WS_PROJ = 241 * MiB, WS_VT = 435 * MiB, WS_CQN = 500 * MiB, WS_CKVN = 533 * MiB, WS_QRAW = 550 * MiB, WS_KV = 647 * MiB;
constexpr size_t WS_OUTA = 776 * MiB, WS_OUTB = 840 * MiB, WS_QP = 112 * MiB, WS_KP = 435 * MiB, WS_MIX = 112 * MiB, WS_HN2 = 816 * MiB, WS_G = 112 * MiB, WS_ACT = 464 * MiB;
constexpr size_t WS_END = 944 * MiB;

__device__ __forceinline__ unsigned cvt_pk_bf16(float lo, float hi) { unsigned r; asm volatile("v_cvt_pk_bf16_f32 %0, %1, %2" : "=v"(r) : "v"(lo), "v"(hi)); return r; }
__device__ __forceinline__ float bflo(unsigned u) { return __uint_as_float(u << 16); }
__device__ __forceinline__ float bfhi(unsigned u) { return __uint_as_float(u & 0xffff0000u); }
__device__ __forceinline__ unsigned short f2bf(float f) { unsigned u = __float_as_uint(f); return (unsigned short)((u + 0x7fffu + ((u >> 16) & 1u)) >> 16); }
__device__ __forceinline__ float bfround(float f) { return __uint_as_float(((unsigned)f2bf(f)) << 16); }
__device__ __forceinline__ float wave_sum(float v) {
#pragma unroll
    for (int o = 1; o < 64; o <<= 1) v += __shfl_xor(v, o);
    return v;
}
__device__ __forceinline__ float wave_max(float v) {
#pragma unroll
    for (int o = 1; o < 64; o <<= 1) v = fmaxf(v, __shfl_xor(v, o));
    return v;
}
__device__ __forceinline__ float dot8(u32x4 a, u32x4 b) {
    return bflo(a.x) * bflo(b.x) + bfhi(a.x) * bfhi(b.x) + bflo(a.y) * bflo(b.y) + bfhi(a.y) * bfhi(b.y)
         + bflo(a.z) * bflo(b.z) + bfhi(a.z) * bfhi(b.z) + bflo(a.w) * bflo(b.w) + bfhi(a.w) * bfhi(b.w);
}

namespace pg8 {
#define PG8_LAS __attribute__((address_space(3)))
constexpr int BM = 256, BK = 64, HALF = 128, HTB = HALF * BK * 2, STAGE_BYTES = 8 * HTB, NXCD = 8, WGM = 8;
__host__ __device__ __forceinline__ int lds_byte(int r, int c) { const int st = (r >> 4) * 2 + (c >> 5), rr = r & 15, cc = c & 31, ob = rr * 64 + cc * 2; return st * 1024 + (ob ^ (((ob >> 9) & 1) << 5)); }
__host__ __device__ __forceinline__ void stage_rc(int b, int& R, int& C) { const int st = b / 1024, sb = b % 1024, swz = sb ^ (((sb >> 9) & 1) << 5); R = (st >> 1) * 16 + swz / 64; C = (st & 1) * 32 + (swz % 64) / 2; }
__host__ __device__ __forceinline__ int perm32(int rho) { const int n = rho >> 4, i = rho & 15; return 8 * (i >> 2) + 4 * n + (i & 3); }
struct Unit { int pm, pn; };
struct Gemm { const bf16_t* A; const bf16_t* Bt; int M, N, K; };
struct StaticOrder {
    int nM, nN, nwg, G, c;
    __host__ __device__ void init(int M, int N, int G_, int c_) { nM = M / BM; nN = N / BM; nwg = nM * nN; G = G_; c = c_; }
    __host__ __device__ bool next(int i, Unit& u) const {
        const long L = (long)i * G + c; if (L >= nwg) return false;
        int wgid = (int)L; { const int q = nwg / NXCD, r = nwg % NXCD, xcd = wgid % NXCD, off = wgid / NXCD; wgid = (xcd < r ? xcd * (q + 1) : r * (q + 1) + (xcd - r) * q) + off; }
        const int nig = WGM * nN, gid = wgid / nig, fm = gid * WGM, gsz = (nM - fm) < WGM ? (nM - fm) : WGM;
        u.pm = fm + ((wgid % nig) % gsz); u.pn = (wgid % nig) / gsz; return true;
    }
    __device__ __forceinline__ void a_ready(const Unit&) const {}
    __device__ __forceinline__ void done(const Unit&) const {}
};
struct EpiBf16 {
    static constexpr bool PERM = true, AFTER_DRAIN = false;
    bf16_t* O; int ldc; const float* ssq;
    __device__ __forceinline__ void operator()(const f32x4 (&acc)[2][2][4][2], const Unit& u, int wr, int wc, int fr, int fq) const {
        const int row0 = u.pm * BM + wr * 64 + fr; const int col0 = u.pn * BM + wc * 32 + 8 * fq;
#pragma unroll
        for (int ai = 0; ai < 2; ++ai)
#pragma unroll
            for (int m = 0; m < 4; ++m) { bf16_t* rowp = O + (size_t)(row0 + ai * HALF + m * 16) * ldc + col0;
                const float rsc = ssq ? __builtin_amdgcn_rsqf(ssq[row0 + ai * HALF + m * 16] * (1.f / DM) + EPS) : 1.f;
#pragma unroll
                for (int bj = 0; bj < 2; ++bj) { const f32x4 v0 = acc[ai][bj][m][0] * rsc, v1 = acc[ai][bj][m][1] * rsc;
                    u32x4 w; w.x = cvt_pk_bf16(v0[0], v0[1]); w.y = cvt_pk_bf16(v0[2], v0[3]); w.z = cvt_pk_bf16(v1[0], v1[1]); w.w = cvt_pk_bf16(v1[2], v1[3]);
                    *(u32x4*)(rowp + bj * HALF) = w; } }
    }
};
struct EpiResF32 {
    static constexpr bool PERM = true, AFTER_DRAIN = false;
    const float* base; float* out; int ldc;
    __device__ __forceinline__ void operator()(const f32x4 (&acc)[2][2][4][2], const Unit& u, int wr, int wc, int fr, int fq) const {
        const int row0 = u.pm * BM + wr * 64 + fr; const int col0 = u.pn * BM + wc * 32 + 8 * fq;
#pragma unroll
        for (int ai = 0; ai < 2; ++ai)
#pragma unroll
            for (int m = 0; m < 4; ++m) { const size_t off = (size_t)(row0 + ai * HALF + m * 16) * ldc + col0;
#pragma unroll
                for (int bj = 0; bj < 2; ++bj) {
                    const f32x4 o0 = *(const f32x4*)(base + off + bj * HALF) + acc[ai][bj][m][0], o1 = *(const f32x4*)(base + off + bj * HALF + 4) + acc[ai][bj][m][1];
                    *(f32x4*)(out + off + bj * HALF) = o0; *(f32x4*)(out + off + bj * HALF + 4) = o1; }
                asm volatile("" ::: "memory"); }
    }
};
struct EpiResSsq {
    static constexpr bool PERM = true, AFTER_DRAIN = false;
    const float* base; float* out; bf16_t* xb; float* ssq; int ldc;
    __device__ __forceinline__ void operator()(const f32x4 (&acc)[2][2][4][2], const Unit& u, int wr, int wc, int fr, int fq) const {
        const int row0 = u.pm * BM + wr * 64 + fr; const int col0 = u.pn * BM + wc * 32 + 8 * fq;
#pragma unroll
        for (int ai = 0; ai < 2; ++ai)
#pragma unroll
            for (int m = 0; m < 4; ++m) { const int row = row0 + ai * HALF + m * 16; const size_t off = (size_t)row * ldc + col0; float sq = 0.f;
#pragma unroll
                for (int bj = 0; bj < 2; ++bj) {
                    const f32x4 o0 = *(const f32x4*)(base + off + bj * HALF) + acc[ai][bj][m][0], o1 = *(const f32x4*)(base + off + bj * HALF + 4) + acc[ai][bj][m][1];
                    *(f32x4*)(out + off + bj * HALF) = o0; *(f32x4*)(out + off + bj * HALF + 4) = o1;
                    u32x4 w; w.x = cvt_pk_bf16(o0[0], o0[1]); w.y = cvt_pk_bf16(o0[2], o0[3]); w.z = cvt_pk_bf16(o1[0], o1[1]); w.w = cvt_pk_bf16(o1[2], o1[3]);
                    *(u32x4*)(xb + off + bj * HALF) = w;
                    sq += (o0[0] * o0[0] + o0[1] * o0[1]) + (o0[2] * o0[2] + o0[3] * o0[3]) + (o1[0] * o1[0] + o1[1] * o1[1]) + (o1[2] * o1[2] + o1[3] * o1[3]); }
                (void)sq; (void)fq;
                asm volatile("" ::: "memory"); }
    }
};
struct EpiConvGlu {
    static constexpr bool PERM = true, AFTER_DRAIN = false;
    const bf16_t* Gt; bf16_t* O; int ldc; const float* cw; const float* cb; const float* g15; const float* ssq;
    __device__ __forceinline__ void operator()(const f32x4 (&acc)[2][2][4][2], const Unit& u, int wr, int wc, int fr, int fq) const {
        const int row0 = u.pm * BM + wr * 64 + fr; const int col0 = u.pn * BM + wc * 32 + 8 * fq;
#pragma unroll
        for (int bj = 0; bj < 2; ++bj) {
            const int col = col0 + bj * HALF;
            const f32x4 w0a = *(const f32x4*)(cw + col), w0b = *(const f32x4*)(cw + col + 4);
            const f32x4 w1a = *(const f32x4*)(cw + DFF + col), w1b = *(const f32x4*)(cw + DFF + col + 4);
            const f32x4 w2a = *(const f32x4*)(cw + 2 * DFF + col), w2b = *(const f32x4*)(cw + 2 * DFF + col + 4);
            const f32x4 cba = *(const f32x4*)(cb + col), cbb = *(const f32x4*)(cb + col + 4);
#pragma unroll
            for (int ai = 0; ai < 2; ++ai)
#pragma unroll
                for (int m = 0; m < 4; ++m) {
                    const int row = row0 + ai * HALF + m * 16; const int t = row & (SEQ - 1), b = row >> 14;
                    const bf16_t* gp = Gt + (size_t)row * ldc + col; const float rsc = __builtin_amdgcn_rsqf(ssq[row] * (1.f / DM) + EPS);
                    const u32x4 gc = *(const u32x4*)gp;
                    f32x4 pa, pb, na, nb;
                    if (t == 0) { pa = *(const f32x4*)(g15 + b * DFF + col); pb = *(const f32x4*)(g15 + b * DFF + col + 4); }
                    else { const u32x4 gq = *(const u32x4*)(gp - ldc); pa = (f32x4){bflo(gq.x), bfhi(gq.x), bflo(gq.y), bfhi(gq.y)}; pb = (f32x4){bflo(gq.z), bfhi(gq.z), bflo(gq.w), bfhi(gq.w)}; }
                    if (t == SEQ - 1) { na = (f32x4){0.f, 0.f, 0.f, 0.f}; nb = na; }
                    else { const u32x4 gq = *(const u32x4*)(gp + ldc); na = (f32x4){bflo(gq.x), bfhi(gq.x), bflo(gq.y), bfhi(gq.y)}; nb = (f32x4){bflo(gq.z), bfhi(gq.z), bflo(gq.w), bfhi(gq.w)}; }
                    const f32x4 ca = (f32x4){bflo(gc.x), bfhi(gc.x), bflo(gc.y), bfhi(gc.y)}, cbv = (f32x4){bflo(gc.z), bfhi(gc.z), bflo(gc.w), bfhi(gc.w)};
                    f32x4 ra, rb;
#pragma unroll
                    for (int e = 0; e < 4; ++e) {
                        const float xa = __builtin_fmaf(w2a[e], na[e], __builtin_fmaf(w1a[e], ca[e], __builtin_fmaf(w0a[e], pa[e], cba[e])));
                        const float xb = __builtin_fmaf(w2b[e], nb[e], __builtin_fmaf(w1b[e], cbv[e], __builtin_fmaf(w0b[e], pb[e], cbb[e])));
                        ra[e] = (xa * __builtin_amdgcn_rcpf(1.f + __builtin_amdgcn_exp2f(xa * -LOG2E))) * (acc[ai][bj][m][0][e] * rsc);
                        rb[e] = (xb * __builtin_amdgcn_rcpf(1.f + __builtin_amdgcn_exp2f(xb * -LOG2E))) * (acc[ai][bj][m][1][e] * rsc); }
                    u32x4 w; w.x = cvt_pk_bf16(ra[0], ra[1]); w.y = cvt_pk_bf16(ra[2], ra[3]); w.z = cvt_pk_bf16(rb[0], rb[1]); w.w = cvt_pk_bf16(rb[2], rb[3]);
                    *(u32x4*)(O + (size_t)row * ldc + col) = w;
                }
        }
    }
};

template <class Epi, class Sched, bool ALIGN_EPI = false, bool SP2 = false>
__device__ __forceinline__ void gemm_phase(PG8_LAS unsigned char* lds, const Gemm g, const Sched& S, const Epi& E, const int tid) {
    const int wid = __builtin_amdgcn_readfirstlane(tid >> 6), lane = tid & 63, wr = wid >> 2, wc = wid & 3, fr = lane & 15, fq = lane >> 4;
    const int K = g.K, nt = K / BK;
    unsigned voffA[2], voffB[2];
#pragma unroll
    for (int i = 0; i < 2; ++i) { int R, C; stage_rc(tid * 16 + i * 8192, R, C); const int Rb = Epi::PERM ? ((R & ~31) + perm32(R & 31)) : R;
        voffA[i] = (unsigned)(R * K + C) * 2u; voffB[i] = (unsigned)(Rb * K + C) * 2u; }
    const size_t kstep = (size_t)(BK * 2);
    const size_t hstep = (size_t)HALF * K * 2;
    const size_t tstep = 2 * hstep;
    const unsigned ldsw = (unsigned)wid * 1024u;
    const int aoff = lds_byte(wr * 64 + fr, fq * 8), boff = lds_byte(wc * 32 + fr, fq * 8);
#define PG8_SA(b, h) (((b) * 2 + (h)) * HTB)
#define PG8_SB(b, h) ((4 + (b) * 2 + (h)) * HTB)
#define PG8_STAGE(bufoff, gbase, voff) do { _Pragma("unroll") for (int _i = 0; _i < 2; ++_i) \
        __builtin_amdgcn_global_load_lds((const unsigned*)((const char*)(gbase) + (voff)[_i]), (PG8_LAS unsigned*)(lds + (bufoff) + ldsw + _i * 8192), 16, 0, 0); } while (0)
#define PG8_LDA(dst, b, h) do { _Pragma("unroll") for (int m = 0; m < 4; ++m) _Pragma("unroll") for (int k = 0; k < 2; ++k) dst[m][k] = *(const PG8_LAS bf16x8*)(lds + PG8_SA(b, h) + aoff + m * 2048 + k * 1024); } while (0)
#define PG8_LDB(dst, b, h) do { _Pragma("unroll") for (int n = 0; n < 2; ++n) _Pragma("unroll") for (int k = 0; k < 2; ++k) dst[n][k] = *(const PG8_LAS bf16x8*)(lds + PG8_SB(b, h) + boff + n * 2048 + k * 1024); } while (0)
#define PG8_MMA(ai, bj, At, Bt) do { __builtin_amdgcn_s_setprio(1); _Pragma("unroll") for (int m = 0; m < 4; ++m) _Pragma("unroll") for (int n = 0; n < 2; ++n) _Pragma("unroll") for (int k = 0; k < 2; ++k) \
        acc[ai][bj][m][n] = __builtin_amdgcn_mfma_f32_16x16x32_bf16(Bt[n][k], At[m][k], acc[ai][bj][m][n], 0, 0, 0); __builtin_amdgcn_s_setprio(0); } while (0)
#define PG8_WAIT_V(n) asm volatile("s_waitcnt vmcnt(" #n ")" ::: "memory")
#define PG8_WAIT_L(n) asm volatile("s_waitcnt lgkmcnt(" #n ")" ::: "memory")
#define PG8_BAR __builtin_amdgcn_s_barrier()
#define PG8_SCHED __builtin_amdgcn_sched_barrier(0)
    Unit cur, nxt; int ui = 0;
    if (!S.next(0, cur)) return;
    f32x4 acc[2][2][4][2];
#pragma unroll
    for (int a = 0; a < 2; ++a)
#pragma unroll
        for (int b = 0; b < 2; ++b)
#pragma unroll
            for (int m = 0; m < 4; ++m)
#pragma unroll
                for (int n = 0; n < 2; ++n) acc[a][b][m][n] = (f32x4){0.f, 0.f, 0.f, 0.f};
    bf16x8 At[4][2], B0[2][2], B1[2][2];
    const char* cA = (const char*)g.A + (size_t)cur.pm * tstep; const char* cB = (const char*)g.Bt + (size_t)cur.pn * tstep;
    S.a_ready(cur);
    if constexpr (SP2) {
        PG8_STAGE(PG8_SB(0, 0), cB, voffB); PG8_STAGE(PG8_SB(0, 1), cB + hstep, voffB); PG8_STAGE(PG8_SA(0, 0), cA, voffA); PG8_STAGE(PG8_SA(0, 1), cA + hstep, voffA);
        if (wr == 1) PG8_BAR;
        PG8_WAIT_V(2); PG8_BAR;
        PG8_STAGE(PG8_SB(1, 0), cB + kstep, voffB); PG8_STAGE(PG8_SA(1, 0), cA + kstep, voffA); PG8_STAGE(PG8_SB(1, 1), cB + hstep + kstep, voffB);
        PG8_WAIT_V(6); PG8_BAR;
    } else {
        PG8_STAGE(PG8_SB(0, 0), cB, voffB); PG8_STAGE(PG8_SA(0, 0), cA, voffA); PG8_STAGE(PG8_SB(0, 1), cB + hstep, voffB); PG8_STAGE(PG8_SA(0, 1), cA + hstep, voffA);
        if (wr == 1) PG8_BAR;
        PG8_WAIT_V(4); PG8_BAR;
        PG8_STAGE(PG8_SB(1, 0), cB + kstep, voffB); PG8_STAGE(PG8_SA(1, 0), cA + kstep, voffA); PG8_STAGE(PG8_SB(1, 1), cB + hstep + kstep, voffB);
        PG8_WAIT_V(6); PG8_BAR;
    }
    for (;;) {
        const bool has_next = S.next(ui + 1, nxt);
        const char* nA = has_next ? (const char*)g.A + (size_t)nxt.pm * tstep : cA; const char* nB = has_next ? (const char*)g.Bt + (size_t)nxt.pn * tstep : cB;
        for (int t = 0; t < nt; t += 2) {
            const bool last = (t == nt - 2);
            const char* a1 = cA + (size_t)(t + 1) * kstep;
            const char* a2 = last ? nA : cA + (size_t)(t + 2) * kstep; const char* b2 = last ? nB : cB + (size_t)(t + 2) * kstep;
            const char* a3 = a2 + kstep; const char* b3 = b2 + kstep;
            if (last && has_next) S.a_ready(nxt);
            if constexpr (SP2) {
            PG8_LDB(B0, 0, 0); PG8_LDB(B1, 0, 1); PG8_SCHED; PG8_LDA(At, 0, 0); PG8_STAGE(PG8_SA(1, 1), a1 + hstep, voffA);
            PG8_WAIT_V(8); PG8_WAIT_L(0); PG8_BAR; PG8_MMA(0, 0, At, B0); PG8_MMA(0, 1, At, B1); PG8_BAR; PG8_SCHED;
            PG8_LDA(At, 0, 1); PG8_STAGE(PG8_SB(0, 0), b2, voffB); PG8_STAGE(PG8_SB(0, 1), b2 + hstep, voffB); PG8_STAGE(PG8_SA(0, 0), a2, voffA);
            PG8_WAIT_V(8); PG8_WAIT_L(0); PG8_BAR; PG8_MMA(1, 0, At, B0); PG8_MMA(1, 1, At, B1); PG8_BAR; PG8_SCHED;
            PG8_LDB(B0, 1, 0); PG8_LDB(B1, 1, 1); PG8_SCHED; PG8_LDA(At, 1, 0); PG8_STAGE(PG8_SA(0, 1), a2 + hstep, voffA);
            PG8_WAIT_V(8); PG8_WAIT_L(0); PG8_BAR; PG8_MMA(0, 0, At, B0); PG8_MMA(0, 1, At, B1); PG8_BAR; PG8_SCHED;
            PG8_LDA(At, 1, 1); PG8_STAGE(PG8_SB(1, 0), b3, voffB); PG8_STAGE(PG8_SB(1, 1), b3 + hstep, voffB); PG8_STAGE(PG8_SA(1, 0), a3, voffA);
            PG8_WAIT_V(8); PG8_WAIT_L(0); PG8_BAR; PG8_MMA(1, 0, At, B0); PG8_MMA(1, 1, At, B1); PG8_BAR; PG8_SCHED;
            } else {
            PG8_LDB(B0, 0, 0); PG8_SCHED; PG8_LDA(At, 0, 0); PG8_STAGE(PG8_SA(1, 1), a1 + hstep, voffA);
            PG8_WAIT_L(8); PG8_BAR; PG8_WAIT_L(0); PG8_MMA(0, 0, At, B0); PG8_BAR; PG8_SCHED;
            PG8_LDB(B1, 0, 1); PG8_STAGE(PG8_SB(0, 0), b2, voffB);
            PG8_BAR; PG8_WAIT_L(0); PG8_MMA(0, 1, At, B1); PG8_BAR;
            PG8_LDA(At, 0, 1); PG8_STAGE(PG8_SA(0, 0), a2, voffA);
            PG8_BAR; PG8_WAIT_L(0); PG8_MMA(1, 0, At, B0); PG8_BAR; PG8_SCHED;
            PG8_STAGE(PG8_SB(0, 1), b2 + hstep, voffB);
            PG8_WAIT_V(6); PG8_BAR; PG8_MMA(1, 1, At, B1); PG8_BAR;
            PG8_LDB(B0, 1, 0); PG8_SCHED; PG8_LDA(At, 1, 0); PG8_STAGE(PG8_SA(0, 1), a2 + hstep, voffA);
            PG8_WAIT_L(8); PG8_BAR; PG8_WAIT_L(0); PG8_MMA(0, 0, At, B0); PG8_BAR; PG8_SCHED;
            PG8_LDB(B1, 1, 1); PG8_STAGE(PG8_SB(1, 0), b3, voffB);
            PG8_BAR; PG8_WAIT_L(0); PG8_MMA(0, 1, At, B1); PG8_BAR;
            PG8_LDA(At, 1, 1); PG8_STAGE(PG8_SA(1, 0), a3, voffA);
            PG8_BAR; PG8_WAIT_L(0); PG8_MMA(1, 0, At, B0); PG8_BAR; PG8_SCHED;
            PG8_STAGE(PG8_SB(1, 1), b3 + hstep, voffB);
            PG8_WAIT_V(6); PG8_BAR; PG8_MMA(1, 1, At, B1); PG8_BAR;
            }
        }
        if constexpr (ALIGN_EPI) { if (wr == 0) PG8_BAR; }
        if constexpr (!Epi::AFTER_DRAIN) { E(acc, cur, wr, wc, fr, fq); S.done(cur); }
        if (!has_next) break;
#pragma unroll
        for (int a = 0; a < 2; ++a)
#pragma unroll
            for (int b = 0; b < 2; ++b)
#pragma unroll
                for (int m = 0; m < 4; ++m)
#pragma unroll
                    for (int n = 0; n < 2; ++n) acc[a][b][m][n] = (f32x4){0.f, 0.f, 0.f, 0.f};
        cur = nxt; cA = nA; cB = nB; ++ui;
        if constexpr (ALIGN_EPI) { if (wr == 1) PG8_BAR; }
    }
    PG8_WAIT_V(0);
    if constexpr (!ALIGN_EPI) { if (wr == 0) PG8_BAR; }
    PG8_BAR;
#undef PG8_SA
#undef PG8_SB
#undef PG8_STAGE
#undef PG8_LDA
#undef PG8_LDB
#undef PG8_MMA
#undef PG8_WAIT_V
#undef PG8_WAIT_L
#undef PG8_BAR
#undef PG8_SCHED
}
}

namespace mla {
constexpr int NW = 8, QBLK = 32, KVBLK = 64;
constexpr float SCALE = 0.07216878364870322f;
constexpr float THR = 8.f;
constexpr int SHM_V = 64 * 128 * 2, SHM_K = 64 * 192 * 2, SHM_ATTN = 2 * SHM_V + 2 * SHM_K + NW * 64 * 4;
constexpr int LDQ = 1536, LDKK = 1536, LDV = 2048, LDO = 1024;
#define SBAR() __builtin_amdgcn_sched_barrier(0)
__device__ __forceinline__ int crow(int r, int hi) { return (r & 3) + 8 * (r >> 2) + 4 * hi; }
__device__ __forceinline__ void partialSM(f32x16& p0, f32x16& p1, float& m_reg, float& mn, float& alpha) {
  constexpr float C = SCALE * 1.4426950408889634f;
  float pmax = p0[0];
#pragma unroll
  for (int r = 1; r < 16; ++r) pmax = fmaxf(pmax, p0[r]);
#pragma unroll
  for (int r = 0; r < 16; ++r) pmax = fmaxf(pmax, p1[r]);
  { auto rr = __builtin_amdgcn_permlane32_swap(__float_as_uint(pmax), __float_as_uint(pmax), false, false);
    pmax = fmaxf(__uint_as_float(rr[0]), __uint_as_float(rr[1])); }
  if (__builtin_expect(__all(pmax - m_reg <= THR / SCALE), 1)) { mn = m_reg; alpha = 1.f; }
  else { mn = fmaxf(m_reg, pmax); alpha = __builtin_amdgcn_exp2f((m_reg - mn) * C); m_reg = mn; }
  float mnC = -mn * C;
#pragma unroll
  for (int r = 0; r < 16; ++r) p0[r] = fmaf(p0[r], C, mnC);
#pragma unroll
  for (int r = 0; r < 16; ++r) p1[r] = fmaf(p1[r], C, mnC);
#pragma unroll
  for (int r = 0; r < 16; ++r) p0[r] = __builtin_amdgcn_exp2f(p0[r]);
}
__device__ __forceinline__ void finishSM(f32x16& p0, f32x16& p1, float alpha, float& l_reg, bf16x8& pa0, bf16x8& pa1, bf16x8& pa2, bf16x8& pa3) {
#pragma unroll
  for (int r = 0; r < 16; ++r) p1[r] = __builtin_amdgcn_exp2f(p1[r]);
  float ps = 0;
#pragma unroll
  for (int r = 0; r < 16; ++r) ps += p0[r];
#pragma unroll
  for (int r = 0; r < 16; ++r) ps += p1[r];
  { auto rr = __builtin_amdgcn_permlane32_swap(__float_as_uint(ps), __float_as_uint(ps), false, false);
    ps = __uint_as_float(rr[0]) + __uint_as_float(rr[1]); }
  l_reg = l_reg * alpha + ps;
#define PK4(P, BASE, OUT) do { unsigned a0 = cvt_pk_bf16(P[BASE + 0], P[BASE + 1]), a1 = cvt_pk_bf16(P[BASE + 2], P[BASE + 3]);   \
    unsigned b0 = cvt_pk_bf16(P[BASE + 4], P[BASE + 5]), b1 = cvt_pk_bf16(P[BASE + 6], P[BASE + 7]);                              \
    auto r0 = __builtin_amdgcn_permlane32_swap(a0, b0, false, false); auto r1 = __builtin_amdgcn_permlane32_swap(a1, b1, false, false); \
    u32x4 w = {r0[0], r1[0], r0[1], r1[1]}; OUT = *reinterpret_cast<bf16x8*>(&w); } while (0)
  PK4(p0, 0, pa0); PK4(p0, 8, pa1); PK4(p1, 0, pa2); PK4(p1, 8, pa3);
#undef PK4
}
__device__ __forceinline__ void qkt(f32x16& p0, f32x16& p1, const char* Ks, const bf16x8* qr, const int* kb4) {
  p0 = f32x16{}; p1 = f32x16{};
#pragma unroll
  for (int d0 = 0; d0 < 12; ++d0) {
    bf16x8 b0 = *reinterpret_cast<const bf16x8*>(Ks + kb4[d0 & 3] + (d0 >> 2) * 128);
    bf16x8 b1 = *reinterpret_cast<const bf16x8*>(Ks + kb4[d0 & 3] + (d0 >> 2) * 128 + 32 * 384);
    p0 = __builtin_amdgcn_mfma_f32_32x32x16_bf16(b0, qr[d0], p0, 0, 0, 0);
    p1 = __builtin_amdgcn_mfma_f32_32x32x16_bf16(b1, qr[d0], p1, 0, 0, 0); }
}
__device__ __forceinline__ int v_st(int k, int c) { const int kk = (k & ~0xC) | ((k & 4) << 1) | ((k & 8) >> 1); return ((kk >> 3) * 4 + (c >> 5)) * 512 + ((kk & 7) * 32 + (c & 31)) * 2; }
__device__ __forceinline__ int v_rd_base(int lane) { return ((lane & 3) << 3) | (((lane >> 2) & 3) << 6) | (((lane >> 4) & 1) << 5) | (((lane >> 5) & 1) << 8); }
constexpr int v_rd_off(int d0, int ks, int half) { return d0 * 512 + ks * 4096 + half * 2048; }
template <int OFF> __device__ __forceinline__ s16x4 tr_read(int vb) {
  s16x4 r; asm volatile("ds_read_b64_tr_b16 %0, %1 offset:%2" : "=&v"(r) : "v"(vb), "i"(OFF) : "memory"); return r;
}
template <int D0> __device__ __forceinline__ void pv_one(f32x16& od, int vb, bf16x8 pa0, bf16x8 pa1, bf16x8 pa2, bf16x8 pa3) {
  const s16x4 l0 = tr_read<v_rd_off(D0, 0, 0)>(vb), h0 = tr_read<v_rd_off(D0, 0, 1)>(vb), l1 = tr_read<v_rd_off(D0, 1, 0)>(vb), h1 = tr_read<v_rd_off(D0, 1, 1)>(vb);
  const s16x4 l2 = tr_read<v_rd_off(D0, 2, 0)>(vb), h2 = tr_read<v_rd_off(D0, 2, 1)>(vb), l3 = tr_read<v_rd_off(D0, 3, 0)>(vb), h3 = tr_read<v_rd_off(D0, 3, 1)>(vb);
  asm volatile("s_waitcnt lgkmcnt(0)" ::: "memory"); SBAR();
#define PK(L, H) (bf16x8){L[0], L[1], L[2], L[3], H[0], H[1], H[2], H[3]}
  od = __builtin_amdgcn_mfma_f32_32x32x16_bf16(pa0, PK(l0, h0), od, 0, 0, 0);
  od = __builtin_amdgcn_mfma_f32_32x32x16_bf16(pa1, PK(l1, h1), od, 0, 0, 0);
  od = __builtin_amdgcn_mfma_f32_32x32x16_bf16(pa2, PK(l2, h2), od, 0, 0, 0);
  od = __builtin_amdgcn_mfma_f32_32x32x16_bf16(pa3, PK(l3, h3), od, 0, 0, 0);
#undef PK
}
__device__ __forceinline__ void pv_d0(f32x16* o, int vb, bf16x8 pa0, bf16x8 pa1, bf16x8 pa2, bf16x8 pa3) {
  pv_one<0>(o[0], vb, pa0, pa1, pa2, pa3); pv_one<1>(o[1], vb, pa0, pa1, pa2, pa3); pv_one<2>(o[2], vb, pa0, pa1, pa2, pa3); pv_one<3>(o[3], vb, pa0, pa1, pa2, pa3);
}

__device__ __forceinline__ void attn_unit(const bf16_t* __restrict__ Qb, const bf16_t* __restrict__ Kh, const bf16_t* __restrict__ Vh,
                                          bf16_t* __restrict__ Ob, int metaRow, int realRow0, char* lds, const int tid) {
  const int wid = tid >> 6, lane = tid & 63, r32 = lane & 31, hi = lane >> 5;
  char* V_lds = lds; char* K_lds = lds + 2 * SHM_V;
  float* ws = (float*)(lds + 2 * SHM_V + 2 * SHM_K) + wid * 64; float* li_l = ws; float* al_l = ws + 32;
  float m_reg = -1e30f, l_reg = 0; f32x16 o[4] = {}; bf16x8 qr[12];
  const bf16_t* Qw = Qb + (long)(wid * QBLK + r32) * LDQ + hi * 8;
#pragma unroll
  for (int d0 = 0; d0 < 12; ++d0) qr[d0] = *reinterpret_cast<const bf16x8*>(Qw + d0 * 16);
  const int sr = tid >> 3, vc = (tid & 7) * 8, vst0 = v_st(sr, vc);
  const int vgo0 = sr * LDV + vc;
  const int kgo0 = sr * LDKK + vc, klo0 = sr * 384 + ((vc * 2) ^ (((sr >> 1) & 7) << 4));
  int kb4[4];
#pragma unroll
  for (int q = 0; q < 4; ++q) kb4[q] = r32 * 384 + ((q * 32 + hi * 16) ^ (((r32 >> 1) & 7) << 4));
  const int vb0 = (int)(uintptr_t)V_lds + v_rd_base(lane);
  bf16x8 vs0, vs1, ks0, ks1, ks2;
#define TROW(t) ((t) == 0 ? (long)metaRow : (long)realRow0 + (long)((t) - 1) * KVBLK)
#define SLOAD(t) do { const long r0_ = TROW(t); const bf16_t* vp_ = Vh + r0_ * LDV + vgo0; const bf16_t* kp_ = Kh + r0_ * LDKK + kgo0; \
    vs0 = *reinterpret_cast<const bf16x8*>(vp_); vs1 = *reinterpret_cast<const bf16x8*>(vp_ + 64); \
    ks0 = *reinterpret_cast<const bf16x8*>(kp_); ks1 = *reinterpret_cast<const bf16x8*>(kp_ + 64); ks2 = *reinterpret_cast<const bf16x8*>(kp_ + 128); } while (0)
#define SWRITE(b) do { *(bf16x8*)(V_lds + (b) * SHM_V + vst0) = vs0; *(bf16x8*)(V_lds + (b) * SHM_V + vst0 + 1024) = vs1; \
    *(bf16x8*)(K_lds + (b) * SHM_K + klo0) = ks0; *(bf16x8*)(K_lds + (b) * SHM_K + klo0 + 128) = ks1; *(bf16x8*)(K_lds + (b) * SHM_K + klo0 + 256) = ks2; } while (0)
#define SWAIT() asm volatile("s_waitcnt vmcnt(0)" ::: "memory")
#define BARL() asm volatile("s_waitcnt lgkmcnt(0)\n\ts_barrier" ::: "memory")
#define RESC(a) do { if (__any((a) < 1.f)) { if (hi == 0) al_l[r32] = (a); asm volatile("s_waitcnt lgkmcnt(0)" ::: "memory"); \
    _Pragma("unroll") for (int d = 0; d < 4; ++d) _Pragma("unroll") for (int r = 0; r < 16; ++r) o[d][r] *= al_l[crow(r, hi)]; } } while (0)
  f32x16 pA0, pA1, pB0, pB1; float mnA, mnB, alA, alB; bf16x8 pa0, pa1, pa2, pa3; constexpr int NT = NCHUNK;
  SLOAD(0); SWAIT(); SWRITE(0); __syncthreads();
  qkt(pA0, pA1, K_lds, qr, kb4);
#pragma unroll
  for (int r = 8; r < 16; ++r) pA0[r] = -1e30f;
#pragma unroll
  for (int r = 0; r < 16; ++r) pA1[r] = -1e30f;
  partialSM(pA0, pA1, m_reg, mnA, alA);
  SLOAD(1); SWAIT(); SWRITE(1); SLOAD(2); BARL();
  for (int j = 1; j + 1 < NT; j += 2) {
    SBAR(); qkt(pB0, pB1, K_lds + SHM_K, qr, kb4);
    finishSM(pA0, pA1, alA, l_reg, pa0, pa1, pa2, pa3); SBAR();
    pv_d0(o, vb0, pa0, pa1, pa2, pa3); partialSM(pB0, pB1, m_reg, mnB, alB);
    BARL(); SWAIT(); SWRITE(0); if (j + 2 < NT) SLOAD(j + 2);
    RESC(alB); BARL();
    SBAR(); qkt(pA0, pA1, K_lds, qr, kb4);
    finishSM(pB0, pB1, alB, l_reg, pa0, pa1, pa2, pa3); SBAR();
    pv_d0(o, vb0 + (int)SHM_V, pa0, pa1, pa2, pa3); partialSM(pA0, pA1, m_reg, mnA, alA);
    BARL(); if (j + 2 < NT) { SWAIT(); SWRITE(1); } if (j + 3 < NT) SLOAD(j + 3);
    RESC(alA); BARL();
  }
  finishSM(pA0, pA1, alA, l_reg, pa0, pa1, pa2, pa3); SBAR();
  pv_d0(o, vb0, pa0, pa1, pa2, pa3);
  if (hi == 0) li_l[r32] = l_reg; asm volatile("s_waitcnt lgkmcnt(0)" ::: "memory");
  float rli[16];
#pragma unroll
  for (int r = 0; r < 16; ++r) rli[r] = __builtin_amdgcn_rcpf(li_l[crow(r, hi)]);
  bf16_t* Ow = Ob + (long)(wid * QBLK) * LDO;
#pragma unroll
  for (int r = 0; r < 16; ++r) { const int orow = crow(r, hi);
#pragma unroll
    for (int d0 = 0; d0 < 4; ++d0) Ow[(long)orow * LDO + d0 * 32 + r32] = f2bf(o[d0][r] * rli[r]); }
  __syncthreads();
#undef TROW
#undef SLOAD
#undef SWRITE
#undef SWAIT
#undef RESC
}


__device__ __forceinline__ void qkt2(f32x16& p0, f32x16& p1, const char* Ks, const bf16x8* qr, const int* kb4) {
#define KLD(d, half) (*reinterpret_cast<const bf16x8*>(Ks + kb4[(d) & 3] + ((d) >> 2) * 128 + (half) * 12288))
  p0 = f32x16{}; p1 = f32x16{};
  bf16x8 a0 = KLD(0, 0), b0 = KLD(0, 1), a1 = KLD(1, 0), b1 = KLD(1, 1), a2, b2;
#define QSTEP(d, A, B, NA, NB) do { if ((d) + 2 < 12) { NA = KLD((d) + 2, 0); NB = KLD((d) + 2, 1); } SBAR(); \
    p0 = __builtin_amdgcn_mfma_f32_32x32x16_bf16(A, qr[d], p0, 0, 0, 0); p1 = __builtin_amdgcn_mfma_f32_32x32x16_bf16(B, qr[d], p1, 0, 0, 0); SBAR(); } while (0)
  QSTEP(0, a0, b0, a2, b2); QSTEP(1, a1, b1, a0, b0); QSTEP(2, a2, b2, a1, b1);
  QSTEP(3, a0, b0, a2, b2); QSTEP(4, a1, b1, a0, b0); QSTEP(5, a2, b2, a1, b1);
  QSTEP(6, a0, b0, a2, b2); QSTEP(7, a1, b1, a0, b0); QSTEP(8, a2, b2, a1, b1);
  QSTEP(9, a0, b0, a2, b2); QSTEP(10, a1, b1, a0, b0); QSTEP(11, a2, b2, a1, b1);
#undef QSTEP
#undef KLD
}
struct VSet { s16x4 l0, h0, l1, h1, l2, h2, l3, h3; };
template <int D0> __device__ __forceinline__ void v_issue(VSet& s, int vb) {
  s.l0 = tr_read<v_rd_off(D0, 0, 0)>(vb); s.h0 = tr_read<v_rd_off(D0, 0, 1)>(vb); s.l1 = tr_read<v_rd_off(D0, 1, 0)>(vb); s.h1 = tr_read<v_rd_off(D0, 1, 1)>(vb);
  s.l2 = tr_read<v_rd_off(D0, 2, 0)>(vb); s.h2 = tr_read<v_rd_off(D0, 2, 1)>(vb); s.l3 = tr_read<v_rd_off(D0, 3, 0)>(vb); s.h3 = tr_read<v_rd_off(D0, 3, 1)>(vb);
}
__device__ __forceinline__ void v_mma(f32x16& od, VSet& s, bf16x8 pa0, bf16x8 pa1, bf16x8 pa2, bf16x8 pa3) {
  asm volatile("" : "+v"(s.l0), "+v"(s.h0), "+v"(s.l1), "+v"(s.h1), "+v"(s.l2), "+v"(s.h2), "+v"(s.l3), "+v"(s.h3));
#define PK(L, H) (bf16x8){L[0], L[1], L[2], L[3], H[0], H[1], H[2], H[3]}
  od = __builtin_amdgcn_mfma_f32_32x32x16_bf16(pa0, PK(s.l0, s.h0), od, 0, 0, 0);
  od = __builtin_amdgcn_mfma_f32_32x32x16_bf16(pa1, PK(s.l1, s.h1), od, 0, 0, 0);
  od = __builtin_amdgcn_mfma_f32_32x32x16_bf16(pa2, PK(s.l2, s.h2), od, 0, 0, 0);
  od = __builtin_amdgcn_mfma_f32_32x32x16_bf16(pa3, PK(s.l3, s.h3), od, 0, 0, 0);
#undef PK
}
__device__ __forceinline__ void pv2(f32x16* o, int vb, bf16x8 pa0, bf16x8 pa1, bf16x8 pa2, bf16x8 pa3) {
  VSet X, Y;
  SBAR(); v_issue<0>(X, vb); v_issue<1>(Y, vb);
  asm volatile("s_waitcnt lgkmcnt(8)" ::: "memory"); SBAR(); v_mma(o[0], X, pa0, pa1, pa2, pa3); SBAR();
  v_issue<2>(X, vb);
  asm volatile("s_waitcnt lgkmcnt(8)" ::: "memory"); SBAR(); v_mma(o[1], Y, pa0, pa1, pa2, pa3); SBAR();
  v_issue<3>(Y, vb);
  asm volatile("s_waitcnt lgkmcnt(8)" ::: "memory"); SBAR(); v_mma(o[2], X, pa0, pa1, pa2, pa3); SBAR();
  asm volatile("s_waitcnt lgkmcnt(0)" ::: "memory"); SBAR(); v_mma(o[3], Y, pa0, pa1, pa2, pa3); SBAR();
}
__device__ __forceinline__ void attn_unit2(const bf16_t* __restrict__ Qb, const bf16_t* __restrict__ Kh, const bf16_t* __restrict__ Vh,
                                           bf16_t* __restrict__ Ob, int metaRow, int realRow0, char* lds, const int tid,
                                           const float* __restrict__ qgain, const float* __restrict__ tab, int pos0) {
  const int wid = __builtin_amdgcn_readfirstlane(tid >> 6), lane = tid & 63, r32 = lane & 31, hi = lane >> 5;
  char* V_lds = lds; char* K_lds = lds + 2 * SHM_V;
  float* ws = (float*)(lds + 2 * SHM_V + 2 * SHM_K) + wid * 64; float* li_l = ws; float* al_l = ws + 32;
  float m_reg = -1e30f, l_reg = 0; f32x16 o[4] = {}; bf16x8 qr[12];
  const bf16_t* Qw = Qb + (long)(wid * QBLK + r32) * LDQ + hi * 8;
#pragma unroll
  for (int d0 = 0; d0 < 12; ++d0) qr[d0] = *reinterpret_cast<const bf16x8*>(Qw + d0 * 16);
  {
    float ss = 0.f;
#pragma unroll
    for (int d0 = 0; d0 < 12; ++d0) { const u32x4 v = __builtin_bit_cast(u32x4, qr[d0]);
      const float f0 = bflo(v.x), f1 = bfhi(v.x), f2 = bflo(v.y), f3 = bfhi(v.y), f4 = bflo(v.z), f5 = bfhi(v.z), f6 = bflo(v.w), f7 = bfhi(v.w);
      ss += (f0 * f0 + f1 * f1) + (f2 * f2 + f3 * f3) + (f4 * f4 + f5 * f5) + (f6 * f6 + f7 * f7); }
    { auto rr = __builtin_amdgcn_permlane32_swap(__float_as_uint(ss), __float_as_uint(ss), false, false); ss = __uint_as_float(rr[0]) + __uint_as_float(rr[1]); }
    const float rs = __builtin_amdgcn_rsqf(ss * (1.f / 192.f) + EPS);
#pragma unroll
    for (int d0 = 0; d0 < 8; ++d0) { const u32x4 v = __builtin_bit_cast(u32x4, qr[d0]); const float* gp = qgain + 16 * d0 + 8 * hi; const f32x4 g0 = *(const f32x4*)gp, g1 = *(const f32x4*)(gp + 4);
      u32x4 w; w.x = cvt_pk_bf16(bflo(v.x) * rs * g0.x, bfhi(v.x) * rs * g0.y); w.y = cvt_pk_bf16(bflo(v.y) * rs * g0.z, bfhi(v.y) * rs * g0.w);
      w.z = cvt_pk_bf16(bflo(v.z) * rs * g1.x, bfhi(v.z) * rs * g1.y); w.w = cvt_pk_bf16(bflo(v.w) * rs * g1.z, bfhi(v.w) * rs * g1.w); qr[d0] = __builtin_bit_cast(bf16x8, w); }
    const float* tb = tab + ((size_t)(pos0 + wid * QBLK + r32) * 32 + 8 * hi) * 2;
#pragma unroll
    for (int dd = 0; dd < 2; ++dd) {
      const u32x4 va = __builtin_bit_cast(u32x4, qr[8 + dd]), vb = __builtin_bit_cast(u32x4, qr[10 + dd]);
      const float* ga = qgain + 128 + 16 * dd + 8 * hi; const float* gb = ga + 32; const float* tc = tb + 32 * dd;
      const f32x4 a0 = *(const f32x4*)ga, a1 = *(const f32x4*)(ga + 4), b0 = *(const f32x4*)gb, b1 = *(const f32x4*)(gb + 4);
      const f32x4 c0 = *(const f32x4*)tc, c1 = *(const f32x4*)(tc + 4), c2 = *(const f32x4*)(tc + 8), c3 = *(const f32x4*)(tc + 12);
      const float x0 = bflo(va.x) * rs * a0.x, x1 = bfhi(va.x) * rs * a0.y, x2 = bflo(va.y) * rs * a0.z, x3 = bfhi(va.y) * rs * a0.w, x4 = bflo(va.z) * rs * a1.x, x5 = bfhi(va.z) * rs * a1.y, x6 = bflo(va.w) * rs * a1.z, x7 = bfhi(va.w) * rs * a1.w;
      const float y0 = bflo(vb.x) * rs * b0.x, y1 = bfhi(vb.x) * rs * b0.y, y2 = bflo(vb.y) * rs * b0.z, y3 = bfhi(vb.y) * rs * b0.w, y4 = bflo(vb.z) * rs * b1.x, y5 = bfhi(vb.z) * rs * b1.y, y6 = bflo(vb.w) * rs * b1.z, y7 = bfhi(vb.w) * rs * b1.w;
      u32x4 wa, wb;
      wa.x = cvt_pk_bf16(x0 * c0.x - y0 * c0.y, x1 * c0.z - y1 * c0.w); wa.y = cvt_pk_bf16(x2 * c1.x - y2 * c1.y, x3 * c1.z - y3 * c1.w);
      wa.z = cvt_pk_bf16(x4 * c2.x - y4 * c2.y, x5 * c2.z - y5 * c2.w); wa.w = cvt_pk_bf16(x6 * c3.x - y6 * c3.y, x7 * c3.z - y7 * c3.w);
      wb.x = cvt_pk_bf16(y0 * c0.x + x0 * c0.y, y1 * c0.z + x1 * c0.w); wb.y = cvt_pk_bf16(y2 * c1.x + x2 * c1.y, y3 * c1.z + x3 * c1.w);
      wb.z = cvt_pk_bf16(y4 * c2.x + x4 * c2.y, y5 * c2.z + x5 * c2.w); wb.w = cvt_pk_bf16(y6 * c3.x + x6 * c3.y, y7 * c3.z + x7 * c3.w);
      qr[8 + dd] = __builtin_bit_cast(bf16x8, wa); qr[10 + dd] = __builtin_bit_cast(bf16x8, wb); }
  }
  const int sr = tid >> 3, vc = (tid & 7) * 8, vst0 = v_st(sr, vc);
  const int vgo0 = sr * LDV + vc;
  const int kgo0 = sr * LDKK + vc, klo0 = sr * 384 + ((vc * 2) ^ (((sr >> 1) & 7) << 4));
  int kb4[4];
#pragma unroll
  for (int q = 0; q < 4; ++q) kb4[q] = r32 * 384 + ((q * 32 + hi * 16) ^ (((r32 >> 1) & 7) << 4));
  const int vb0 = (int)(uintptr_t)V_lds + v_rd_base(lane);
  bf16x8 vs0, vs1, ks0, ks1, ks2;
#define TROW(t) ((t) == 0 ? (long)metaRow : (long)realRow0 + (long)((t) - 1) * KVBLK)
#define SLOAD(t) do { const long r0_ = TROW(t); const bf16_t* vp_ = Vh + r0_ * LDV + vgo0; const bf16_t* kp_ = Kh + r0_ * LDKK + kgo0; \
    vs0 = *reinterpret_cast<const bf16x8*>(vp_); vs1 = *reinterpret_cast<const bf16x8*>(vp_ + 64); \
    ks0 = *reinterpret_cast<const bf16x8*>(kp_); ks1 = *reinterpret_cast<const bf16x8*>(kp_ + 64); ks2 = *reinterpret_cast<const bf16x8*>(kp_ + 128); } while (0)
#define SWRITE(b) do { *(bf16x8*)(V_lds + (b) * SHM_V + vst0) = vs0; *(bf16x8*)(V_lds + (b) * SHM_V + vst0 + 1024) = vs1; \
    *(bf16x8*)(K_lds + (b) * SHM_K + klo0) = ks0; *(bf16x8*)(K_lds + (b) * SHM_K + klo0 + 128) = ks1; *(bf16x8*)(K_lds + (b) * SHM_K + klo0 + 256) = ks2; } while (0)
#define SWAIT() asm volatile("s_waitcnt vmcnt(0)" ::: "memory")
#define BARRIER() asm volatile("s_waitcnt lgkmcnt(0)\n\ts_barrier" ::: "memory")
#define RESC(a) do { if (__any((a) < 1.f)) { if (hi == 0) al_l[r32] = (a); asm volatile("s_waitcnt lgkmcnt(0)" ::: "memory"); \
    _Pragma("unroll") for (int d = 0; d < 4; ++d) _Pragma("unroll") for (int r = 0; r < 16; ++r) o[d][r] *= al_l[crow(r, hi)]; } } while (0)
#define MASK0() do { _Pragma("unroll") for (int r = 8; r < 16; ++r) p0[r] = -1e30f; _Pragma("unroll") for (int r = 0; r < 16; ++r) p1[r] = -1e30f; } while (0)
  f32x16 p0, p1; float mn, al = 1.f; bf16x8 pa0, pa1, pa2, pa3; constexpr int NT = NCHUNK;
  SLOAD(0); SWAIT(); SWRITE(0); BARRIER();
#define S1(t, CUR) do { SBAR(); qkt2(p0, p1, K_lds + (CUR) * SHM_K, qr, kb4); if ((t) == 0) MASK0(); partialSM(p0, p1, m_reg, mn, al); } while (0)
#define S2(t, CUR) do { RESC(al); finishSM(p0, p1, al, l_reg, pa0, pa1, pa2, pa3); SBAR(); pv2(o, vb0 + (CUR) * (int)SHM_V, pa0, pa1, pa2, pa3); } while (0)
  if (wid < 4) {
#define A_TILE(t, CUR) do { S1(t, CUR); BARRIER(); \
      if ((t) + 1 < NT) { SWAIT(); SWRITE((CUR) ^ 1); if ((t) + 2 < NT) SLOAD((t) + 2); } S2(t, CUR); BARRIER(); } while (0)
    SLOAD(1);
    for (int t = 0; t + 1 < NT; t += 2) { A_TILE(t, 0); A_TILE(t + 1, 1); }
    A_TILE(NT - 1, 0);
    BARRIER();
#undef A_TILE
  } else {
    SLOAD(1); BARRIER();
#define B_TILE(t, CUR) do { if ((t) + 1 < NT) { SWAIT(); SWRITE((CUR) ^ 1); if ((t) + 2 < NT) SLOAD((t) + 2); } S1(t, CUR); BARRIER(); \
      S2(t, CUR); BARRIER(); } while (0)
    for (int t = 0; t + 1 < NT; t += 2) { B_TILE(t, 0); B_TILE(t + 1, 1); }
    B_TILE(NT - 1, 0);
#undef B_TILE
  }
  if (hi == 0) li_l[r32] = l_reg; asm volatile("s_waitcnt lgkmcnt(0)" ::: "memory");
  float rli[16];
#pragma unroll
  for (int r = 0; r < 16; ++r) rli[r] = __builtin_amdgcn_rcpf(li_l[crow(r, hi)]);
  bf16_t* Ow = Ob + (long)(wid * QBLK) * LDO;
#pragma unroll
  for (int r = 0; r < 16; ++r) { const int orow = crow(r, hi);
#pragma unroll
    for (int d0 = 0; d0 < 4; ++d0) Ow[(long)orow * LDO + d0 * 32 + r32] = f2bf(o[d0][r] * rli[r]); }
  __syncthreads();
#undef TROW
#undef SLOAD
#undef SWRITE
#undef SWAIT
#undef BARRIER
#undef RESC
#undef MASK0
#undef S1
#undef S2
}
#undef SBAR
}


#define XB_TMO      128
#define XB_XCNT(j)  (256  + 64 * (j))
#define XB_XSUB(j)  (1280 + 64 * (j))
#define XB_XGEN(j)  (2304 + 64 * (j))
#define XB_TOP      3328
#define XB_TOPGEN   3392
#define XCD_BAR_WORDS 3456
#define XB_SPIN_CAP (1u << 18)
__device__ __forceinline__ unsigned xb_ld(unsigned* p)              { return __hip_atomic_load(p, __ATOMIC_RELAXED, __HIP_MEMORY_SCOPE_AGENT); }
__device__ __forceinline__ unsigned xb_add(unsigned* p, unsigned v) { return __hip_atomic_fetch_add(p, v, __ATOMIC_RELAXED, __HIP_MEMORY_SCOPE_AGENT); }
__device__ __forceinline__ unsigned xb_xcc_id() { return (unsigned)__builtin_amdgcn_s_getreg((3 << 11) | 20) & 0xFu; }
#define XB_SPIN(cond, bar) do { unsigned _sp = 0; while (cond) { __builtin_amdgcn_s_sleep(1); \
    if ((++_sp & 255u) == 0u) { if (xb_ld(&(bar)[XB_TMO])) break; if (_sp > XB_SPIN_CAP) { atomicAdd(&(bar)[XB_TMO], 1u); break; } } } } while (0)
struct XcdBarrier { unsigned* bar; unsigned x; volatile LAS unsigned* st; };
__device__ __forceinline__ XcdBarrier xcd_barrier_post(unsigned* bar, volatile LAS unsigned* st) {
    XcdBarrier b; b.bar = bar; b.x = xb_xcc_id(); b.st = st;
    if (threadIdx.x == 0) (void)xb_add(&bar[XB_XCNT(b.x)], 1u);
    return b;
}
__device__ __forceinline__ void xcd_barrier_complete(unsigned* bar, unsigned x, unsigned& nloc, unsigned& nx) {
    const unsigned G = gridDim.x * gridDim.y * gridDim.z;
    unsigned sum, cnt, mine, sp = 0u;
    for (;;) {
        sum = 0u; cnt = 0u; mine = 0u;
#pragma unroll
        for (unsigned j = 0; j < 16; ++j) { const unsigned c = xb_ld(&bar[XB_XCNT(j)]); sum += c; cnt += (c > 0u) ? 1u : 0u; mine = (j == x) ? c : mine; }
        if (sum == G) break;
        __builtin_amdgcn_s_sleep(1);
        if ((++sp & 255u) == 0u) { if (xb_ld(&bar[XB_TMO])) break; if (sp > XB_SPIN_CAP) { atomicAdd(&bar[XB_TMO], 1u); break; } }
    }
    nloc = mine > 0u ? mine : 1u; nx = cnt > 0u ? cnt : 1u;
}
__device__ __forceinline__ void xcd_barrier(const XcdBarrier& b) {
    asm volatile("s_waitcnt vmcnt(0)" ::: "memory");
    __syncthreads();
    if (threadIdx.x == 0) {
        unsigned* bar = b.bar;
        __builtin_amdgcn_s_waitcnt(0);
        unsigned nloc = b.st[0], nx = b.st[1];
        if (nloc == 0u) { xcd_barrier_complete(bar, b.x, nloc, nx); b.st[0] = nloc; b.st[1] = nx; }
        const unsigned old = xb_add(&bar[XB_XSUB(b.x)], 1u);
        const unsigned gen = old / nloc;
        if (old + 1u == (gen + 1u) * nloc) {
            __builtin_amdgcn_fence(__ATOMIC_RELEASE, "agent");
            asm volatile("s_waitcnt vmcnt(0)" ::: "memory");
            const unsigned og = xb_add(&bar[XB_TOP], 1u);
            const unsigned tg = og / nx;
            if (og + 1u == (tg + 1u) * nx) xb_add(&bar[XB_TOPGEN], 1u);
            else XB_SPIN(xb_ld(&bar[XB_TOPGEN]) == tg, bar);
            __builtin_amdgcn_fence(__ATOMIC_ACQUIRE, "agent");
            xb_add(&bar[XB_XGEN(b.x)], 1u);
            asm volatile("s_waitcnt vmcnt(0)" ::: "memory");
        } else {
            XB_SPIN(xb_ld(&bar[XB_XGEN(b.x)]) == gen, bar);
            __builtin_amdgcn_fence(__ATOMIC_ACQUIRE, "agent");
            asm volatile("s_waitcnt vmcnt(0)" ::: "memory");
        }
    }
    __syncthreads();
}

struct Args {
    const float *x, *meta, *mix_g, *w_in, *na_q_g, *na_k_g, *rpb, *meta_bias, *cq_g, *ckv_g, *w_q_up, *w_kv_up, *mq_g, *mk_g, *na_out_g, *mla_out_g, *w_out, *ffn_g, *w_gate, *w_up, *conv_w, *conv_b, *w_down;
    float* out; unsigned char* ws;
};
constexpr int LDS_BYTES = 135168;

__device__ __forceinline__ void tr_item(const float* __restrict__ W, int ldw, int c0, int ncb, int K, bf16_t* __restrict__ WT, int row_off, LAS float* scr, int item, int lane, const float* __restrict__ kgain = nullptr) {
    const int kb = item / ncb, nb = item % ncb, k0 = 64 * kb, n0 = 32 * nb;
    float tv[32];
#pragma unroll
    for (int i = 0; i < 32; ++i) { const int kk = 2 * i + (lane >> 5); tv[i] = W[(size_t)(k0 + kk) * ldw + c0 + n0 + (lane & 31)]; }
    if (kgain) {
#pragma unroll
        for (int i = 0; i < 32; ++i) { const int kk = 2 * i + (lane >> 5); tv[i] *= kgain[k0 + kk]; } }
#pragma unroll
    for (int i = 0; i < 32; ++i) { const int kk = 2 * i + (lane >> 5); scr[kk * 33 + (lane & 31)] = tv[i]; }
    asm volatile("s_waitcnt lgkmcnt(0)" ::: "memory");
    const int c = lane & 7;
#pragma unroll
    for (int j = 0; j < 4; ++j) { const int n = (lane >> 3) + 8 * j; const LAS float* s = scr + (8 * c) * 33 + n;
        u32x4 o; o.x = cvt_pk_bf16(s[0 * 33], s[1 * 33]); o.y = cvt_pk_bf16(s[2 * 33], s[3 * 33]); o.z = cvt_pk_bf16(s[4 * 33], s[5 * 33]); o.w = cvt_pk_bf16(s[6 * 33], s[7 * 33]);
        *(u32x4*)(WT + (size_t)(row_off + n0 + n) * K + k0 + 8 * c) = o; }
    asm volatile("s_waitcnt lgkmcnt(0)" ::: "memory");
}

__device__ __forceinline__ void rms_row_f32(const float* __restrict__ src, const float* __restrict__ gain, bf16_t* __restrict__ dst, int lane) {
    f32x4 v[8]; float s = 0.f;
#pragma unroll
    for (int j = 0; j < 8; ++j) { v[j] = *(const f32x4*)(src + 4 * lane + 256 * j); s += (v[j].x * v[j].x + v[j].y * v[j].y) + (v[j].z * v[j].z + v[j].w * v[j].w); }
    const float rs = __builtin_amdgcn_rsqf(wave_sum(s) * (1.f / DM) + EPS);
#pragma unroll
    for (int j = 0; j < 8; ++j) { const f32x4 g = *(const f32x4*)(gain + 4 * lane + 256 * j); u32x2 w; w.x = cvt_pk_bf16(v[j].x * rs * g.x, v[j].y * rs * g.y); w.y = cvt_pk_bf16(v[j].z * rs * g.z, v[j].w * rs * g.w);
        *(u32x2*)(dst + 4 * lane + 256 * j) = w; }
}

__device__ __forceinline__ void na_norm_q(bf16x8 (&qf)[4], const float* __restrict__ gq, int g) {
    float f[4][8]; float ss = 0.f;
#pragma unroll
    for (int ds = 0; ds < 4; ++ds) { const u32x4 v = __builtin_bit_cast(u32x4, qf[ds]);
        f[ds][0] = bflo(v.x); f[ds][1] = bfhi(v.x); f[ds][2] = bflo(v.y); f[ds][3] = bfhi(v.y); f[ds][4] = bflo(v.z); f[ds][5] = bfhi(v.z); f[ds][6] = bflo(v.w); f[ds][7] = bfhi(v.w);
#pragma unroll
        for (int e = 0; e < 8; ++e) ss += f[ds][e] * f[ds][e]; }
    ss += __shfl_xor(ss, 16); ss += __shfl_xor(ss, 32);
    const float rs = __builtin_amdgcn_rsqf(ss * (1.f / 128.f) + EPS);
#pragma unroll
    for (int ds = 0; ds < 4; ++ds) { const f32x4 g0 = *(const f32x4*)(gq + 32 * ds + 8 * g), g1 = *(const f32x4*)(gq + 32 * ds + 8 * g + 4);
        u32x4 w; w.x = cvt_pk_bf16(f[ds][0] * rs * g0.x, f[ds][1] * rs * g0.y); w.y = cvt_pk_bf16(f[ds][2] * rs * g0.z, f[ds][3] * rs * g0.w);
        w.z = cvt_pk_bf16(f[ds][4] * rs * g1.x, f[ds][5] * rs * g1.y); w.w = cvt_pk_bf16(f[ds][6] * rs * g1.z, f[ds][7] * rs * g1.w);
        qf[ds] = __builtin_bit_cast(bf16x8, w); }
}

__global__ void __launch_bounds__(512, 2) fwd_kernel(Args P) {
    extern __shared__ __attribute__((aligned(16))) unsigned char lds[];
    cg::grid_group grid = cg::this_grid();
    volatile LAS unsigned* bst = (volatile LAS unsigned*)((LAS unsigned char*)lds + 131072 + 64);
    if (threadIdx.x < 2) bst[threadIdx.x] = 0u;
    __syncthreads();
    const XcdBarrier xbar = xcd_barrier_post((unsigned*)P.ws, bst);
    const int wid0 = __builtin_amdgcn_readfirstlane((int)threadIdx.x >> 6);
    const int G = gridDim.x, NGW = G * 8;
#define CAS __attribute__((address_space(4)))
#define PH_BEGIN const CAS Args* pa_ = (const CAS Args*)__builtin_amdgcn_kernarg_segment_ptr(); asm volatile("" : "+s"(pa_)); const CAS Args& P = *pa_; (void)P;   \
    int tid; asm volatile("v_mbcnt_lo_u32_b32 %0, -1, 0\n\tv_mbcnt_hi_u32_b32 %0, -1, %0" : "=v"(tid)); tid += wid0 * 64;     const int lane = tid & 63, wid = __builtin_amdgcn_readfirstlane(tid >> 6), gw = blockIdx.x * 8 + wid; (void)lane; (void)gw;
    unsigned char* ws = P.ws;
        bf16_t* W1T = (bf16_t*)(ws + WS_W1T); bf16_t* WVT = (bf16_t*)(ws + WS_WVT); bf16_t* WQT = (bf16_t*)(ws + WS_WQT); bf16_t* WKVT = (bf16_t*)(ws + WS_WKVT);
        bf16_t* WOT = (bf16_t*)(ws + WS_WOT); bf16_t* WGT = (bf16_t*)(ws + WS_WGT); bf16_t* WUT = (bf16_t*)(ws + WS_WUT); bf16_t* WDT = (bf16_t*)(ws + WS_WDT);
        bf16_t* HN = (bf16_t*)(ws + WS_HN); bf16_t* PROJ = (bf16_t*)(ws + WS_PROJ); bf16_t* VT = (bf16_t*)(ws + WS_VT); bf16_t* CQN = (bf16_t*)(ws + WS_CQN); bf16_t* CKVN = (bf16_t*)(ws + WS_CKVN);
        bf16_t* QRAW = (bf16_t*)(ws + WS_QRAW); bf16_t* KV = (bf16_t*)(ws + WS_KV); bf16_t* OUTA = (bf16_t*)(ws + WS_OUTA); bf16_t* OUTB = (bf16_t*)(ws + WS_OUTB);
        bf16_t* QP = (bf16_t*)(ws + WS_QP); bf16_t* KP = (bf16_t*)(ws + WS_KP); bf16_t* MIX = (bf16_t*)(ws + WS_MIX); bf16_t* HN2 = (bf16_t*)(ws + WS_HN2);
        bf16_t* GB = (bf16_t*)(ws + WS_G); bf16_t* ACT = (bf16_t*)(ws + WS_ACT);
        float* TAB = (float*)(ws + WS_TAB); float* PART = (float*)(ws + WS_PART);
        float* OA15 = (float*)(ws + WS_SMALL + SM_OA15); float* MIX15 = (float*)(ws + WS_SMALL + SM_MIX15); float* H115 = (float*)(ws + WS_SMALL + SM_H115);
        float* HN215 = (float*)(ws + WS_SMALL + SM_HN215); float* G15 = (float*)(ws + WS_SMALL + SM_G15); float* SSQ = (float*)(ws + WS_SMALL + SM_SSQ); (void)HN215;

        { PH_BEGIN
            LAS float* scr = (LAS float*)((LAS unsigned char*)lds + wid * 16384);
            constexpr int I1 = 32 * 64, I2 = 32 * 32, I3 = 32 * 26, I4 = 8 * 48, I5 = 4 * 64, I6 = 32 * 64, I7 = 32 * 176, I8 = 32 * 176, I9 = 88 * 64;
            constexpr int NIT = I1 + I2 + I3 + I4 + I5 + I6 + I7 + I8 + I9;
            for (int it = gw; it < NIT; it += NGW) {
                int r = it;
                if (r < I1) { tr_item(P.w_in, INC, 0, 64, DM, W1T, 0, scr, r, lane); continue; } r -= I1;
                if (r < I2) { tr_item(P.w_in, INC, 2048, 32, DM, WVT, 0, scr, r, lane); continue; } r -= I2;
                if (r < I3) { tr_item(P.w_in, INC, 3072, 26, DM, W1T, 2048, scr, r, lane); continue; } r -= I3;
                if (r < I4) { tr_item(P.w_q_up, 1536, 0, 48, 512, WQT, 0, scr, r, lane); continue; } r -= I4;
                if (r < I5) { tr_item(P.w_kv_up, 2048, 0, 64, 256, WKVT, 0, scr, r, lane); continue; } r -= I5;
                if (r < I6) { tr_item(P.w_out, DM, 0, 64, DM, WOT, 0, scr, r, lane); continue; } r -= I6;
                if (r < I7) { tr_item(P.w_gate, DFF, 0, 176, DM, WGT, 0, scr, r, lane, P.ffn_g); continue; } r -= I7;
                if (r < I8) { tr_item(P.w_up, DFF, 0, 176, DM, WUT, 0, scr, r, lane, P.ffn_g); continue; } r -= I8;
                tr_item(P.w_down, DM, 0, 64, DFF, WDT, 0, scr, r, lane);
            }
            for (int i = blockIdx.x * 512 + tid; i < NREAL; i += G * 512) SSQ[i] = 0.f;
            { const u32x4 z = {0u, 0u, 0u, 0u};
              for (size_t i = (size_t)blockIdx.x * 512 + tid; i < (size_t)192 * DM / 8; i += (size_t)G * 512) *(u32x4*)(W1T + (size_t)2880 * DM + i * 8) = z;
              for (size_t i = (size_t)blockIdx.x * 512 + tid; i < (size_t)(MP - 32800) * DM / 8; i += (size_t)G * 512) *(u32x4*)(HN + (size_t)32800 * DM + i * 8) = z; }
            for (int row = gw; row < 32800; row += NGW) {
                const float* src = row < NREAL ? P.x + (size_t)row * DM : P.meta + (size_t)((row - MROW0) & 15) * DM;
                rms_row_f32(src, P.mix_g, HN + (size_t)row * DM, lane);
            }
            for (int e = blockIdx.x * 512 + tid; e < LTOT * 32; e += G * 512) {
                const int pos = e >> 5, i = e & 31;
                const double inv = exp2(-(double)i * (13.287712379549449 / 32.0));
                const float a = (float)pos * (float)inv;
                double rev = (double)a * 0.15915494309189535; rev -= rint(rev);
                const float fr = (float)rev;
                TAB[2 * e] = __builtin_amdgcn_cosf(fr); TAB[2 * e + 1] = __builtin_amdgcn_sinf(fr);
            }
        }
        grid.sync();
        { PH_BEGIN pg8::Gemm g = pg8::Gemm{HN, W1T, MP, PJ, DM}; pg8::EpiBf16 E = pg8::EpiBf16{PROJ, PJ, nullptr}; pg8::StaticOrder S; S.init(g.M, g.N, G, (int)blockIdx.x);
          pg8::gemm_phase<pg8::EpiBf16, pg8::StaticOrder, true, true>((LAS unsigned char*)lds, g, S, E, tid); }
        { PH_BEGIN pg8::Gemm g = pg8::Gemm{WVT, HN, 1024, MP, DM}; pg8::EpiBf16 E = pg8::EpiBf16{VT, MP, nullptr}; pg8::StaticOrder S; S.init(g.M, g.N, G, (int)((blockIdx.x + G / 2) % G));
          pg8::gemm_phase<pg8::EpiBf16, pg8::StaticOrder, true, true>((LAS unsigned char*)lds, g, S, E, tid); }
        xcd_barrier(xbar);
        { PH_BEGIN
            for (int row = gw; row < MP; row += NGW) {
                bf16_t* pr = PROJ + (size_t)row * PJ;
#pragma unroll
                for (int i = 2; i < 4; ++i) {
                    const u32x4 v = *(const u32x4*)(pr + 512 * i + 8 * lane);
                    float f0 = bflo(v.x), f1 = bfhi(v.x), f2 = bflo(v.y), f3 = bfhi(v.y), f4 = bflo(v.z), f5 = bfhi(v.z), f6 = bflo(v.w), f7 = bfhi(v.w);
                    float ss = f0 * f0 + f1 * f1 + f2 * f2 + f3 * f3 + f4 * f4 + f5 * f5 + f6 * f6 + f7 * f7;
                    ss += __shfl_xor(ss, 1); ss += __shfl_xor(ss, 2); ss += __shfl_xor(ss, 4); ss += __shfl_xor(ss, 8);
                    const float rs = __builtin_amdgcn_rsqf(ss * (1.f / 128.f) + EPS);
                    const float* gp = (i < 2 ? P.na_q_g : P.na_k_g) + ((8 * lane) & 127);
                    const f32x4 g0 = *(const f32x4*)gp, g1 = *(const f32x4*)(gp + 4);
                    u32x4 w; w.x = cvt_pk_bf16(f0 * rs * g0.x, f1 * rs * g0.y); w.y = cvt_pk_bf16(f2 * rs * g0.z, f3 * rs * g0.w); w.z = cvt_pk_bf16(f4 * rs * g1.x, f5 * rs * g1.y); w.w = cvt_pk_bf16(f6 * rs * g1.z, f7 * rs * g1.w);
                    *(u32x4*)(pr + 512 * i + 8 * lane) = w;
                }
                {
                    const u32x4 v = *(const u32x4*)(pr + 2048 + 8 * lane);
                    float f0 = bflo(v.x), f1 = bfhi(v.x), f2 = bflo(v.y), f3 = bfhi(v.y), f4 = bflo(v.z), f5 = bfhi(v.z), f6 = bflo(v.w), f7 = bfhi(v.w);
                    const float ss = wave_sum(f0 * f0 + f1 * f1 + f2 * f2 + f3 * f3 + f4 * f4 + f5 * f5 + f6 * f6 + f7 * f7);
                    const float rs = __builtin_amdgcn_rsqf(ss * (1.f / 512.f) + EPS);
                    const float* gp = P.cq_g + 8 * lane; const f32x4 g0 = *(const f32x4*)gp, g1 = *(const f32x4*)(gp + 4);
                    u32x4 w; w.x = cvt_pk_bf16(f0 * rs * g0.x, f1 * rs * g0.y); w.y = cvt_pk_bf16(f2 * rs * g0.z, f3 * rs * g0.w); w.z = cvt_pk_bf16(f4 * rs * g1.x, f5 * rs * g1.y); w.w = cvt_pk_bf16(f6 * rs * g1.z, f7 * rs * g1.w);
                    *(u32x4*)(CQN + (size_t)row * 512 + 8 * lane) = w;
                }
                {
                    const u32x4 v = *(const u32x4*)(pr + 2560 + 8 * lane);
                    float f0 = bflo(v.x), f1 = bfhi(v.x), f2 = bflo(v.y), f3 = bfhi(v.y), f4 = bflo(v.z), f5 = bfhi(v.z), f6 = bflo(v.w), f7 = bfhi(v.w);
                    float ss = f0 * f0 + f1 * f1 + f2 * f2 + f3 * f3 + f4 * f4 + f5 * f5 + f6 * f6 + f7 * f7;
                    ss += __shfl_xor(ss, 1); ss += __shfl_xor(ss, 2); ss += __shfl_xor(ss, 4); ss += __shfl_xor(ss, 8); ss += __shfl_xor(ss, 16);
                    const float rs = __builtin_amdgcn_rsqf(ss * (1.f / 256.f) + EPS);
                    const float* gp = P.ckv_g + ((8 * lane) & 255); const f32x4 g0 = *(const f32x4*)gp, g1 = *(const f32x4*)(gp + 4);
                    u32x4 w; w.x = cvt_pk_bf16(f0 * rs * g0.x, f1 * rs * g0.y); w.y = cvt_pk_bf16(f2 * rs * g0.z, f3 * rs * g0.w); w.z = cvt_pk_bf16(f4 * rs * g1.x, f5 * rs * g1.y); w.w = cvt_pk_bf16(f6 * rs * g1.z, f7 * rs * g1.w);
                    if (lane < 32) *(u32x4*)(CKVN + (size_t)row * 256 + 8 * lane) = w;
                }
            }
        }
        xcd_barrier(xbar);
        { PH_BEGIN pg8::Gemm g = pg8::Gemm{CQN, WQT, MP, 1536, 512}; pg8::EpiBf16 E = pg8::EpiBf16{QRAW, 1536, nullptr}; pg8::StaticOrder S; S.init(g.M, g.N, G, (int)blockIdx.x);
          pg8::gemm_phase<pg8::EpiBf16, pg8::StaticOrder, true, true>((LAS unsigned char*)lds, g, S, E, tid); }
        { PH_BEGIN pg8::Gemm g = pg8::Gemm{CKVN, WKVT, MP, 2048, 256}; pg8::EpiBf16 E = pg8::EpiBf16{KV, 2048, nullptr}; pg8::StaticOrder S; S.init(g.M, g.N, G, (int)((blockIdx.x + G / 2) % G));
          pg8::gemm_phase<pg8::EpiBf16, pg8::StaticOrder, true, true>((LAS unsigned char*)lds, g, S, E, tid); }
        { PH_BEGIN
            const int ql = lane & 15, g = lane >> 4, rsel = wid >> 2, j = wid & 3;
            float* rp = (float*)lds + wid * 512;
            char* stg = (char*)lds + 16384;
            int hcur = -1;
            const int xcd = (int)blockIdx.x & 7, cblk = (int)blockIdx.x >> 3;
            const int ktok = tid >> 4, kc = tid & 15, klds = ktok * 256 + 16 * (kc ^ ((((ktok >> 3) & 3) << 2) | (ktok & 3)));
            const int vd = tid >> 3, vc = tid & 7, vlds = vd * 128 + 16 * (vc ^ ((vd >> 1) & 7));
            const int kb = min(max(16 * j - 8, 0), 32);
            const int xh = ((kb >> 3) + (ql >> 2)) & 3, xl = ql & 3;
            const int kbase = (kb + 8 * (ql >> 2) + (ql & 3)) * 256 + 16 * (g ^ xl);
            const int kofs0 = kbase + 64 * (0 ^ xh), kofs1 = kbase + 64 * (1 ^ xh), kofs2 = kbase + 64 * (2 ^ xh), kofs3 = kbase + 64 * (3 ^ xh);
            const int vofs = ql * 128 + 16 * (((kb >> 3) + g) ^ (ql >> 1));
            for (int k = 0;; ++k) {
                int combo, rpair;
                if (G == 256) { if (k >= 8) break; const int lin = k * 32 + cblk; combo = xcd * 2 + (lin >> 7); rpair = lin & 127; }
                else { const int bi = (int)blockIdx.x + k * G; if (bi >= 2048) break; combo = bi >> 7; rpair = bi & 127; }
                const int h = combo & 7, b = combo >> 3, r0 = 2 * rpair, r = r0 + rsel;
                if (h != hcur) { for (int i = lane; i < 465; i += 64) rp[i] = P.rpb[h * 465 + i]; hcur = h; }
                const int u0 = min(max(r0 - 4, 0), 248), rs = min(max(r - 4, 0), 248);
                const size_t tokb = (size_t)b * SEQ, tok_q = tokb + r * 64 + 16 * j;
                const bf16_t* qp = PROJ + (tok_q + ql) * PJ + h * 128 + 8 * g;
                bf16x8 qf[4];
#pragma unroll
                for (int ds = 0; ds < 4; ++ds) qf[ds] = *(const bf16x8*)(qp + 32 * ds);
                na_norm_q(qf, P.na_q_g, g);
#define NA_LOADT(s, R0, R1) do { const size_t t0_ = tokb + (size_t)min(u0 + ((s) % 9), 255) * 64; \
                    if ((s) < 9) { const bf16_t* p_ = PROJ + (t0_ + ktok) * PJ + 1024 + h * 128 + kc * 8; R0 = *(const bf16x8*)p_; R1 = *(const bf16x8*)(p_ + (size_t)32 * PJ); } \
                    else { const bf16_t* p_ = VT + (size_t)(h * 128 + vd) * MP + t0_ + vc * 8; R0 = *(const bf16x8*)p_; R1 = *(const bf16x8*)(p_ + (size_t)64 * MP); } } while (0)
#define NA_WRITET(s, R0, R1) do { char* b_ = stg + ((s) & 1) * 16384; \
                    if ((s) < 9) { *(bf16x8*)(b_ + klds) = R0; *(bf16x8*)(b_ + klds + 8192) = R1; } else { *(bf16x8*)(b_ + vlds) = R0; *(bf16x8*)(b_ + vlds + 8192) = R1; } } while (0)
#define NA_BAR() asm volatile("s_waitcnt lgkmcnt(0)\n\ts_barrier" ::: "memory")
                bf16x8 ra0, ra1, rb0, rb1;
                NA_LOADT(0, ra0, ra1); NA_LOADT(1, rb0, rb1);
                f32x4 st[19];
#define NA_SSTEP(s, R0, R1) do { NA_WRITET(s, R0, R1); NA_LOADT((s) + 2, R0, R1); NA_BAR(); \
                    const char* kbuf_ = stg + ((s) & 1) * 16384; \
                    _Pragma("unroll") for (int hh = 0; hh < 2; ++hh) { f32x4 a = {0.f, 0.f, 0.f, 0.f}; \
                        a = __builtin_amdgcn_mfma_f32_16x16x32_bf16(*(const bf16x8*)(kbuf_ + hh * 1024 + kofs0), qf[0], a, 0, 0, 0); \
                        a = __builtin_amdgcn_mfma_f32_16x16x32_bf16(*(const bf16x8*)(kbuf_ + hh * 1024 + kofs1), qf[1], a, 0, 0, 0); \
                        a = __builtin_amdgcn_mfma_f32_16x16x32_bf16(*(const bf16x8*)(kbuf_ + hh * 1024 + kofs2), qf[2], a, 0, 0, 0); \
                        a = __builtin_amdgcn_mfma_f32_16x16x32_bf16(*(const bf16x8*)(kbuf_ + hh * 1024 + kofs3), qf[3], a, 0, 0, 0); \
                        st[2 * (s) + hh] = a; } } while (0)
                NA_SSTEP(0, ra0, ra1); NA_SSTEP(1, rb0, rb1); NA_SSTEP(2, ra0, ra1); NA_SSTEP(3, rb0, rb1); NA_SSTEP(4, ra0, ra1);
                NA_SSTEP(5, rb0, rb1); NA_SSTEP(6, ra0, ra1);
                bf16x8 km[4];
                { const bf16_t* kpm = PROJ + (size_t)(MROW0 + ql) * PJ + 1024 + h * 128 + 8 * g;
#pragma unroll
                  for (int ds = 0; ds < 4; ++ds) km[ds] = *(const bf16x8*)(kpm + 32 * ds); }
                NA_SSTEP(7, rb0, rb1); NA_SSTEP(8, ra0, ra1);
                { f32x4 a = {0.f, 0.f, 0.f, 0.f};
#pragma unroll
                  for (int ds = 0; ds < 4; ++ds) a = __builtin_amdgcn_mfma_f32_16x16x32_bf16(km[ds], qf[ds], a, 0, 0, 0);
                  st[18] = a; }
                const int c = 16 * j + ql, cs = min(max(c - 8, 0), 48);
                constexpr float SC = 0.08838834764831845f;
                float mx = -1e30f;
#pragma unroll
                for (int t = 0; t < 18; ++t) {
                    const int kr = u0 + (t >> 1); const bool rowok = (kr >= rs) && (kr < rs + 8);
                    const int dr = min(max(kr - r + 7, 0), 14);
#pragma unroll
                    for (int e = 0; e < 4; ++e) {
                        const int kcol = kb + 8 * g + 4 * (t & 1) + e; const bool valid = rowok && (kcol >= cs) && (kcol < cs + 16);
                        const int dc = min(max(kcol - c + 15, 0), 30);
                        float sv = (st[t][e] * SC + rp[dr * 31 + dc]) * LOG2E; sv = valid ? sv : -1e30f; st[t][e] = sv; mx = fmaxf(mx, sv);
                    }
                }
#pragma unroll
                for (int e = 0; e < 4; ++e) { const float sv = (st[18][e] * SC + P.meta_bias[h * 16 + 4 * g + e]) * LOG2E; st[18][e] = sv; mx = fmaxf(mx, sv); }
                mx = fmaxf(mx, __shfl_xor(mx, 16)); mx = fmaxf(mx, __shfl_xor(mx, 32));
                float l = 0.f;
#pragma unroll
                for (int t = 0; t < 19; ++t)
#pragma unroll
                    for (int e = 0; e < 4; ++e) { const float p = __builtin_amdgcn_exp2f(st[t][e] - mx); st[t][e] = p; l += p; }
                l += __shfl_xor(l, 16); l += __shfl_xor(l, 32);
                f32x4 o[8];
#pragma unroll
                for (int dg = 0; dg < 8; ++dg) o[dg] = (f32x4){0.f, 0.f, 0.f, 0.f};
#define NA_VSTEP(s, R0, R1) do { NA_WRITET(s, R0, R1); if ((s) + 2 < 18) NA_LOADT((s) + 2, R0, R1); NA_BAR(); \
                    const char* vbuf_ = stg + ((s) & 1) * 16384 + vofs; constexpr int i_ = (s) - 9; \
                    u32x4 pw; pw.x = cvt_pk_bf16(st[2 * i_][0], st[2 * i_][1]); pw.y = cvt_pk_bf16(st[2 * i_][2], st[2 * i_][3]); pw.z = cvt_pk_bf16(st[2 * i_ + 1][0], st[2 * i_ + 1][1]); pw.w = cvt_pk_bf16(st[2 * i_ + 1][2], st[2 * i_ + 1][3]); \
                    const bf16x8 pa = __builtin_bit_cast(bf16x8, pw); \
                    _Pragma("unroll") for (int dg = 0; dg < 8; ++dg) o[dg] = __builtin_amdgcn_mfma_f32_16x16x32_bf16(pa, *(const bf16x8*)(vbuf_ + dg * 2048), o[dg], 0, 0, 0); } while (0)
                NA_VSTEP(9, rb0, rb1); NA_VSTEP(10, ra0, ra1); NA_VSTEP(11, rb0, rb1); NA_VSTEP(12, ra0, ra1); NA_VSTEP(13, rb0, rb1);
                NA_VSTEP(14, ra0, ra1); NA_VSTEP(15, rb0, rb1);
                u32x2 vmf[8];
                { const bf16_t* vm = VT + (size_t)(h * 128 + ql) * MP + MROW0 + 4 * g;
#pragma unroll
                  for (int dg = 0; dg < 8; ++dg) vmf[dg] = *(const u32x2*)(vm + (size_t)(16 * dg) * MP); }
                NA_VSTEP(16, ra0, ra1); NA_VSTEP(17, rb0, rb1);
                {   u32x4 pw; pw.x = cvt_pk_bf16(st[18][0], st[18][1]); pw.y = cvt_pk_bf16(st[18][2], st[18][3]); pw.z = 0u; pw.w = 0u;
                    const bf16x8 pa = __builtin_bit_cast(bf16x8, pw);
#pragma unroll
                    for (int dg = 0; dg < 8; ++dg) { const u32x4 bw = {vmf[dg].x, vmf[dg].y, 0u, 0u};
                        o[dg] = __builtin_amdgcn_mfma_f32_16x16x32_bf16(pa, __builtin_bit_cast(bf16x8, bw), o[dg], 0, 0, 0); }
                }
#undef NA_LOADT
#undef NA_WRITET
#undef NA_BAR
#undef NA_SSTEP
#undef NA_VSTEP
                const float inv = __builtin_amdgcn_rcpf(l);
                float il[4];
#pragma unroll
                for (int e = 0; e < 4; ++e) il[e] = __shfl(inv, 4 * g + e);
#pragma unroll
                for (int e = 0; e < 4; ++e) { bf16_t* op = OUTA + (tok_q + 4 * g + e) * 1024 + h * 128 + ql;
#pragma unroll
                    for (int dg = 0; dg < 8; ++dg) op[16 * dg] = f2bf(o[dg][e] * il[e]); }
            }
            __syncthreads();
            if (gw < 8) {
                const int h = gw;
                const bf16_t* qp = PROJ + (size_t)(MROW0 + ql) * PJ + h * 128 + 8 * g; const bf16_t* kp = qp + 1024;
                bf16x8 qm[4];
#pragma unroll
                for (int ds = 0; ds < 4; ++ds) qm[ds] = *(const bf16x8*)(qp + 32 * ds);
                na_norm_q(qm, P.na_q_g, g);
                f32x4 a = {0.f, 0.f, 0.f, 0.f};
#pragma unroll
                for (int ds = 0; ds < 4; ++ds) a = __builtin_amdgcn_mfma_f32_16x16x32_bf16(*(const bf16x8*)(kp + 32 * ds), qm[ds], a, 0, 0, 0);
                float mx = -1e30f;
#pragma unroll
                for (int e = 0; e < 4; ++e) { a[e] = (a[e] * 0.08838834764831845f + P.meta_bias[h * 16 + 4 * g + e]) * LOG2E; mx = fmaxf(mx, a[e]); }
                mx = fmaxf(mx, __shfl_xor(mx, 16)); mx = fmaxf(mx, __shfl_xor(mx, 32));
                float l = 0.f;
#pragma unroll
                for (int e = 0; e < 4; ++e) { a[e] = __builtin_amdgcn_exp2f(a[e] - mx); l += a[e]; }
                l += __shfl_xor(l, 16); l += __shfl_xor(l, 32);
                u32x4 pw; pw.x = cvt_pk_bf16(a[0], a[1]); pw.y = cvt_pk_bf16(a[2], a[3]); pw.z = 0u; pw.w = 0u;
                const bf16x8 pa = __builtin_bit_cast(bf16x8, pw);
                const bf16_t* vm = VT + (size_t)(h * 128 + ql) * MP + MROW0 + 4 * g;
                const float inv15 = __shfl(__builtin_amdgcn_rcpf(l), 15);
#pragma unroll
                for (int dg = 0; dg < 8; ++dg) { const u32x2 lo = *(const u32x2*)(vm + (size_t)(16 * dg) * MP); const u32x4 bw = {lo.x, lo.y, 0u, 0u};
                    f32x4 o = {0.f, 0.f, 0.f, 0.f}; o = __builtin_amdgcn_mfma_f32_16x16x32_bf16(pa, __builtin_bit_cast(bf16x8, bw), o, 0, 0, 0);
                    if (g == 3) OA15[h * 128 + 16 * dg + ql] = o[3] * inv15; }
            }
        }
        xcd_barrier(xbar);
        { PH_BEGIN
            const int h = lane >> 3, sub = lane & 7;
            for (int row = gw; row < MP; row += NGW) {
                const int pos = row < NREAL ? 16 + (row & (SEQ - 1)) : ((row - MROW0) & 15);
                const float* tb = TAB + ((size_t)pos * 32 + 8 * (sub & 3)) * 2;
                const f32x4 t0 = *(const f32x4*)tb, t1 = *(const f32x4*)(tb + 4), t2 = *(const f32x4*)(tb + 8), t3 = *(const f32x4*)(tb + 12);
#pragma unroll
                for (int which = 0; which < 2; ++which) {
                    if (which == 0 && row < NREAL) continue;
                    const bf16_t* np = which == 0 ? QRAW + (size_t)row * 1536 + h * 192 + 16 * sub : KV + (size_t)row * 2048 + h * 256 + 16 * sub;
                    const bf16_t* rpp = which == 0 ? QRAW + (size_t)row * 1536 + h * 192 + 128 + 8 * sub : PROJ + (size_t)row * PJ + 2816 + 8 * sub;
                    const float* gn = which == 0 ? P.mq_g : P.mk_g;
                    bf16_t* dst = (which == 0 ? QP : KP) + (size_t)row * 1536 + h * 192;
                    const u32x4 a = *(const u32x4*)np, bq = *(const u32x4*)(np + 8), c = *(const u32x4*)rpp;
                    float n0 = bflo(a.x), n1 = bfhi(a.x), n2 = bflo(a.y), n3 = bfhi(a.y), n4 = bflo(a.z), n5 = bfhi(a.z), n6 = bflo(a.w), n7 = bfhi(a.w);
                    float m0 = bflo(bq.x), m1 = bfhi(bq.x), m2 = bflo(bq.y), m3 = bfhi(bq.y), m4 = bflo(bq.z), m5 = bfhi(bq.z), m6 = bflo(bq.w), m7 = bfhi(bq.w);
                    float r0 = bflo(c.x), r1 = bfhi(c.x), r2 = bflo(c.y), r3 = bfhi(c.y), r4 = bflo(c.z), r5 = bfhi(c.z), r6 = bflo(c.w), r7 = bfhi(c.w);
                    float ss = n0 * n0 + n1 * n1 + n2 * n2 + n3 * n3 + n4 * n4 + n5 * n5 + n6 * n6 + n7 * n7 + m0 * m0 + m1 * m1 + m2 * m2 + m3 * m3 + m4 * m4 + m5 * m5 + m6 * m6 + m7 * m7
                             + r0 * r0 + r1 * r1 + r2 * r2 + r3 * r3 + r4 * r4 + r5 * r5 + r6 * r6 + r7 * r7;
                    ss += __shfl_xor(ss, 1); ss += __shfl_xor(ss, 2); ss += __shfl_xor(ss, 4);
                    const float rs = __builtin_amdgcn_rsqf(ss * (1.f / 192.f) + EPS);
                    const f32x4 ga = *(const f32x4*)(gn + 16 * sub), gb = *(const f32x4*)(gn + 16 * sub + 4), gc = *(const f32x4*)(gn + 16 * sub + 8), gd = *(const f32x4*)(gn + 16 * sub + 12);
                    const f32x4 ge = *(const f32x4*)(gn + 128 + 8 * sub), gf = *(const f32x4*)(gn + 128 + 8 * sub + 4);
                    u32x4 w;
                    w.x = cvt_pk_bf16(n0 * rs * ga.x, n1 * rs * ga.y); w.y = cvt_pk_bf16(n2 * rs * ga.z, n3 * rs * ga.w); w.z = cvt_pk_bf16(n4 * rs * gb.x, n5 * rs * gb.y); w.w = cvt_pk_bf16(n6 * rs * gb.z, n7 * rs * gb.w);
                    *(u32x4*)(dst + 16 * sub) = w;
                    w.x = cvt_pk_bf16(m0 * rs * gc.x, m1 * rs * gc.y); w.y = cvt_pk_bf16(m2 * rs * gc.z, m3 * rs * gc.w); w.z = cvt_pk_bf16(m4 * rs * gd.x, m5 * rs * gd.y); w.w = cvt_pk_bf16(m6 * rs * gd.z, m7 * rs * gd.w);
                    *(u32x4*)(dst + 16 * sub + 8) = w;
                    const float y0 = r0 * rs * ge.x, y1 = r1 * rs * ge.y, y2 = r2 * rs * ge.z, y3 = r3 * rs * ge.w, y4 = r4 * rs * gf.x, y5 = r5 * rs * gf.y, y6 = r6 * rs * gf.z, y7 = r7 * rs * gf.w;
                    const float z0 = __shfl_xor(y0, 4), z1 = __shfl_xor(y1, 4), z2 = __shfl_xor(y2, 4), z3 = __shfl_xor(y3, 4), z4 = __shfl_xor(y4, 4), z5 = __shfl_xor(y5, 4), z6 = __shfl_xor(y6, 4), z7 = __shfl_xor(y7, 4);
                    const float sg = (sub < 4) ? -1.f : 1.f;
                    w.x = cvt_pk_bf16(y0 * t0.x + sg * z0 * t0.y, y1 * t0.z + sg * z1 * t0.w); w.y = cvt_pk_bf16(y2 * t1.x + sg * z2 * t1.y, y3 * t1.z + sg * z3 * t1.w);
                    w.z = cvt_pk_bf16(y4 * t2.x + sg * z4 * t2.y, y5 * t2.z + sg * z5 * t2.w); w.w = cvt_pk_bf16(y6 * t3.x + sg * z6 * t3.y, y7 * t3.z + sg * z7 * t3.w);
                    *(u32x4*)(dst + 128 + 8 * sub) = w;
                }
            }
        }
        xcd_barrier(xbar);
        { PH_BEGIN
            for (int it = gw; it < 16 * NCHUNK; it += NGW) {
                const int bh = it / NCHUNK, c = it % NCHUNK, b = bh >> 3, h = bh & 7;
                const size_t rowbase = (c == 0) ? (size_t)(MROW0 + 16 * b) : (size_t)b * SEQ + (size_t)(c - 1) * 64;
                const bf16_t* q = QP + (size_t)(MROW0 + 16 * b + 15) * 1536 + h * 192; const bf16_t* k = KP + (rowbase + lane) * 1536 + h * 192;
                float s = 0.f;
#pragma unroll 4
                for (int ch = 0; ch < 24; ++ch) s += dot8(*(const u32x4*)(q + ch * 8), *(const u32x4*)(k + ch * 8));
                s *= mla::SCALE * LOG2E; if (c == 0 && lane >= 16) s = -1e30f;
                const float m = wave_max(s); const float p = __builtin_amdgcn_exp2f(s - m); const float l = wave_sum(p);
                const bf16_t* vp = KV + rowbase * 2048 + h * 256 + 128 + 2 * lane;
                float o0 = 0.f, o1 = 0.f;
#pragma unroll 8
                for (int key = 0; key < 64; ++key) { const float pk = __shfl(p, key); const unsigned u = *(const unsigned*)(vp + (size_t)key * 2048); o0 += pk * bflo(u); o1 += pk * bfhi(u); }
                float* pt = PART + (size_t)it * PARTW;
                if (lane == 0) { pt[0] = m; pt[1] = l; }
                pt[4 + 2 * lane] = o0; pt[5 + 2 * lane] = o1;
            }
            __syncthreads();
            const int xcd = blockIdx.x & 7, idx = blockIdx.x >> 3, nper = G >> 3;
            for (int i = 0;; ++i) {
                int u;
                if ((G & 7) == 0 && nper == 32) { const int slot = i * 8 + xcd; if (slot >= 32) break; u = (slot >> 1) * 64 + (slot & 1) * 32 + idx; }
                else { u = blockIdx.x + i * G; if (u >= 1024) break; }
                const int bh = u >> 6, qb = u & 63, b = bh >> 3, h = bh & 7;
                const size_t q0 = (size_t)b * SEQ + (size_t)qb * 256;
                int tid_u = tid; asm volatile("" : "+v"(tid_u));
                mla::attn_unit2(QRAW + q0 * 1536 + h * 192, KP + h * 192, KV + h * 256 + 128, OUTB + q0 * 1024 + h * 128, MROW0 + 16 * b, b * SEQ, (char*)lds, tid_u, P.mq_g, TAB, 16 + qb * 256);
            }
        }
        xcd_barrier(xbar);
        { PH_BEGIN
            const int nw9 = (G > 1) ? (G - 1) * 8 : 8;
            if ((int)blockIdx.x < G - 1 || G == 1)
            for (int row = gw; row < NREAL; row += nw9) {
#pragma unroll
                for (int which = 0; which < 2; ++which) {
                    const bf16_t* src = (which == 0 ? OUTA : OUTB) + (size_t)row * 1024 + 16 * lane; const float* gn = (which == 0 ? P.na_out_g : P.mla_out_g) + 16 * lane;
                    const u32x4 a = *(const u32x4*)src, bq = *(const u32x4*)(src + 8);
                    float n0 = bflo(a.x), n1 = bfhi(a.x), n2 = bflo(a.y), n3 = bfhi(a.y), n4 = bflo(a.z), n5 = bfhi(a.z), n6 = bflo(a.w), n7 = bfhi(a.w);
                    float m0 = bflo(bq.x), m1 = bfhi(bq.x), m2 = bflo(bq.y), m3 = bfhi(bq.y), m4 = bflo(bq.z), m5 = bfhi(bq.z), m6 = bflo(bq.w), m7 = bfhi(bq.w);
                    const float ss = wave_sum(n0 * n0 + n1 * n1 + n2 * n2 + n3 * n3 + n4 * n4 + n5 * n5 + n6 * n6 + n7 * n7 + m0 * m0 + m1 * m1 + m2 * m2 + m3 * m3 + m4 * m4 + m5 * m5 + m6 * m6 + m7 * m7);
                    const float rs = __builtin_amdgcn_rsqf(ss * (1.f / 1024.f) + EPS);
                    const f32x4 ga = *(const f32x4*)gn, gb = *(const f32x4*)(gn + 4), gc = *(const f32x4*)(gn + 8), gd = *(const f32x4*)(gn + 12);
                    bf16_t* dst = MIX + (size_t)row * DM + which * 1024 + 16 * lane; u32x4 w;
                    w.x = cvt_pk_bf16(n0 * rs * ga.x, n1 * rs * ga.y); w.y = cvt_pk_bf16(n2 * rs * ga.z, n3 * rs * ga.w); w.z = cvt_pk_bf16(n4 * rs * gb.x, n5 * rs * gb.y); w.w = cvt_pk_bf16(n6 * rs * gb.z, n7 * rs * gb.w);
                    *(u32x4*)dst = w;
                    w.x = cvt_pk_bf16(m0 * rs * gc.x, m1 * rs * gc.y); w.y = cvt_pk_bf16(m2 * rs * gc.z, m3 * rs * gc.w); w.z = cvt_pk_bf16(m4 * rs * gd.x, m5 * rs * gd.y); w.w = cvt_pk_bf16(m6 * rs * gd.z, m7 * rs * gd.w);
                    *(u32x4*)(dst + 8) = w;
                }
            }
            if ((int)blockIdx.x == G - 1) {
                float* sh = (float*)lds;
                __syncthreads();
                for (int bh = wid; bh < 16; bh += 8) {
                    const float* pt = PART + (size_t)bh * NCHUNK * PARTW;
                    float mm = -1e30f;
                    for (int c = lane; c < NCHUNK; c += 64) mm = fmaxf(mm, pt[(size_t)c * PARTW]);
                    mm = wave_max(mm);
                    float L = 0.f, o0 = 0.f, o1 = 0.f;
                    for (int c = 0; c < NCHUNK; ++c) { const float* pc = pt + (size_t)c * PARTW; const float w = __builtin_amdgcn_exp2f(pc[0] - mm); L += w * pc[1]; o0 += w * pc[4 + 2 * lane]; o1 += w * pc[5 + 2 * lane]; }
                    const float inv = 1.f / L;
                    sh[bh * 128 + 2 * lane] = bfround(o0 * inv); sh[bh * 128 + 2 * lane + 1] = bfround(o1 * inv);
                }
                __syncthreads();
                if (wid < 2) {
                    const int b = wid; float sa = 0.f, sb = 0.f;
#pragma unroll
                    for (int e = 0; e < 16; ++e) { const float va = bfround(OA15[16 * lane + e]), vb = sh[b * 1024 + 16 * lane + e]; sa += va * va; sb += vb * vb; }
                    const float ra = __builtin_amdgcn_rsqf(wave_sum(sa) * (1.f / 1024.f) + EPS), rb = __builtin_amdgcn_rsqf(wave_sum(sb) * (1.f / 1024.f) + EPS);
#pragma unroll
                    for (int e = 0; e < 16; ++e) { const int i = 16 * lane + e;
                        MIX15[b * DM + i] = bfround(bfround(OA15[i]) * ra * P.na_out_g[i]); MIX15[b * DM + 1024 + i] = bfround(sh[b * 1024 + i] * rb * P.mla_out_g[i]); }
                }
                __syncthreads();
            }
        }
        xcd_barrier(xbar);
        { PH_BEGIN pg8::Gemm g = pg8::Gemm{MIX, WOT, NREAL, DM, DM}; pg8::EpiResSsq E = pg8::EpiResSsq{P.x, P.out, HN2, SSQ, DM}; pg8::StaticOrder S; S.init(g.M, g.N, G, (int)blockIdx.x);
          pg8::gemm_phase<pg8::EpiResSsq, pg8::StaticOrder, false, true>((LAS unsigned char*)lds, g, S, E, tid); }
        { PH_BEGIN
            {
                for (int n = gw; n < DM; n += NGW) {
                    const bf16_t* w = WOT + (size_t)n * DM; float a0 = 0.f, a1 = 0.f;
#pragma unroll
                    for (int i = 0; i < 4; ++i) { const int k = 8 * lane + 512 * i; const u32x4 wv = *(const u32x4*)(w + k);
                        const f32x4 x0 = *(const f32x4*)(MIX15 + k), x1 = *(const f32x4*)(MIX15 + k + 4), y0 = *(const f32x4*)(MIX15 + DM + k), y1 = *(const f32x4*)(MIX15 + DM + k + 4);
                        const float w0 = bflo(wv.x), w1 = bfhi(wv.x), w2 = bflo(wv.y), w3 = bfhi(wv.y), w4 = bflo(wv.z), w5 = bfhi(wv.z), w6 = bflo(wv.w), w7 = bfhi(wv.w);
                        a0 += w0 * x0.x + w1 * x0.y + w2 * x0.z + w3 * x0.w + w4 * x1.x + w5 * x1.y + w6 * x1.z + w7 * x1.w;
                        a1 += w0 * y0.x + w1 * y0.y + w2 * y0.z + w3 * y0.w + w4 * y1.x + w5 * y1.y + w6 * y1.z + w7 * y1.w; }
                    a0 = wave_sum(a0); a1 = wave_sum(a1);
                    if (lane == 0) { const float mb = P.meta[15 * DM + n]; H115[n] = mb + a0; H115[DM + n] = mb + a1; }
                }
            }
        }
        xcd_barrier(xbar);
        { PH_BEGIN
            for (int row = gw; row < NREAL; row += NGW) {
                const bf16_t* src = HN2 + (size_t)row * DM + 8 * lane; float ss = 0.f;
#pragma unroll
                for (int i = 0; i < 4; ++i) { const u32x4 v = *(const u32x4*)(src + 512 * i);
                    const float f0 = bflo(v.x), f1 = bfhi(v.x), f2 = bflo(v.y), f3 = bfhi(v.y), f4 = bflo(v.z), f5 = bfhi(v.z), f6 = bflo(v.w), f7 = bfhi(v.w);
                    ss += f0 * f0 + f1 * f1 + f2 * f2 + f3 * f3 + f4 * f4 + f5 * f5 + f6 * f6 + f7 * f7; }
                ss = wave_sum(ss);
                if (lane == 0) SSQ[row] = ss;
            }
        }
        xcd_barrier(xbar);
        { PH_BEGIN pg8::Gemm g = pg8::Gemm{HN2, WGT, NREAL, DFF, DM}; pg8::EpiBf16 E = pg8::EpiBf16{GB, DFF, SSQ}; pg8::StaticOrder S; S.init(g.M, g.N, G, (int)blockIdx.x);
          pg8::gemm_phase<pg8::EpiBf16, pg8::StaticOrder, true, true>((LAS unsigned char*)lds, g, S, E, tid); }
        { PH_BEGIN
            {
                for (int n = gw; n < DFF; n += NGW) {
                    const bf16_t* w = WGT + (size_t)n * DM; float a0 = 0.f, a1 = 0.f, s0 = 0.f, s1 = 0.f;
#pragma unroll
                    for (int i = 0; i < 4; ++i) { const int k = 8 * lane + 512 * i; const u32x4 wv = *(const u32x4*)(w + k);
                        const f32x4 x0 = *(const f32x4*)(H115 + k), x1 = *(const f32x4*)(H115 + k + 4), y0 = *(const f32x4*)(H115 + DM + k), y1 = *(const f32x4*)(H115 + DM + k + 4);
                        const float w0 = bflo(wv.x), w1 = bfhi(wv.x), w2 = bflo(wv.y), w3 = bfhi(wv.y), w4 = bflo(wv.z), w5 = bfhi(wv.z), w6 = bflo(wv.w), w7 = bfhi(wv.w);
                        a0 += w0 * x0.x + w1 * x0.y + w2 * x0.z + w3 * x0.w + w4 * x1.x + w5 * x1.y + w6 * x1.z + w7 * x1.w;
                        a1 += w0 * y0.x + w1 * y0.y + w2 * y0.z + w3 * y0.w + w4 * y1.x + w5 * y1.y + w6 * y1.z + w7 * y1.w;
                        s0 += x0.x * x0.x + x0.y * x0.y + x0.z * x0.z + x0.w * x0.w + x1.x * x1.x + x1.y * x1.y + x1.z * x1.z + x1.w * x1.w;
                        s1 += y0.x * y0.x + y0.y * y0.y + y0.z * y0.z + y0.w * y0.w + y1.x * y1.x + y1.y * y1.y + y1.z * y1.z + y1.w * y1.w; }
                    a0 = wave_sum(a0) * __builtin_amdgcn_rsqf(wave_sum(s0) * (1.f / DM) + EPS); a1 = wave_sum(a1) * __builtin_amdgcn_rsqf(wave_sum(s1) * (1.f / DM) + EPS);
                    if (lane == 0) { G15[n] = a0; G15[DFF + n] = a1; }
                }
            }
        }
        xcd_barrier(xbar);
        { PH_BEGIN pg8::Gemm g{HN2, WUT, NREAL, DFF, DM}; pg8::EpiConvGlu E{GB, ACT, DFF, P.conv_w, P.conv_b, G15, SSQ}; pg8::StaticOrder S; S.init(g.M, g.N, G, (int)blockIdx.x);
          pg8::gemm_phase<pg8::EpiConvGlu, pg8::StaticOrder, true, true>((LAS unsigned char*)lds, g, S, E, tid); }
        xcd_barrier(xbar);
        { PH_BEGIN pg8::Gemm g = pg8::Gemm{ACT, WDT, NREAL, DM, DFF}; pg8::EpiResF32 E = pg8::EpiResF32{P.out, P.out, DM}; pg8::StaticOrder S; S.init(g.M, g.N, G, (int)blockIdx.x);
          pg8::gemm_phase<pg8::EpiResF32, pg8::StaticOrder, true, true>((LAS unsigned char*)lds, g, S, E, tid); }
}

extern "C" void kernel_launch(void* const* d_in, const int* in_sizes, int n_in, void* d_out, int out_size, void* d_ws, size_t ws_size, hipStream_t stream) {
    static int grid = 0;
    if (grid == 0) {
        if (n_in != 23 || in_sizes[0] != NREAL * DM || out_size != NREAL * DM || ws_size < WS_END) {
            fprintf(stderr, "kernel_launch: unexpected shapes: n_in %d in0 %d out %d ws %zu (need %zu)\n", n_in, n_in > 0 ? in_sizes[0] : -1, out_size, ws_size, (size_t)WS_END); grid = -1; return; }
        int dev = 0, cus = 0, per_cu = 0;
        hipGetDevice(&dev); hipDeviceGetAttribute(&cus, hipDeviceAttributeMultiprocessorCount, dev);
        if (hipFuncSetAttribute((const void*)fwd_kernel, hipFuncAttributeMaxDynamicSharedMemorySize, LDS_BYTES) != hipSuccess) { fprintf(stderr, "kernel_launch: hipFuncSetAttribute failed\n"); grid = -1; return; }
        if (hipOccupancyMaxActiveBlocksPerMultiprocessor(&per_cu, (const void*)fwd_kernel, 512, LDS_BYTES) != hipSuccess || per_cu < 1) { fprintf(stderr, "kernel_launch: occupancy query gave %d\n", per_cu); per_cu = 1; }
        (void)hipGetLastError();
        grid = cus * per_cu;
    }
    if (grid < 0) return;
    Args a{};
    const float** ap = (const float**)&a;
    for (int i = 0; i < 23; ++i) ap[i] = (const float*)d_in[i];
    a.out = (float*)d_out; a.ws = (unsigned char*)d_ws;
    if (hipMemsetAsync(d_ws, 0, 16384, stream) != hipSuccess) { fprintf(stderr, "kernel_launch: memset failed\n"); return; }
    void* args[] = {&a};
    hipError_t e = hipLaunchCooperativeKernel((const void*)fwd_kernel, dim3(grid), dim3(512), args, LDS_BYTES, stream);
    if (e != hipSuccess) fprintf(stderr, "cooperative launch failed: %s (grid %d)\n", hipGetErrorString(e), grid);
}
```

```cpp
#include <hip/hip_runtime.h>
#include <hip/hip_cooperative_groups.h>
#include <cstdio>
#include <cstdint>
namespace cg = cooperative_groups;

#define LAS __attribute__((address_space(3)))
typedef unsigned short bf16_t;
typedef short bf16x8 __attribute__((ext_vector_type(8)));
typedef short s16x4 __attribute__((ext_vector_type(4)));
typedef float f32x4 __attribute__((ext_vector_type(4)));
typedef float f32x16 __attribute__((ext_vector_type(16)));
typedef unsigned u32x4 __attribute__((ext_vector_type(4)));
typedef unsigned u32x2 __attribute__((ext_vector_type(2)));

constexpr int DM = 2048, SEQ = 16384, NREAL = 32768, MROW0 = 32768, MP = 33024, DFF = 5632, INC = 3904, LTOT = 16400;
constexpr float EPS = 1e-6f, LOG2E = 1.4426950408889634f;
constexpr int PJ = 3072;
constexpr int NCHUNK = 257;
constexpr int PARTW = 132;

constexpr size_t MiB = 1u << 20;
constexpr size_t WS_TAB = 1 * MiB, WS_PART = 6 * MiB, WS_SMALL = 9 * MiB;
constexpr size_t SM_SSQP = 1048576;
constexpr size_t SM_OA15 = 0, SM_MIX15 = 8192, SM_H115 = 32768, SM_HN215 = 65536, SM_G15 = 131072, SM_SSQ = 262144;
constexpr size_t WS_W1T = 16 * MiB, WS_WVT = 28 * MiB, WS_WQT = 32 * MiB, WS_WKVT = 34 * MiB, WS_WOT = 36 * MiB, WS_WGT = 44 * MiB, WS_WUT = 66 * MiB, WS_WDT = 88 * MiB;
constexpr size_t WS_HN = 112 * MiB, WS_PROJ = 241 * MiB, WS_VT = 435 * MiB, WS_CQN = 500 * MiB, WS_CKVN = 533 * MiB, WS_QRAW = 550 * MiB, WS_KV = 647 * MiB;
constexpr size_t WS_OUTA = 776 * MiB, WS_OUTB = 840 * MiB, WS_QP = 112 * MiB, WS_KP = 435 * MiB, WS_MIX = 112 * MiB, WS_HN2 = 816 * MiB, WS_G = 112 * MiB, WS_ACT = 464 * MiB;
constexpr size_t WS_END = 944 * MiB;

__device__ __forceinline__ unsigned cvt_pk_bf16(float lo, float hi) { unsigned r; asm volatile("v_cvt_pk_bf16_f32 %0, %1, %2" : "=v"(r) : "v"(lo), "v"(hi)); return r; }
__device__ __forceinline__ float bflo(unsigned u) { return __uint_as_float(u << 16); }
__device__ __forceinline__ float bfhi(unsigned u) { return __uint_as_float(u & 0xffff0000u); }
__device__ __forceinline__ unsigned short f2bf(float f) { unsigned u = __float_as_uint(f); return (unsigned short)((u + 0x7fffu + ((u >> 16) & 1u)) >> 16); }
__device__ __forceinline__ float bfround(float f) { return __uint_as_float(((unsigned)f2bf(f)) << 16); }
__device__ __forceinline__ float wave_sum(float v) {
#pragma unroll
    for (int o = 1; o < 64; o <<= 1) v += __shfl_xor(v, o);
    return v;
}
__device__ __forceinline__ float wave_max(float v) {
#pragma unroll
    for (int o = 1; o < 64; o <<= 1) v = fmaxf(v, __shfl_xor(v, o));
    return v;
}
__device__ __forceinline__ float dot8(u32x4 a, u32x4 b) {
    return bflo(a.x) * bflo(b.x) + bfhi(a.x) * bfhi(b.x) + bflo(a.y) * bflo(b.y) + bfhi(a.y) * bfhi(b.y)
         + bflo(a.z) * bflo(b.z) + bfhi(a.z) * bfhi(b.z) + bflo(a.w) * bflo(b.w) + bfhi(a.w) * bfhi(b.w);
}

namespace pg8 {
#define PG8_LAS __attribute__((address_space(3)))
constexpr int BM = 256, BK = 64, HALF = 128, HTB = HALF * BK * 2, STAGE_BYTES = 8 * HTB, NXCD = 8, WGM = 8;
__host__ __device__ __forceinline__ int lds_byte(int r, int c) { const int st = (r >> 4) * 2 + (c >> 5), rr = r & 15, cc = c & 31, ob = rr * 64 + cc * 2; return st * 1024 + (ob ^ (((ob >> 9) & 1) << 5)); }
__host__ __device__ __forceinline__ void stage_rc(int b, int& R, int& C) { const int st = b / 1024, sb = b % 1024, swz = sb ^ (((sb >> 9) & 1) << 5); R = (st >> 1) * 16 + swz / 64; C = (st & 1) * 32 + (swz % 64) / 2; }
__host__ __device__ __forceinline__ int perm32(int rho) { const int n = rho >> 4, i = rho & 15; return 8 * (i >> 2) + 4 * n + (i & 3); }
struct Unit { int pm, pn; };
struct Gemm { const bf16_t* A; const bf16_t* Bt; int M, N, K; };
struct StaticOrder {
    int nM, nN, nwg, G, c;
    __host__ __device__ void init(int M, int N, int G_, int c_) { nM = M / BM; nN = N / BM; nwg = nM * nN; G = G_; c = c_; }
    __host__ __device__ bool next(int i, Unit& u) const {
        const long L = (long)i * G + c; if (L >= nwg) return false;
        int wgid = (int)L; { const int q = nwg / NXCD, r = nwg % NXCD, xcd = wgid % NXCD, off = wgid / NXCD; wgid = (xcd < r ? xcd * (q + 1) : r * (q + 1) + (xcd - r) * q) + off; }
        const int nig = WGM * nN, gid = wgid / nig, fm = gid * WGM, gsz = (nM - fm) < WGM ? (nM - fm) : WGM;
        u.pm = fm + ((wgid % nig) % gsz); u.pn = (wgid % nig) / gsz; return true;
    }
    __device__ __forceinline__ void a_ready(const Unit&) const {}
    __device__ __forceinline__ void done(const Unit&) const {}
};
struct EpiBf16 {
    static constexpr bool PERM = true, AFTER_DRAIN = false;
    bf16_t* O; int ldc; const float* ssq;
    __device__ __forceinline__ void operator()(const f32x4 (&acc)[2][2][4][2], const Unit& u, int wr, int wc, int fr, int fq) const {
        const int row0 = u.pm * BM + wr * 64 + fr; const int col0 = u.pn * BM + wc * 32 + 8 * fq;
#pragma unroll
        for (int ai = 0; ai < 2; ++ai)
#pragma unroll
            for (int m = 0; m < 4; ++m) { bf16_t* rowp = O + (size_t)(row0 + ai * HALF + m * 16) * ldc + col0;
                const float rsc = ssq ? __builtin_amdgcn_rsqf(ssq[row0 + ai * HALF + m * 16] * (1.f / DM) + EPS) : 1.f;
#pragma unroll
                for (int bj = 0; bj < 2; ++bj) { const f32x4 v0 = acc[ai][bj][m][0] * rsc, v1 = acc[ai][bj][m][1] * rsc;
                    u32x4 w; w.x = cvt_pk_bf16(v0[0], v0[1]); w.y = cvt_pk_bf16(v0[2], v0[3]); w.z = cvt_pk_bf16(v1[0], v1[1]); w.w = cvt_pk_bf16(v1[2], v1[3]);
                    *(u32x4*)(rowp + bj * HALF) = w; } }
    }
};
struct EpiResF32 {
    static constexpr bool PERM = true, AFTER_DRAIN = false;
    const float* base; float* out; int ldc;
    __device__ __forceinline__ void operator()(const f32x4 (&acc)[2][2][4][2], const Unit& u, int wr, int wc, int fr, int fq) const {
        const int row0 = u.pm * BM + wr * 64 + fr; const int col0 = u.pn * BM + wc * 32 + 8 * fq;
#pragma unroll
        for (int ai = 0; ai < 2; ++ai)
#pragma unroll
            for (int m = 0; m < 4; ++m) { const size_t off = (size_t)(row0 + ai * HALF + m * 16) * ldc + col0;
#pragma unroll
                for (int bj = 0; bj < 2; ++bj) {
                    const f32x4 o0 = *(const f32x4*)(base + off + bj * HALF) + acc[ai][bj][m][0], o1 = *(const f32x4*)(base + off + bj * HALF + 4) + acc[ai][bj][m][1];
                    *(f32x4*)(out + off + bj * HALF) = o0; *(f32x4*)(out + off + bj * HALF + 4) = o1; }
                asm volatile("" ::: "memory"); }
    }
};
struct EpiResSsq {
    static constexpr bool PERM = true, AFTER_DRAIN = false;
    const float* base; float* out; bf16_t* xb; float* ssq; int ldc;
    __device__ __forceinline__ void operator()(const f32x4 (&acc)[2][2][4][2], const Unit& u, int wr, int wc, int fr, int fq) const {
        const int row0 = u.pm * BM + wr * 64 + fr; const int col0 = u.pn * BM + wc * 32 + 8 * fq;
#pragma unroll
        for (int ai = 0; ai < 2; ++ai)
#pragma unroll
            for (int m = 0; m < 4; ++m) { const int row = row0 + ai * HALF + m * 16; const size_t off = (size_t)row * ldc + col0; float sq = 0.f;
#pragma unroll
                for (int bj = 0; bj < 2; ++bj) {
                    const f32x4 o0 = *(const f32x4*)(base + off + bj * HALF) + acc[ai][bj][m][0], o1 = *(const f32x4*)(base + off + bj * HALF + 4) + acc[ai][bj][m][1];
                    *(f32x4*)(out + off + bj * HALF) = o0; *(f32x4*)(out + off + bj * HALF + 4) = o1;
                    u32x4 w; w.x = cvt_pk_bf16(o0[0], o0[1]); w.y = cvt_pk_bf16(o0[2], o0[3]); w.z = cvt_pk_bf16(o1[0], o1[1]); w.w = cvt_pk_bf16(o1[2], o1[3]);
                    *(u32x4*)(xb + off + bj * HALF) = w;
                    sq += (o0[0] * o0[0] + o0[1] * o0[1]) + (o0[2] * o0[2] + o0[3] * o0[3]) + (o1[0] * o1[0] + o1[1] * o1[1]) + (o1[2] * o1[2] + o1[3] * o1[3]); }
                sq += __shfl_xor(sq, 16); sq += __shfl_xor(sq, 32);
                if (fq == 0) ssq[(size_t)row * 32 + u.pn * 4 + wc] = sq;
                asm volatile("" ::: "memory"); }
    }
};
struct EpiConvGlu {
    static constexpr bool PERM = true, AFTER_DRAIN = false;
    const bf16_t* Gt; bf16_t* O; int ldc; const float* cw; const float* cb; const float* g15; const float* ssq;
    __device__ __forceinline__ void operator()(const f32x4 (&acc)[2][2][4][2], const Unit& u, int wr, int wc, int fr, int fq) const {
        const int row0 = u.pm * BM + wr * 64 + fr; const int col0 = u.pn * BM + wc * 32 + 8 * fq;
#pragma unroll
        for (int bj = 0; bj < 2; ++bj) {
            const int col = col0 + bj * HALF;
            const f32x4 w0a = *(const f32x4*)(cw + col), w0b = *(const f32x4*)(cw + col + 4);
            const f32x4 w1a = *(const f32x4*)(cw + DFF + col), w1b = *(const f32x4*)(cw + DFF + col + 4);
            const f32x4 w2a = *(const f32x4*)(cw + 2 * DFF + col), w2b = *(const f32x4*)(cw + 2 * DFF + col + 4);
            const f32x4 cba = *(const f32x4*)(cb + col), cbb = *(const f32x4*)(cb + col + 4);
#pragma unroll
            for (int ai = 0; ai < 2; ++ai)
#pragma unroll
                for (int m = 0; m < 4; ++m) {
                    const int row = row0 + ai * HALF + m * 16; const int t = row & (SEQ - 1), b = row >> 14;
                    const bf16_t* gp = Gt + (size_t)row * ldc + col; const float rsc = __builtin_amdgcn_rsqf(ssq[row] * (1.f / DM) + EPS);
                    const u32x4 gc = *(const u32x4*)gp;
                    f32x4 pa, pb, na, nb;
                    if (t == 0) { pa = *(const f32x4*)(g15 + b * DFF + col); pb = *(const f32x4*)(g15 + b * DFF + col + 4); }
                    else { const u32x4 gq = *(const u32x4*)(gp - ldc); pa = (f32x4){bflo(gq.x), bfhi(gq.x), bflo(gq.y), bfhi(gq.y)}; pb = (f32x4){bflo(gq.z), bfhi(gq.z), bflo(gq.w), bfhi(gq.w)}; }
                    if (t == SEQ - 1) { na = (f32x4){0.f, 0.f, 0.f, 0.f}; nb = na; }
                    else { const u32x4 gq = *(const u32x4*)(gp + ldc); na = (f32x4){bflo(gq.x), bfhi(gq.x), bflo(gq.y), bfhi(gq.y)}; nb = (f32x4){bflo(gq.z), bfhi(gq.z), bflo(gq.w), bfhi(gq.w)}; }
                    const f32x4 ca = (f32x4){bflo(gc.x), bfhi(gc.x), bflo(gc.y), bfhi(gc.y)}, cbv = (f32x4){bflo(gc.z), bfhi(gc.z), bflo(gc.w), bfhi(gc.w)};
                    f32x4 ra, rb;
#pragma unroll
                    for (int e = 0; e < 4; ++e) {
                        const float xa = __builtin_fmaf(w2a[e], na[e], __builtin_fmaf(w1a[e], ca[e], __builtin_fmaf(w0a[e], pa[e], cba[e])));
                        const float xb = __builtin_fmaf(w2b[e], nb[e], __builtin_fmaf(w1b[e], cbv[e], __builtin_fmaf(w0b[e], pb[e], cbb[e])));
                        ra[e] = (xa * __builtin_amdgcn_rcpf(1.f + __builtin_amdgcn_exp2f(xa * -LOG2E))) * (acc[ai][bj][m][0][e] * rsc);
                        rb[e] = (xb * __builtin_amdgcn_rcpf(1.f + __builtin_amdgcn_exp2f(xb * -LOG2E))) * (acc[ai][bj][m][1][e] * rsc); }
                    u32x4 w; w.x = cvt_pk_bf16(ra[0], ra[1]); w.y = cvt_pk_bf16(ra[2], ra[3]); w.z = cvt_pk_bf16(rb[0], rb[1]); w.w = cvt_pk_bf16(rb[2], rb[3]);
                    *(u32x4*)(O + (size_t)row * ldc + col) = w;
                }
        }
    }
};

template <class Epi, class Sched, bool ALIGN_EPI = false, bool SP2 = false>
__device__ __forceinline__ void gemm_phase(PG8_LAS unsigned char* lds, const Gemm g, const Sched& S, const Epi& E, const int tid) {
    const int wid = __builtin_amdgcn_readfirstlane(tid >> 6), lane = tid & 63, wr = wid >> 2, wc = wid & 3, fr = lane & 15, fq = lane >> 4;
    const int K = g.K, nt = K / BK;
    unsigned voffA[2], voffB[2];
#pragma unroll
    for (int i = 0; i < 2; ++i) { int R, C; stage_rc(tid * 16 + i * 8192, R, C); const int Rb = Epi::PERM ? ((R & ~31) + perm32(R & 31)) : R;
        voffA[i] = (unsigned)(R * K + C) * 2u; voffB[i] = (unsigned)(Rb * K + C) * 2u; }
    const size_t kstep = (size_t)(BK * 2);
    const size_t hstep = (size_t)HALF * K * 2;
    const size_t tstep = 2 * hstep;
    const unsigned ldsw = (unsigned)wid * 1024u;
    const int aoff = lds_byte(wr * 64 + fr, fq * 8), boff = lds_byte(wc * 32 + fr, fq * 8);
#define PG8_SA(b, h) (((b) * 2 + (h)) * HTB)
#define PG8_SB(b, h) ((4 + (b) * 2 + (h)) * HTB)
#define PG8_STAGE(bufoff, gbase, voff) do { _Pragma("unroll") for (int _i = 0; _i < 2; ++_i) \
        __builtin_amdgcn_global_load_lds((const unsigned*)((const char*)(gbase) + (voff)[_i]), (PG8_LAS unsigned*)(lds + (bufoff) + ldsw + _i * 8192), 16, 0, 0); } while (0)
#define PG8_LDA(dst, b, h) do { _Pragma("unroll") for (int m = 0; m < 4; ++m) _Pragma("unroll") for (int k = 0; k < 2; ++k) dst[m][k] = *(const PG8_LAS bf16x8*)(lds + PG8_SA(b, h) + aoff + m * 2048 + k * 1024); } while (0)
#define PG8_LDB(dst, b, h) do { _Pragma("unroll") for (int n = 0; n < 2; ++n) _Pragma("unroll") for (int k = 0; k < 2; ++k) dst[n][k] = *(const PG8_LAS bf16x8*)(lds + PG8_SB(b, h) + boff + n * 2048 + k * 1024); } while (0)
#define PG8_MMA(ai, bj, At, Bt) do { __builtin_amdgcn_s_setprio(1); _Pragma("unroll") for (int m = 0; m < 4; ++m) _Pragma("unroll") for (int n = 0; n < 2; ++n) _Pragma("unroll") for (int k = 0; k < 2; ++k) \
        acc[ai][bj][m][n] = __builtin_amdgcn_mfma_f32_16x16x32_bf16(Bt[n][k], At[m][k], acc[ai][bj][m][n], 0, 0, 0); __builtin_amdgcn_s_setprio(0); } while (0)
#define PG8_WAIT_V(n) asm volatile("s_waitcnt vmcnt(" #n ")" ::: "memory")
#define PG8_WAIT_L(n) asm volatile("s_waitcnt lgkmcnt(" #n ")" ::: "memory")
#define PG8_BAR __builtin_amdgcn_s_barrier()
#define PG8_SCHED __builtin_amdgcn_sched_barrier(0)
    Unit cur, nxt; int ui = 0;
    if (!S.next(0, cur)) return;
    f32x4 acc[2][2][4][2];
#pragma unroll
    for (int a = 0; a < 2; ++a)
#pragma unroll
        for (int b = 0; b < 2; ++b)
#pragma unroll
            for (int m = 0; m < 4; ++m)
#pragma unroll
                for (int n = 0; n < 2; ++n) acc[a][b][m][n] = (f32x4){0.f, 0.f, 0.f, 0.f};
    bf16x8 At[4][2], B0[2][2], B1[2][2];
    const char* cA = (const char*)g.A + (size_t)cur.pm * tstep; const char* cB = (const char*)g.Bt + (size_t)cur.pn * tstep;
    S.a_ready(cur);
    if constexpr (SP2) {
        PG8_STAGE(PG8_SB(0, 0), cB, voffB); PG8_STAGE(PG8_SB(0, 1), cB + hstep, voffB); PG8_STAGE(PG8_SA(0, 0), cA, voffA); PG8_STAGE(PG8_SA(0, 1), cA + hstep, voffA);
        if (wr == 1) PG8_BAR;
        PG8_WAIT_V(2); PG8_BAR;
        PG8_STAGE(PG8_SB(1, 0), cB + kstep, voffB); PG8_STAGE(PG8_SA(1, 0), cA + kstep, voffA); PG8_STAGE(PG8_SB(1, 1), cB + hstep + kstep, voffB);
        PG8_WAIT_V(6); PG8_BAR;
    } else {
        PG8_STAGE(PG8_SB(0, 0), cB, voffB); PG8_STAGE(PG8_SA(0, 0), cA, voffA); PG8_STAGE(PG8_SB(0, 1), cB + hstep, voffB); PG8_STAGE(PG8_SA(0, 1), cA + hstep, voffA);
        if (wr == 1) PG8_BAR;
        PG8_WAIT_V(4); PG8_BAR;
        PG8_STAGE(PG8_SB(1, 0), cB + kstep, voffB); PG8_STAGE(PG8_SA(1, 0), cA + kstep, voffA); PG8_STAGE(PG8_SB(1, 1), cB + hstep + kstep, voffB);
        PG8_WAIT_V(6); PG8_BAR;
    }
    for (;;) {
        const bool has_next = S.next(ui + 1, nxt);
        const char* nA = has_next ? (const char*)g.A + (size_t)nxt.pm * tstep : cA; const char* nB = has_next ? (const char*)g.Bt + (size_t)nxt.pn * tstep : cB;
        for (int t = 0; t < nt; t += 2) {
            const bool last = (t == nt - 2);
            const char* a1 = cA + (size_t)(t + 1) * kstep;
            const char* a2 = last ? nA : cA + (size_t)(t + 2) * kstep; const char* b2 = last ? nB : cB + (size_t)(t + 2) * kstep;
            const char* a3 = a2 + kstep; const char* b3 = b2 + kstep;
            if (last && has_next) S.a_ready(nxt);
            if constexpr (SP2) {
            PG8_LDB(B0, 0, 0); PG8_LDB(B1, 0, 1); PG8_SCHED; PG8_LDA(At, 0, 0); PG8_STAGE(PG8_SA(1, 1), a1 + hstep, voffA);
            PG8_WAIT_V(8); PG8_WAIT_L(0); PG8_BAR; PG8_MMA(0, 0, At, B0); PG8_MMA(0, 1, At, B1); PG8_BAR; PG8_SCHED;
            PG8_LDA(At, 0, 1); PG8_STAGE(PG8_SB(0, 0), b2, voffB); PG8_STAGE(PG8_SB(0, 1), b2 + hstep, voffB); PG8_STAGE(PG8_SA(0, 0), a2, voffA);
            PG8_WAIT_V(8); PG8_WAIT_L(0); PG8_BAR; PG8_MMA(1, 0, At, B0); PG8_MMA(1, 1, At, B1); PG8_BAR; PG8_SCHED;
            PG8_LDB(B0, 1, 0); PG8_LDB(B1, 1, 1); PG8_SCHED; PG8_LDA(At, 1, 0); PG8_STAGE(PG8_SA(0, 1), a2 + hstep, voffA);
            PG8_WAIT_V(8); PG8_WAIT_L(0); PG8_BAR; PG8_MMA(0, 0, At, B0); PG8_MMA(0, 1, At, B1); PG8_BAR; PG8_SCHED;
            PG8_LDA(At, 1, 1); PG8_STAGE(PG8_SB(1, 0), b3, voffB); PG8_STAGE(PG8_SB(1, 1), b3 + hstep, voffB); PG8_STAGE(PG8_SA(1, 0), a3, voffA);
            PG8_WAIT_V(8); PG8_WAIT_L(0); PG8_BAR; PG8_MMA(1, 0, At, B0); PG8_MMA(1, 1, At, B1); PG8_BAR; PG8_SCHED;
            } else {
            PG8_LDB(B0, 0, 0); PG8_SCHED; PG8_LDA(At, 0, 0); PG8_STAGE(PG8_SA(1, 1), a1 + hstep, voffA);
            PG8_WAIT_L(8); PG8_BAR; PG8_WAIT_L(0); PG8_MMA(0, 0, At, B0); PG8_BAR; PG8_SCHED;
            PG8_LDB(B1, 0, 1); PG8_STAGE(PG8_SB(0, 0), b2, voffB);
            PG8_BAR; PG8_WAIT_L(0); PG8_MMA(0, 1, At, B1); PG8_BAR;
            PG8_LDA(At, 0, 1); PG8_STAGE(PG8_SA(0, 0), a2, voffA);
            PG8_BAR; PG8_WAIT_L(0); PG8_MMA(1, 0, At, B0); PG8_BAR; PG8_SCHED;
            PG8_STAGE(PG8_SB(0, 1), b2 + hstep, voffB);
            PG8_WAIT_V(6); PG8_BAR; PG8_MMA(1, 1, At, B1); PG8_BAR;
            PG8_LDB(B0, 1, 0); PG8_SCHED; PG8_LDA(At, 1, 0); PG8_STAGE(PG8_SA(0, 1), a2 + hstep, voffA);
            PG8_WAIT_L(8); PG8_BAR; PG8_WAIT_L(0); PG8_MMA(0, 0, At, B0); PG8_BAR; PG8_SCHED;
            PG8_LDB(B1, 1, 1); PG8_STAGE(PG8_SB(1, 0), b3, voffB);
            PG8_BAR; PG8_WAIT_L(0); PG8_MMA(0, 1, At, B1); PG8_BAR;
            PG8_LDA(At, 1, 1); PG8_STAGE(PG8_SA(1, 0), a3, voffA);
            PG8_BAR; PG8_WAIT_L(0); PG8_MMA(1, 0, At, B0); PG8_BAR; PG8_SCHED;
            PG8_STAGE(PG8_SB(1, 1), b3 + hstep, voffB);
            PG8_WAIT_V(6); PG8_BAR; PG8_MMA(1, 1, At, B1); PG8_BAR;
            }
        }
        if constexpr (ALIGN_EPI) { if (wr == 0) PG8_BAR; }
        if constexpr (!Epi::AFTER_DRAIN) { E(acc, cur, wr, wc, fr, fq); S.done(cur); }
        if (!has_next) break;
#pragma unroll
        for (int a = 0; a < 2; ++a)
#pragma unroll
            for (int b = 0; b < 2; ++b)
#pragma unroll
                for (int m = 0; m < 4; ++m)
#pragma unroll
                    for (int n = 0; n < 2; ++n) acc[a][b][m][n] = (f32x4){0.f, 0.f, 0.f, 0.f};
        cur = nxt; cA = nA; cB = nB; ++ui;
        if constexpr (ALIGN_EPI) { if (wr == 1) PG8_BAR; }
    }
    PG8_WAIT_V(0);
    if constexpr (!ALIGN_EPI) { if (wr == 0) PG8_BAR; }
    PG8_BAR;
#undef PG8_SA
#undef PG8_SB
#undef PG8_STAGE
#undef PG8_LDA
#undef PG8_LDB
#undef PG8_MMA
#undef PG8_WAIT_V
#undef PG8_WAIT_L
#undef PG8_BAR
#undef PG8_SCHED
}
}

namespace mla {
constexpr int NW = 8, QBLK = 32, KVBLK = 64;
constexpr float SCALE = 0.07216878364870322f;
constexpr float THR = 8.f;
constexpr int SHM_V = 64 * 128 * 2, SHM_K = 64 * 192 * 2, SHM_ATTN = 2 * SHM_V + 2 * SHM_K + NW * 64 * 4;
constexpr int LDQ = 1536, LDKK = 1536, LDV = 2048, LDO = 1024;
#define SBAR() __builtin_amdgcn_sched_barrier(0)
__device__ __forceinline__ int crow(int r, int hi) { return (r & 3) + 8 * (r >> 2) + 4 * hi; }
__device__ __forceinline__ void partialSM(f32x16& p0, f32x16& p1, float& m_reg, float& mn, float& alpha) {
  constexpr float C = SCALE * 1.4426950408889634f;
  float pmax = p0[0];
#pragma unroll
  for (int r = 1; r < 16; ++r) pmax = fmaxf(pmax, p0[r]);
#pragma unroll
  for (int r = 0; r < 16; ++r) pmax = fmaxf(pmax, p1[r]);
  { auto rr = __builtin_amdgcn_permlane32_swap(__float_as_uint(pmax), __float_as_uint(pmax), false, false);
    pmax = fmaxf(__uint_as_float(rr[0]), __uint_as_float(rr[1])); }
  if (__builtin_expect(__all(pmax - m_reg <= THR / SCALE), 1)) { mn = m_reg; alpha = 1.f; }
  else { mn = fmaxf(m_reg, pmax); alpha = __builtin_amdgcn_exp2f((m_reg - mn) * C); m_reg = mn; }
  float mnC = -mn * C;
#pragma unroll
  for (int r = 0; r < 16; ++r) p0[r] = fmaf(p0[r], C, mnC);
#pragma unroll
  for (int r = 0; r < 16; ++r) p1[r] = fmaf(p1[r], C, mnC);
#pragma unroll
  for (int r = 0; r < 16; ++r) p0[r] = __builtin_amdgcn_exp2f(p0[r]);
}
__device__ __forceinline__ void finishSM(f32x16& p0, f32x16& p1, float alpha, float& l_reg, bf16x8& pa0, bf16x8& pa1, bf16x8& pa2, bf16x8& pa3) {
#pragma unroll
  for (int r = 0; r < 16; ++r) p1[r] = __builtin_amdgcn_exp2f(p1[r]);
  float ps = 0;
#pragma unroll
  for (int r = 0; r < 16; ++r) ps += p0[r];
#pragma unroll
  for (int r = 0; r < 16; ++r) ps += p1[r];
  { auto rr = __builtin_amdgcn_permlane32_swap(__float_as_uint(ps), __float_as_uint(ps), false, false);
    ps = __uint_as_float(rr[0]) + __uint_as_float(rr[1]); }
  l_reg = l_reg * alpha + ps;
#define PK4(P, BASE, OUT) do { unsigned a0 = cvt_pk_bf16(P[BASE + 0], P[BASE + 1]), a1 = cvt_pk_bf16(P[BASE + 2], P[BASE + 3]);   \
    unsigned b0 = cvt_pk_bf16(P[BASE + 4], P[BASE + 5]), b1 = cvt_pk_bf16(P[BASE + 6], P[BASE + 7]);                              \
    auto r0 = __builtin_amdgcn_permlane32_swap(a0, b0, false, false); auto r1 = __builtin_amdgcn_permlane32_swap(a1, b1, false, false); \
    u32x4 w = {r0[0], r1[0], r0[1], r1[1]}; OUT = *reinterpret_cast<bf16x8*>(&w); } while (0)
  PK4(p0, 0, pa0); PK4(p0, 8, pa1); PK4(p1, 0, pa2); PK4(p1, 8, pa3);
#undef PK4
}
__device__ __forceinline__ void qkt(f32x16& p0, f32x16& p1, const char* Ks, const bf16x8* qr, const int* kb4) {
  p0 = f32x16{}; p1 = f32x16{};
#pragma unroll
  for (int d0 = 0; d0 < 12; ++d0) {
    bf16x8 b0 = *reinterpret_cast<const bf16x8*>(Ks + kb4[d0 & 3] + (d0 >> 2) * 128);
    bf16x8 b1 = *reinterpret_cast<const bf16x8*>(Ks + kb4[d0 & 3] + (d0 >> 2) * 128 + 32 * 384);
    p0 = __builtin_amdgcn_mfma_f32_32x32x16_bf16(b0, qr[d0], p0, 0, 0, 0);
    p1 = __builtin_amdgcn_mfma_f32_32x32x16_bf16(b1, qr[d0], p1, 0, 0, 0); }
}
__device__ __forceinline__ int v_st(int k, int c) { const int kk = (k & ~0xC) | ((k & 4) << 1) | ((k & 8) >> 1); return ((kk >> 3) * 4 + (c >> 5)) * 512 + ((kk & 7) * 32 + (c & 31)) * 2; }
__device__ __forceinline__ int v_rd_base(int lane) { return ((lane & 3) << 3) | (((lane >> 2) & 3) << 6) | (((lane >> 4) & 1) << 5) | (((lane >> 5) & 1) << 8); }
constexpr int v_rd_off(int d0, int ks, int half) { return d0 * 512 + ks * 4096 + half * 2048; }
template <int OFF> __device__ __forceinline__ s16x4 tr_read(int vb) {
  s16x4 r; asm volatile("ds_read_b64_tr_b16 %0, %1 offset:%2" : "=&v"(r) : "v"(vb), "i"(OFF) : "memory"); return r;
}
template <int D0> __device__ __forceinline__ void pv_one(f32x16& od, int vb, bf16x8 pa0, bf16x8 pa1, bf16x8 pa2, bf16x8 pa3) {
  const s16x4 l0 = tr_read<v_rd_off(D0, 0, 0)>(vb), h0 = tr_read<v_rd_off(D0, 0, 1)>(vb), l1 = tr_read<v_rd_off(D0, 1, 0)>(vb), h1 = tr_read<v_rd_off(D0, 1, 1)>(vb);
  const s16x4 l2 = tr_read<v_rd_off(D0, 2, 0)>(vb), h2 = tr_read<v_rd_off(D0, 2, 1)>(vb), l3 = tr_read<v_rd_off(D0, 3, 0)>(vb), h3 = tr_read<v_rd_off(D0, 3, 1)>(vb);
  asm volatile("s_waitcnt lgkmcnt(0)" ::: "memory"); SBAR();
#define PK(L, H) (bf16x8){L[0], L[1], L[2], L[3], H[0], H[1], H[2], H[3]}
  od = __builtin_amdgcn_mfma_f32_32x32x16_bf16(pa0, PK(l0, h0), od, 0, 0, 0);
  od = __builtin_amdgcn_mfma_f32_32x32x16_bf16(pa1, PK(l1, h1), od, 0, 0, 0);
  od = __builtin_amdgcn_mfma_f32_32x32x16_bf16(pa2, PK(l2, h2), od, 0, 0, 0);
  od = __builtin_amdgcn_mfma_f32_32x32x16_bf16(pa3, PK(l3, h3), od, 0, 0, 0);
#undef PK
}
__device__ __forceinline__ void pv_d0(f32x16* o, int vb, bf16x8 pa0, bf16x8 pa1, bf16x8 pa2, bf16x8 pa3) {
  pv_one<0>(o[0], vb, pa0, pa1, pa2, pa3); pv_one<1>(o[1], vb, pa0, pa1, pa2, pa3); pv_one<2>(o[2], vb, pa0, pa1, pa2, pa3); pv_one<3>(o[3], vb, pa0, pa1, pa2, pa3);
}

__device__ __forceinline__ void attn_unit(const bf16_t* __restrict__ Qb, const bf16_t* __restrict__ Kh, const bf16_t* __restrict__ Vh,
                                          bf16_t* __restrict__ Ob, int metaRow, int realRow0, char* lds, const int tid) {
  const int wid = tid >> 6, lane = tid & 63, r32 = lane & 31, hi = lane >> 5;
  char* V_lds = lds; char* K_lds = lds + 2 * SHM_V;
  float* ws = (float*)(lds + 2 * SHM_V + 2 * SHM_K) + wid * 64; float* li_l = ws; float* al_l = ws + 32;
  float m_reg = -1e30f, l_reg = 0; f32x16 o[4] = {}; bf16x8 qr[12];
  const bf16_t* Qw = Qb + (long)(wid * QBLK + r32) * LDQ + hi * 8;
#pragma unroll
  for (int d0 = 0; d0 < 12; ++d0) qr[d0] = *reinterpret_cast<const bf16x8*>(Qw + d0 * 16);
  const int sr = tid >> 3, vc = (tid & 7) * 8, vst0 = v_st(sr, vc);
  const int vgo0 = sr * LDV + vc;
  const int kgo0 = sr * LDKK + vc, klo0 = sr * 384 + ((vc * 2) ^ (((sr >> 1) & 7) << 4));
  int kb4[4];
#pragma unroll
  for (int q = 0; q < 4; ++q) kb4[q] = r32 * 384 + ((q * 32 + hi * 16) ^ (((r32 >> 1) & 7) << 4));
  const int vb0 = (int)(uintptr_t)V_lds + v_rd_base(lane);
  bf16x8 vs0, vs1, ks0, ks1, ks2;
#define TROW(t) ((t) == 0 ? (long)metaRow : (long)realRow0 + (long)((t) - 1) * KVBLK)
#define SLOAD(t) do { const long r0_ = TROW(t); const bf16_t* vp_ = Vh + r0_ * LDV + vgo0; const bf16_t* kp_ = Kh + r0_ * LDKK + kgo0; \
    vs0 = *reinterpret_cast<const bf16x8*>(vp_); vs1 = *reinterpret_cast<const bf16x8*>(vp_ + 64); \
    ks0 = *reinterpret_cast<const bf16x8*>(kp_); ks1 = *reinterpret_cast<const bf16x8*>(kp_ + 64); ks2 = *reinterpret_cast<const bf16x8*>(kp_ + 128); } while (0)
#define SWRITE(b) do { *(bf16x8*)(V_lds + (b) * SHM_V + vst0) = vs0; *(bf16x8*)(V_lds + (b) * SHM_V + vst0 + 1024) = vs1; \
    *(bf16x8*)(K_lds + (b) * SHM_K + klo0) = ks0; *(bf16x8*)(K_lds + (b) * SHM_K + klo0 + 128) = ks1; *(bf16x8*)(K_lds + (b) * SHM_K + klo0 + 256) = ks2; } while (0)
#define SWAIT() asm volatile("s_waitcnt vmcnt(0)" ::: "memory")
#define BARL() asm volatile("s_waitcnt lgkmcnt(0)\n\ts_barrier" ::: "memory")
#define RESC(a) do { if (__any((a) < 1.f)) { if (hi == 0) al_l[r32] = (a); asm volatile("s_waitcnt lgkmcnt(0)" ::: "memory"); \
    _Pragma("unroll") for (int d = 0; d < 4; ++d) _Pragma("unroll") for (int r = 0; r < 16; ++r) o[d][r] *= al_l[crow(r, hi)]; } } while (0)
  f32x16 pA0, pA1, pB0, pB1; float mnA, mnB, alA, alB; bf16x8 pa0, pa1, pa2, pa3; constexpr int NT = NCHUNK;
  SLOAD(0); SWAIT(); SWRITE(0); __syncthreads();
  qkt(pA0, pA1, K_lds, qr, kb4);
#pragma unroll
  for (int r = 8; r < 16; ++r) pA0[r] = -1e30f;
#pragma unroll
  for (int r = 0; r < 16; ++r) pA1[r] = -1e30f;
  partialSM(pA0, pA1, m_reg, mnA, alA);
  SLOAD(1); SWAIT(); SWRITE(1); SLOAD(2); BARL();
  for (int j = 1; j + 1 < NT; j += 2) {
    SBAR(); qkt(pB0, pB1, K_lds + SHM_K, qr, kb4);
    finishSM(pA0, pA1, alA, l_reg, pa0, pa1, pa2, pa3); SBAR();
    pv_d0(o, vb0, pa0, pa1, pa2, pa3); partialSM(pB0, pB1, m_reg, mnB, alB);
    BARL(); SWAIT(); SWRITE(0); if (j + 2 < NT) SLOAD(j + 2);
    RESC(alB); BARL();
    SBAR(); qkt(pA0, pA1, K_lds, qr, kb4);
    finishSM(pB0, pB1, alB, l_reg, pa0, pa1, pa2, pa3); SBAR();
    pv_d0(o, vb0 + (int)SHM_V, pa0, pa1, pa2, pa3); partialSM(pA0, pA1, m_reg, mnA, alA);
    BARL(); if (j + 2 < NT) { SWAIT(); SWRITE(1); } if (j + 3 < NT) SLOAD(j + 3);
    RESC(alA); BARL();
  }
  finishSM(pA0, pA1, alA, l_reg, pa0, pa1, pa2, pa3); SBAR();
  pv_d0(o, vb0, pa0, pa1, pa2, pa3);
  if (hi == 0) li_l[r32] = l_reg; asm volatile("s_waitcnt lgkmcnt(0)" ::: "memory");
  float rli[16];
#pragma unroll
  for (int r = 0; r < 16; ++r) rli[r] = __builtin_amdgcn_rcpf(li_l[crow(r, hi)]);
  bf16_t* Ow = Ob + (long)(wid * QBLK) * LDO;
#pragma unroll
  for (int r = 0; r < 16; ++r) { const int orow = crow(r, hi);
#pragma unroll
    for (int d0 = 0; d0 < 4; ++d0) Ow[(long)orow * LDO + d0 * 32 + r32] = f2bf(o[d0][r] * rli[r]); }
  __syncthreads();
#undef TROW
#undef SLOAD
#undef SWRITE
#undef SWAIT
#undef RESC
}


__device__ __forceinline__ void qkt2(f32x16& p0, f32x16& p1, const char* Ks, const bf16x8* qr, const int* kb4) {
#define KLD(d, half) (*reinterpret_cast<const bf16x8*>(Ks + kb4[(d) & 3] + ((d) >> 2) * 128 + (half) * 12288))
  p0 = f32x16{}; p1 = f32x16{};
  bf16x8 a0 = KLD(0, 0), b0 = KLD(0, 1), a1 = KLD(1, 0), b1 = KLD(1, 1), a2, b2;
#define QSTEP(d, A, B, NA, NB) do { if ((d) + 2 < 12) { NA = KLD((d) + 2, 0); NB = KLD((d) + 2, 1); } SBAR(); \
    p0 = __builtin_amdgcn_mfma_f32_32x32x16_bf16(A, qr[d], p0, 0, 0, 0); p1 = __builtin_amdgcn_mfma_f32_32x32x16_bf16(B, qr[d], p1, 0, 0, 0); SBAR(); } while (0)
  QSTEP(0, a0, b0, a2, b2); QSTEP(1, a1, b1, a0, b0); QSTEP(2, a2, b2, a1, b1);
  QSTEP(3, a0, b0, a2, b2); QSTEP(4, a1, b1, a0, b0); QSTEP(5, a2, b2, a1, b1);
  QSTEP(6, a0, b0, a2, b2); QSTEP(7, a1, b1, a0, b0); QSTEP(8, a2, b2, a1, b1);
  QSTEP(9, a0, b0, a2, b2); QSTEP(10, a1, b1, a0, b0); QSTEP(11, a2, b2, a1, b1);
#undef QSTEP
#undef KLD
}
struct VSet { s16x4 l0, h0, l1, h1, l2, h2, l3, h3; };
template <int D0> __device__ __forceinline__ void v_issue(VSet& s, int vb) {
  s.l0 = tr_read<v_rd_off(D0, 0, 0)>(vb); s.h0 = tr_read<v_rd_off(D0, 0, 1)>(vb); s.l1 = tr_read<v_rd_off(D0, 1, 0)>(vb); s.h1 = tr_read<v_rd_off(D0, 1, 1)>(vb);
  s.l2 = tr_read<v_rd_off(D0, 2, 0)>(vb); s.h2 = tr_read<v_rd_off(D0, 2, 1)>(vb); s.l3 = tr_read<v_rd_off(D0, 3, 0)>(vb); s.h3 = tr_read<v_rd_off(D0, 3, 1)>(vb);
}
__device__ __forceinline__ void v_mma(f32x16& od, VSet& s, bf16x8 pa0, bf16x8 pa1, bf16x8 pa2, bf16x8 pa3) {
  asm volatile("" : "+v"(s.l0), "+v"(s.h0), "+v"(s.l1), "+v"(s.h1), "+v"(s.l2), "+v"(s.h2), "+v"(s.l3), "+v"(s.h3));
#define PK(L, H) (bf16x8){L[0], L[1], L[2], L[3], H[0], H[1], H[2], H[3]}
  od = __builtin_amdgcn_mfma_f32_32x32x16_bf16(pa0, PK(s.l0, s.h0), od, 0, 0, 0);
  od = __builtin_amdgcn_mfma_f32_32x32x16_bf16(pa1, PK(s.l1, s.h1), od, 0, 0, 0);
  od = __builtin_amdgcn_mfma_f32_32x32x16_bf16(pa2, PK(s.l2, s.h2), od, 0, 0, 0);
  od = __builtin_amdgcn_mfma_f32_32x32x16_bf16(pa3, PK(s.l3, s.h3), od, 0, 0, 0);
#undef PK
}
__device__ __forceinline__ void pv2(f32x16* o, int vb, bf16x8 pa0, bf16x8 pa1, bf16x8 pa2, bf16x8 pa3) {
  VSet X, Y;
  SBAR(); v_issue<0>(X, vb); v_issue<1>(Y, vb);
  asm volatile("s_waitcnt lgkmcnt(8)" ::: "memory"); SBAR(); v_mma(o[0], X, pa0, pa1, pa2, pa3); SBAR();
  v_issue<2>(X, vb);
  asm volatile("s_waitcnt lgkmcnt(8)" ::: "memory"); SBAR(); v_mma(o[1], Y, pa0, pa1, pa2, pa3); SBAR();
  v_issue<3>(Y, vb);
  asm volatile("s_waitcnt lgkmcnt(8)" ::: "memory"); SBAR(); v_mma(o[2], X, pa0, pa1, pa2, pa3); SBAR();
  asm volatile("s_waitcnt lgkmcnt(0)" ::: "memory"); SBAR(); v_mma(o[3], Y, pa0, pa1, pa2, pa3); SBAR();
}
__device__ __forceinline__ void attn_unit2(const bf16_t* __restrict__ Qb, const bf16_t* __restrict__ Kh, const bf16_t* __restrict__ Vh,
                                           bf16_t* __restrict__ Ob, int metaRow, int realRow0, char* lds, const int tid,
                                           const float* __restrict__ qgain, const float* __restrict__ tab, int pos0) {
  const int wid = __builtin_amdgcn_readfirstlane(tid >> 6), lane = tid & 63, r32 = lane & 31, hi = lane >> 5;
  char* V_lds = lds; char* K_lds = lds + 2 * SHM_V;
  float* ws = (float*)(lds + 2 * SHM_V + 2 * SHM_K) + wid * 64; float* li_l = ws; float* al_l = ws + 32;
  float m_reg = -1e30f, l_reg = 0; f32x16 o[4] = {}; bf16x8 qr[12];
  const bf16_t* Qw = Qb + (long)(wid * QBLK + r32) * LDQ + hi * 8;
#pragma unroll
  for (int d0 = 0; d0 < 12; ++d0) qr[d0] = *reinterpret_cast<const bf16x8*>(Qw + d0 * 16);
  {
    float ss = 0.f;
#pragma unroll
    for (int d0 = 0; d0 < 12; ++d0) { const u32x4 v = __builtin_bit_cast(u32x4, qr[d0]);
      const float f0 = bflo(v.x), f1 = bfhi(v.x), f2 = bflo(v.y), f3 = bfhi(v.y), f4 = bflo(v.z), f5 = bfhi(v.z), f6 = bflo(v.w), f7 = bfhi(v.w);
      ss += (f0 * f0 + f1 * f1) + (f2 * f2 + f3 * f3) + (f4 * f4 + f5 * f5) + (f6 * f6 + f7 * f7); }
    { auto rr = __builtin_amdgcn_permlane32_swap(__float_as_uint(ss), __float_as_uint(ss), false, false); ss = __uint_as_float(rr[0]) + __uint_as_float(rr[1]); }
    const float rs = __builtin_amdgcn_rsqf(ss * (1.f / 192.f) + EPS);
#pragma unroll
    for (int d0 = 0; d0 < 8; ++d0) { const u32x4 v = __builtin_bit_cast(u32x4, qr[d0]); const float* gp = qgain + 16 * d0 + 8 * hi; const f32x4 g0 = *(const f32x4*)gp, g1 = *(const f32x4*)(gp + 4);
      u32x4 w; w.x = cvt_pk_bf16(bflo(v.x) * rs * g0.x, bfhi(v.x) * rs * g0.y); w.y = cvt_pk_bf16(bflo(v.y) * rs * g0.z, bfhi(v.y) * rs * g0.w);
      w.z = cvt_pk_bf16(bflo(v.z) * rs * g1.x, bfhi(v.z) * rs * g1.y); w.w = cvt_pk_bf16(bflo(v.w) * rs * g1.z, bfhi(v.w) * rs * g1.w); qr[d0] = __builtin_bit_cast(bf16x8, w); }
    const float* tb = tab + ((size_t)(pos0 + wid * QBLK + r32) * 32 + 8 * hi) * 2;
#pragma unroll
    for (int dd = 0; dd < 2; ++dd) {
      const u32x4 va = __builtin_bit_cast(u32x4, qr[8 + dd]), vb = __builtin_bit_cast(u32x4, qr[10 + dd]);
      const float* ga = qgain + 128 + 16 * dd + 8 * hi; const float* gb = ga + 32; const float* tc = tb + 32 * dd;
      const f32x4 a0 = *(const f32x4*)ga, a1 = *(const f32x4*)(ga + 4), b0 = *(const f32x4*)gb, b1 = *(const f32x4*)(gb + 4);
      const f32x4 c0 = *(const f32x4*)tc, c1 = *(const f32x4*)(tc + 4), c2 = *(const f32x4*)(tc + 8), c3 = *(const f32x4*)(tc + 12);
      const float x0 = bflo(va.x) * rs * a0.x, x1 = bfhi(va.x) * rs * a0.y, x2 = bflo(va.y) * rs * a0.z, x3 = bfhi(va.y) * rs * a0.w, x4 = bflo(va.z) * rs * a1.x, x5 = bfhi(va.z) * rs * a1.y, x6 = bflo(va.w) * rs * a1.z, x7 = bfhi(va.w) * rs * a1.w;
      const float y0 = bflo(vb.x) * rs * b0.x, y1 = bfhi(vb.x) * rs * b0.y, y2 = bflo(vb.y) * rs * b0.z, y3 = bfhi(vb.y) * rs * b0.w, y4 = bflo(vb.z) * rs * b1.x, y5 = bfhi(vb.z) * rs * b1.y, y6 = bflo(vb.w) * rs * b1.z, y7 = bfhi(vb.w) * rs * b1.w;
      u32x4 wa, wb;
      wa.x = cvt_pk_bf16(x0 * c0.x - y0 * c0.y, x1 * c0.z - y1 * c0.w); wa.y = cvt_pk_bf16(x2 * c1.x - y2 * c1.y, x3 * c1.z - y3 * c1.w);
      wa.z = cvt_pk_bf16(x4 * c2.x - y4 * c2.y, x5 * c2.z - y5 * c2.w); wa.w = cvt_pk_bf16(x6 * c3.x - y6 * c3.y, x7 * c3.z - y7 * c3.w);
      wb.x = cvt_pk_bf16(y0 * c0.x + x0 * c0.y, y1 * c0.z + x1 * c0.w); wb.y = cvt_pk_bf16(y2 * c1.x + x2 * c1.y, y3 * c1.z + x3 * c1.w);
      wb.z = cvt_pk_bf16(y4 * c2.x + x4 * c2.y, y5 * c2.z + x5 * c2.w); wb.w = cvt_pk_bf16(y6 * c3.x + x6 * c3.y, y7 * c3.z + x7 * c3.w);
      qr[8 + dd] = __builtin_bit_cast(bf16x8, wa); qr[10 + dd] = __builtin_bit_cast(bf16x8, wb); }
  }
  const int sr = tid >> 3, vc = (tid & 7) * 8, vst0 = v_st(sr, vc);
  const int vgo0 = sr * LDV + vc;
  const int kgo0 = sr * LDKK + vc, klo0 = sr * 384 + ((vc * 2) ^ (((sr >> 1) & 7) << 4));
  int kb4[4];
#pragma unroll
  for (int q = 0; q < 4; ++q) kb4[q] = r32 * 384 + ((q * 32 + hi * 16) ^ (((r32 >> 1) & 7) << 4));
  const int vb0 = (int)(uintptr_t)V_lds + v_rd_base(lane);
  bf16x8 vs0, vs1, ks0, ks1, ks2;
#define TROW(t) ((t) == 0 ? (long)metaRow : (long)realRow0 + (long)((t) - 1) * KVBLK)
#define SLOAD(t) do { const long r0_ = TROW(t); const bf16_t* vp_ = Vh + r0_ * LDV + vgo0; const bf16_t* kp_ = Kh + r0_ * LDKK + kgo0; \
    vs0 = *reinterpret_cast<const bf16x8*>(vp_); vs1 = *reinterpret_cast<const bf16x8*>(vp_ + 64); \
    ks0 = *reinterpret_cast<const bf16x8*>(kp_); ks1 = *reinterpret_cast<const bf16x8*>(kp_ + 64); ks2 = *reinterpret_cast<const bf16x8*>(kp_ + 128); } while (0)
#define SWRITE(b) do { *(bf16x8*)(V_lds + (b) * SHM_V + vst0) = vs0; *(bf16x8*)(V_lds + (b) * SHM_V + vst0 + 1024) = vs1; \
    *(bf16x8*)(K_lds + (b) * SHM_K + klo0) = ks0; *(bf16x8*)(K_lds + (b) * SHM_K + klo0 + 128) = ks1; *(bf16x8*)(K_lds + (b) * SHM_K + klo0 + 256) = ks2; } while (0)
#define SWAIT() asm volatile("s_waitcnt vmcnt(0)" ::: "memory")
#define BARRIER() asm volatile("s_waitcnt lgkmcnt(0)\n\ts_barrier" ::: "memory")
#define RESC(a) do { if (__any((a) < 1.f)) { if (hi == 0) al_l[r32] = (a); asm volatile("s_waitcnt lgkmcnt(0)" ::: "memory"); \
    _Pragma("unroll") for (int d = 0; d < 4; ++d) _Pragma("unroll") for (int r = 0; r < 16; ++r) o[d][r] *= al_l[crow(r, hi)]; } } while (0)
#define MASK0() do { _Pragma("unroll") for (int r = 8; r < 16; ++r) p0[r] = -1e30f; _Pragma("unroll") for (int r = 0; r < 16; ++r) p1[r] = -1e30f; } while (0)
  f32x16 p0, p1; float mn, al = 1.f; bf16x8 pa0, pa1, pa2, pa3; constexpr int NT = NCHUNK;
  SLOAD(0); SWAIT(); SWRITE(0); BARRIER();
#define S1(t, CUR) do { SBAR(); qkt2(p0, p1, K_lds + (CUR) * SHM_K, qr, kb4); if ((t) == 0) MASK0(); partialSM(p0, p1, m_reg, mn, al); } while (0)
#define S2(t, CUR) do { RESC(al); finishSM(p0, p1, al, l_reg, pa0, pa1, pa2, pa3); SBAR(); pv2(o, vb0 + (CUR) * (int)SHM_V, pa0, pa1, pa2, pa3); } while (0)
  if (wid < 4) {
#define A_TILE(t, CUR) do { S1(t, CUR); BARRIER(); \
      if ((t) + 1 < NT) { SWAIT(); SWRITE((CUR) ^ 1); if ((t) + 2 < NT) SLOAD((t) + 2); } S2(t, CUR); BARRIER(); } while (0)
    SLOAD(1);
    for (int t = 0; t + 1 < NT; t += 2) { A_TILE(t, 0); A_TILE(t + 1, 1); }
    A_TILE(NT - 1, 0);
    BARRIER();
#undef A_TILE
  } else {
    SLOAD(1); BARRIER();
#define B_TILE(t, CUR) do { if ((t) + 1 < NT) { SWAIT(); SWRITE((CUR) ^ 1); if ((t) + 2 < NT) SLOAD((t) + 2); } S1(t, CUR); BARRIER(); \
      S2(t, CUR); BARRIER(); } while (0)
    for (int t = 0; t + 1 < NT; t += 2) { B_TILE(t, 0); B_TILE(t + 1, 1); }
    B_TILE(NT - 1, 0);
#undef B_TILE
  }
  if (hi == 0) li_l[r32] = l_reg; asm volatile("s_waitcnt lgkmcnt(0)" ::: "memory");
  float rli[16];
#pragma unroll
  for (int r = 0; r < 16; ++r) rli[r] = __builtin_amdgcn_rcpf(li_l[crow(r, hi)]);
  bf16_t* Ow = Ob + (long)(wid * QBLK) * LDO;
#pragma unroll
  for (int r = 0; r < 16; ++r) { const int orow = crow(r, hi);
#pragma unroll
    for (int d0 = 0; d0 < 4; ++d0) Ow[(long)orow * LDO + d0 * 32 + r32] = f2bf(o[d0][r] * rli[r]); }
  __syncthreads();
#undef TROW
#undef SLOAD
#undef SWRITE
#undef SWAIT
#undef BARRIER
#undef RESC
#undef MASK0
#undef S1
#undef S2
}
#undef SBAR
}


#define XB_TMO      128
#define XB_XCNT(j)  (256  + 64 * (j))
#define XB_XSUB(j)  (1280 + 64 * (j))
#define XB_XGEN(j)  (2304 + 64 * (j))
#define XB_TOP      3328
#define XB_TOPGEN   3392
#define XCD_BAR_WORDS 3456
#define XB_SPIN_CAP (1u << 18)
__device__ __forceinline__ unsigned xb_ld(unsigned* p)              { return __hip_atomic_load(p, __ATOMIC_RELAXED, __HIP_MEMORY_SCOPE_AGENT); }
__device__ __forceinline__ unsigned xb_add(unsigned* p, unsigned v) { return __hip_atomic_fetch_add(p, v, __ATOMIC_RELAXED, __HIP_MEMORY_SCOPE_AGENT); }
__device__ __forceinline__ unsigned xb_xcc_id() { return (unsigned)__builtin_amdgcn_s_getreg((3 << 11) | 20) & 0xFu; }
#define XB_SPIN(cond, bar) do { unsigned _sp = 0; while (cond) { __builtin_amdgcn_s_sleep(1); \
    if ((++_sp & 255u) == 0u) { if (xb_ld(&(bar)[XB_TMO])) break; if (_sp > XB_SPIN_CAP) { atomicAdd(&(bar)[XB_TMO], 1u); break; } } } } while (0)
struct XcdBarrier { unsigned* bar; unsigned x; volatile LAS unsigned* st; };
__device__ __forceinline__ XcdBarrier xcd_barrier_post(unsigned* bar, volatile LAS unsigned* st) {
    XcdBarrier b; b.bar = bar; b.x = xb_xcc_id(); b.st = st;
    if (threadIdx.x == 0) (void)xb_add(&bar[XB_XCNT(b.x)], 1u);
    return b;
}
__device__ __forceinline__ void xcd_barrier_complete(unsigned* bar, unsigned x, unsigned& nloc, unsigned& nx) {
    const unsigned G = gridDim.x * gridDim.y * gridDim.z;
    unsigned sum, cnt, mine, sp = 0u;
    for (;;) {
        sum = 0u; cnt = 0u; mine = 0u;
#pragma unroll
        for (unsigned j = 0; j < 16; ++j) { const unsigned c = xb_ld(&bar[XB_XCNT(j)]); sum += c; cnt += (c > 0u) ? 1u : 0u; mine = (j == x) ? c : mine; }
        if (sum == G) break;
        __builtin_amdgcn_s_sleep(1);
        if ((++sp & 255u) == 0u) { if (xb_ld(&bar[XB_TMO])) break; if (sp > XB_SPIN_CAP) { atomicAdd(&bar[XB_TMO], 1u); break; } }
    }
    nloc = mine > 0u ? mine : 1u; nx = cnt > 0u ? cnt : 1u;
}
__device__ __forceinline__ void xcd_barrier(const XcdBarrier& b) {
    asm volatile("s_waitcnt vmcnt(0)" ::: "memory");
    __syncthreads();
    if (threadIdx.x == 0) {
        unsigned* bar = b.bar;
        __builtin_amdgcn_s_waitcnt(0);
        unsigned nloc = b.st[0], nx = b.st[1];
        if (nloc == 0u) { xcd_barrier_complete(bar, b.x, nloc, nx); b.st[0] = nloc; b.st[1] = nx; }
        const unsigned old = xb_add(&bar[XB_XSUB(b.x)], 1u);
        const unsigned gen = old / nloc;
        if (old + 1u == (gen + 1u) * nloc) {
            __builtin_amdgcn_fence(__ATOMIC_RELEASE, "agent");
            asm volatile("s_waitcnt vmcnt(0)" ::: "memory");
            const unsigned og = xb_add(&bar[XB_TOP], 1u);
            const unsigned tg = og / nx;
            if (og + 1u == (tg + 1u) * nx) xb_add(&bar[XB_TOPGEN], 1u);
            else XB_SPIN(xb_ld(&bar[XB_TOPGEN]) == tg, bar);
            __builtin_amdgcn_fence(__ATOMIC_ACQUIRE, "agent");
            xb_add(&bar[XB_XGEN(b.x)], 1u);
            asm volatile("s_waitcnt vmcnt(0)" ::: "memory");
        } else {
            XB_SPIN(xb_ld(&bar[XB_XGEN(b.x)]) == gen, bar);
            __builtin_amdgcn_fence(__ATOMIC_ACQUIRE, "agent");
            asm volatile("s_waitcnt vmcnt(0)" ::: "memory");
        }
    }
    __syncthreads();
}

struct Args {
    const float *x, *meta, *mix_g, *w_in, *na_q_g, *na_k_g, *rpb, *meta_bias, *cq_g, *ckv_g, *w_q_up, *w_kv_up, *mq_g, *mk_g, *na_out_g, *mla_out_g, *w_out, *ffn_g, *w_gate, *w_up, *conv_w, *conv_b, *w_down;
    float* out; unsigned char* ws;
};
constexpr int LDS_BYTES = 135168;

__device__ __forceinline__ void tr_item(const float* __restrict__ W, int ldw, int c0, int ncb, int K, bf16_t* __restrict__ WT, int row_off, LAS float* scr, int item, int lane, const float* __restrict__ kgain = nullptr) {
    const int kb = item / ncb, nb = item % ncb, k0 = 64 * kb, n0 = 32 * nb;
    float tv[32];
#pragma unroll
    for (int i = 0; i < 32; ++i) { const int kk = 2 * i + (lane >> 5); tv[i] = W[(size_t)(k0 + kk) * ldw + c0 + n0 + (lane & 31)]; }
    if (kgain) {
#pragma unroll
        for (int i = 0; i < 32; ++i) { const int kk = 2 * i + (lane >> 5); tv[i] *= kgain[k0 + kk]; } }
#pragma unroll
    for (int i = 0; i < 32; ++i) { const int kk = 2 * i + (lane >> 5); scr[kk * 33 + (lane & 31)] = tv[i]; }
    asm volatile("s_waitcnt lgkmcnt(0)" ::: "memory");
    const int c = lane & 7;
#pragma unroll
    for (int j = 0; j < 4; ++j) { const int n = (lane >> 3) + 8 * j; const LAS float* s = scr + (8 * c) * 33 + n;
        u32x4 o; o.x = cvt_pk_bf16(s[0 * 33], s[1 * 33]); o.y = cvt_pk_bf16(s[2 * 33], s[3 * 33]); o.z = cvt_pk_bf16(s[4 * 33], s[5 * 33]); o.w = cvt_pk_bf16(s[6 * 33], s[7 * 33]);
        *(u32x4*)(WT + (size_t)(row_off + n0 + n) * K + k0 + 8 * c) = o; }
    asm volatile("s_waitcnt lgkmcnt(0)" ::: "memory");
}

__device__ __forceinline__ void rms_row_f32(const float* __restrict__ src, const float* __restrict__ gain, bf16_t* __restrict__ dst, int lane) {
    f32x4 v[8]; float s = 0.f;
#pragma unroll
    for (int j = 0; j < 8; ++j) { v[j] = *(const f32x4*)(src + 4 * lane + 256 * j); s += (v[j].x * v[j].x + v[j].y * v[j].y) + (v[j].z * v[j].z + v[j].w * v[j].w); }
    const float rs = __builtin_amdgcn_rsqf(wave_sum(s) * (1.f / DM) + EPS);
#pragma unroll
    for (int j = 0; j < 8; ++j) { const f32x4 g = *(const f32x4*)(gain + 4 * lane + 256 * j); u32x2 w; w.x = cvt_pk_bf16(v[j].x * rs * g.x, v[j].y * rs * g.y); w.y = cvt_pk_bf16(v[j].z * rs * g.z, v[j].w * rs * g.w);
        *(u32x2*)(dst + 4 * lane + 256 * j) = w; }
}

__device__ __forceinline__ void na_norm_q(bf16x8 (&qf)[4], const float* __restrict__ gq, int g) {
    float f[4][8]; float ss = 0.f;
#pragma unroll
    for (int ds = 0; ds < 4; ++ds) { const u32x4 v = __builtin_bit_cast(u32x4, qf[ds]);
        f[ds][0] = bflo(v.x); f[ds][1] = bfhi(v.x); f[ds][2] = bflo(v.y); f[ds][3] = bfhi(v.y); f[ds][4] = bflo(v.z); f[ds][5] = bfhi(v.z); f[ds][6] = bflo(v.w); f[ds][7] = bfhi(v.w);
#pragma unroll
        for (int e = 0; e < 8; ++e) ss += f[ds][e] * f[ds][e]; }
    ss += __shfl_xor(ss, 16); ss += __shfl_xor(ss, 32);
    const float rs = __builtin_amdgcn_rsqf(ss * (1.f / 128.f) + EPS);
#pragma unroll
    for (int ds = 0; ds < 4; ++ds) { const f32x4 g0 = *(const f32x4*)(gq + 32 * ds + 8 * g), g1 = *(const f32x4*)(gq + 32 * ds + 8 * g + 4);
        u32x4 w; w.x = cvt_pk_bf16(f[ds][0] * rs * g0.x, f[ds][1] * rs * g0.y); w.y = cvt_pk_bf16(f[ds][2] * rs * g0.z, f[ds][3] * rs * g0.w);
        w.z = cvt_pk_bf16(f[ds][4] * rs * g1.x, f[ds][5] * rs * g1.y); w.w = cvt_pk_bf16(f[ds][6] * rs * g1.z, f[ds][7] * rs * g1.w);
        qf[ds] = __builtin_bit_cast(bf16x8, w); }
}

__global__ void __launch_bounds__(512, 2) fwd_kernel(Args P) {
    extern __shared__ __attribute__((aligned(16))) unsigned char lds[];
    cg::grid_group grid = cg::this_grid();
    volatile LAS unsigned* bst = (volatile LAS unsigned*)((LAS unsigned char*)lds + 131072 + 64);
    if (threadIdx.x < 2) bst[threadIdx.x] = 0u;
    __syncthreads();
    const XcdBarrier xbar = xcd_barrier_post((unsigned*)P.ws, bst);
    const int wid0 = __builtin_amdgcn_readfirstlane((int)threadIdx.x >> 6);
    const int G = gridDim.x, NGW = G * 8;
#define CAS __attribute__((address_space(4)))
#define PH_BEGIN const CAS Args* pa_ = (const CAS Args*)__builtin_amdgcn_kernarg_segment_ptr(); asm volatile("" : "+s"(pa_)); const CAS Args& P = *pa_; (void)P;   \
    int tid; asm volatile("v_mbcnt_lo_u32_b32 %0, -1, 0\n\tv_mbcnt_hi_u32_b32 %0, -1, %0" : "=v"(tid)); tid += wid0 * 64;     const int lane = tid & 63, wid = __builtin_amdgcn_readfirstlane(tid >> 6), gw = blockIdx.x * 8 + wid; (void)lane; (void)gw;
    unsigned char* ws = P.ws;
        bf16_t* W1T = (bf16_t*)(ws + WS_W1T); bf16_t* WVT = (bf16_t*)(ws + WS_WVT); bf16_t* WQT = (bf16_t*)(ws + WS_WQT); bf16_t* WKVT = (bf16_t*)(ws + WS_WKVT);
        bf16_t* WOT = (bf16_t*)(ws + WS_WOT); bf16_t* WGT = (bf16_t*)(ws + WS_WGT); bf16_t* WUT = (bf16_t*)(ws + WS_WUT); bf16_t* WDT = (bf16_t*)(ws + WS_WDT);
        bf16_t* HN = (bf16_t*)(ws + WS_HN); bf16_t* PROJ = (bf16_t*)(ws + WS_PROJ); bf16_t* VT = (bf16_t*)(ws + WS_VT); bf16_t* CQN = (bf16_t*)(ws + WS_CQN); bf16_t* CKVN = (bf16_t*)(ws + WS_CKVN);
        bf16_t* QRAW = (bf16_t*)(ws + WS_QRAW); bf16_t* KV = (bf16_t*)(ws + WS_KV); bf16_t* OUTA = (bf16_t*)(ws + WS_OUTA); bf16_t* OUTB = (bf16_t*)(ws + WS_OUTB);
        bf16_t* QP = (bf16_t*)(ws + WS_QP); bf16_t* KP = (bf16_t*)(ws + WS_KP); bf16_t* MIX = (bf16_t*)(ws + WS_MIX); bf16_t* HN2 = (bf16_t*)(ws + WS_HN2);
        bf16_t* GB = (bf16_t*)(ws + WS_G); bf16_t* ACT = (bf16_t*)(ws + WS_ACT);
        float* TAB = (float*)(ws + WS_TAB); float* PART = (float*)(ws + WS_PART);
        float* OA15 = (float*)(ws + WS_SMALL + SM_OA15); float* MIX15 = (float*)(ws + WS_SMALL + SM_MIX15); float* H115 = (float*)(ws + WS_SMALL + SM_H115);
        float* HN215 = (float*)(ws + WS_SMALL + SM_HN215); float* G15 = (float*)(ws + WS_SMALL + SM_G15); float* SSQ = (float*)(ws + WS_SMALL + SM_SSQ); float* SSQP = (float*)(ws + WS_SMALL + SM_SSQP); (void)HN215;

        { PH_BEGIN
            LAS float* scr = (LAS float*)((LAS unsigned char*)lds + wid * 16384);
            constexpr int I1 = 32 * 64, I2 = 32 * 32, I3 = 32 * 26, I4 = 8 * 48, I5 = 4 * 64, I6 = 32 * 64, I7 = 32 * 176, I8 = 32 * 176, I9 = 88 * 64;
            constexpr int NIT = I1 + I2 + I3 + I4 + I5 + I6 + I7 + I8 + I9;
            for (int it = gw; it < NIT; it += NGW) {
                int r = it;
                if (r < I1) { tr_item(P.w_in, INC, 0, 64, DM, W1T, 0, scr, r, lane); continue; } r -= I1;
                if (r < I2) { tr_item(P.w_in, INC, 2048, 32, DM, WVT, 0, scr, r, lane); continue; } r -= I2;
                if (r < I3) { tr_item(P.w_in, INC, 3072, 26, DM, W1T, 2048, scr, r, lane); continue; } r -= I3;
                if (r < I4) { tr_item(P.w_q_up, 1536, 0, 48, 512, WQT, 0, scr, r, lane); continue; } r -= I4;
                if (r < I5) { tr_item(P.w_kv_up, 2048, 0, 64, 256, WKVT, 0, scr, r, lane); continue; } r -= I5;
                if (r < I6) { tr_item(P.w_out, DM, 0, 64, DM, WOT, 0, scr, r, lane); continue; } r -= I6;
                if (r < I7) { tr_item(P.w_gate, DFF, 0, 176, DM, WGT, 0, scr, r, lane, P.ffn_g); continue; } r -= I7;
                if (r < I8) { tr_item(P.w_up, DFF, 0, 176, DM, WUT, 0, scr, r, lane, P.ffn_g); continue; } r -= I8;
                tr_item(P.w_down, DM, 0, 64, DFF, WDT, 0, scr, r, lane);
            }
            for (int i = blockIdx.x * 512 + tid; i < NREAL; i += G * 512) SSQ[i] = 0.f;
            { const u32x4 z = {0u, 0u, 0u, 0u};
              for (size_t i = (size_t)blockIdx.x * 512 + tid; i < (size_t)192 * DM / 8; i += (size_t)G * 512) *(u32x4*)(W1T + (size_t)2880 * DM + i * 8) = z;
              for (size_t i = (size_t)blockIdx.x * 512 + tid; i < (size_t)(MP - 32800) * DM / 8; i += (size_t)G * 512) *(u32x4*)(HN + (size_t)32800 * DM + i * 8) = z; }
            for (int row = gw; row < 32800; row += NGW) {
                const float* src = row < NREAL ? P.x + (size_t)row * DM : P.meta + (size_t)((row - MROW0) & 15) * DM;
                rms_row_f32(src, P.mix_g, HN + (size_t)row * DM, lane);
            }
            for (int e = blockIdx.x * 512 + tid; e < LTOT * 32; e += G * 512) {
                const int pos = e >> 5, i = e & 31;
                const double inv = exp2(-(double)i * (13.287712379549449 / 32.0));
                const float a = (float)pos * (float)inv;
                double rev = (double)a * 0.15915494309189535; rev -= rint(rev);
                const float fr = (float)rev;
                TAB[2 * e] = __builtin_amdgcn_cosf(fr); TAB[2 * e + 1] = __builtin_amdgcn_sinf(fr);
            }
        }
        grid.sync();
        { PH_BEGIN pg8::Gemm g = pg8::Gemm{HN, W1T, MP, PJ, DM}; pg8::EpiBf16 E = pg8::EpiBf16{PROJ, PJ, nullptr}; pg8::StaticOrder S; S.init(g.M, g.N, G, (int)blockIdx.x);
          pg8::gemm_phase<pg8::EpiBf16, pg8::StaticOrder, true, true>((LAS unsigned char*)lds, g, S, E, tid); }
        { PH_BEGIN pg8::Gemm g = pg8::Gemm{WVT, HN, 1024, MP, DM}; pg8::EpiBf16 E = pg8::EpiBf16{VT, MP, nullptr}; pg8::StaticOrder S; S.init(g.M, g.N, G, (int)((blockIdx.x + G / 2) % G));
          pg8::gemm_phase<pg8::EpiBf16, pg8::StaticOrder, true, true>((LAS unsigned char*)lds, g, S, E, tid); }
        xcd_barrier(xbar);
        { PH_BEGIN
            for (int row = gw; row < MP; row += NGW) {
                bf16_t* pr = PROJ + (size_t)row * PJ;
#pragma unroll
                for (int i = 2; i < 4; ++i) {
                    const u32x4 v = *(const u32x4*)(pr + 512 * i + 8 * lane);
                    float f0 = bflo(v.x), f1 = bfhi(v.x), f2 = bflo(v.y), f3 = bfhi(v.y), f4 = bflo(v.z), f5 = bfhi(v.z), f6 = bflo(v.w), f7 = bfhi(v.w);
                    float ss = f0 * f0 + f1 * f1 + f2 * f2 + f3 * f3 + f4 * f4 + f5 * f5 + f6 * f6 + f7 * f7;
                    ss += __shfl_xor(ss, 1); ss += __shfl_xor(ss, 2); ss += __shfl_xor(ss, 4); ss += __shfl_xor(ss, 8);
                    const float rs = __builtin_amdgcn_rsqf(ss * (1.f / 128.f) + EPS);
                    const float* gp = (i < 2 ? P.na_q_g : P.na_k_g) + ((8 * lane) & 127);
                    const f32x4 g0 = *(const f32x4*)gp, g1 = *(const f32x4*)(gp + 4);
                    u32x4 w; w.x = cvt_pk_bf16(f0 * rs * g0.x, f1 * rs * g0.y); w.y = cvt_pk_bf16(f2 * rs * g0.z, f3 * rs * g0.w); w.z = cvt_pk_bf16(f4 * rs * g1.x, f5 * rs * g1.y); w.w = cvt_pk_bf16(f6 * rs * g1.z, f7 * rs * g1.w);
                    *(u32x4*)(pr + 512 * i + 8 * lane) = w;
                }
                {
                    const u32x4 v = *(const u32x4*)(pr + 2048 + 8 * lane);
                    float f0 = bflo(v.x), f1 = bfhi(v.x), f2 = bflo(v.y), f3 = bfhi(v.y), f4 = bflo(v.z), f5 = bfhi(v.z), f6 = bflo(v.w), f7 = bfhi(v.w);
                    const float ss = wave_sum(f0 * f0 + f1 * f1 + f2 * f2 + f3 * f3 + f4 * f4 + f5 * f5 + f6 * f6 + f7 * f7);
                    const float rs = __builtin_amdgcn_rsqf(ss * (1.f / 512.f) + EPS);
                    const float* gp = P.cq_g + 8 * lane; const f32x4 g0 = *(const f32x4*)gp, g1 = *(const f32x4*)(gp + 4);
                    u32x4 w; w.x = cvt_pk_bf16(f0 * rs * g0.x, f1 * rs * g0.y); w.y = cvt_pk_bf16(f2 * rs * g0.z, f3 * rs * g0.w); w.z = cvt_pk_bf16(f4 * rs * g1.x, f5 * rs * g1.y); w.w = cvt_pk_bf16(f6 * rs * g1.z, f7 * rs * g1.w);
                    *(u32x4*)(CQN + (size_t)row * 512 + 8 * lane) = w;
                }
                {
                    const u32x4 v = *(const u32x4*)(pr + 2560 + 8 * lane);
                    float f0 = bflo(v.x), f1 = bfhi(v.x), f2 = bflo(v.y), f3 = bfhi(v.y), f4 = bflo(v.z), f5 = bfhi(v.z), f6 = bflo(v.w), f7 = bfhi(v.w);
                    float ss = f0 * f0 + f1 * f1 + f2 * f2 + f3 * f3 + f4 * f4 + f5 * f5 + f6 * f6 + f7 * f7;
                    ss += __shfl_xor(ss, 1); ss += __shfl_xor(ss, 2); ss += __shfl_xor(ss, 4); ss += __shfl_xor(ss, 8); ss += __shfl_xor(ss, 16);
                    const float rs = __builtin_amdgcn_rsqf(ss * (1.f / 256.f) + EPS);
                    const float* gp = P.ckv_g + ((8 * lane) & 255); const f32x4 g0 = *(const f32x4*)gp, g1 = *(const f32x4*)(gp + 4);
                    u32x4 w; w.x = cvt_pk_bf16(f0 * rs * g0.x, f1 * rs * g0.y); w.y = cvt_pk_bf16(f2 * rs * g0.z, f3 * rs * g0.w); w.z = cvt_pk_bf16(f4 * rs * g1.x, f5 * rs * g1.y); w.w = cvt_pk_bf16(f6 * rs * g1.z, f7 * rs * g1.w);
                    if (lane < 32) *(u32x4*)(CKVN + (size_t)row * 256 + 8 * lane) = w;
                }
            }
        }
        xcd_barrier(xbar);
        { PH_BEGIN pg8::Gemm g = pg8::Gemm{CQN, WQT, MP, 1536, 512}; pg8::EpiBf16 E = pg8::EpiBf16{QRAW, 1536, nullptr}; pg8::StaticOrder S; S.init(g.M, g.N, G, (int)blockIdx.x);
          pg8::gemm_phase<pg8::EpiBf16, pg8::StaticOrder, true, true>((LAS unsigned char*)lds, g, S, E, tid); }
        { PH_BEGIN pg8::Gemm g = pg8::Gemm{CKVN, WKVT, MP, 2048, 256}; pg8::EpiBf16 E = pg8::EpiBf16{KV, 2048, nullptr}; pg8::StaticOrder S; S.init(g.M, g.N, G, (int)((blockIdx.x + G / 2) % G));
          pg8::gemm_phase<pg8::EpiBf16, pg8::StaticOrder, true, true>((LAS unsigned char*)lds, g, S, E, tid); }
        { PH_BEGIN
            const int ql = lane & 15, g = lane >> 4, rsel = wid >> 2, j = wid & 3;
            float* rp = (float*)lds + wid * 512;
            char* stg = (char*)lds + 16384;
            int hcur = -1;
            const int xcd = (int)blockIdx.x & 7, cblk = (int)blockIdx.x >> 3;
            const int ktok = tid >> 4, kc = tid & 15, klds = ktok * 256 + 16 * (kc ^ ((((ktok >> 3) & 3) << 2) | (ktok & 3)));
            const int vd = tid >> 3, vc = tid & 7, vlds = vd * 128 + 16 * (vc ^ ((vd >> 1) & 7));
            const int kb = min(max(16 * j - 8, 0), 32);
            const int xh = ((kb >> 3) + (ql >> 2)) & 3, xl = ql & 3;
            const int kbase = (kb + 8 * (ql >> 2) + (ql & 3)) * 256 + 16 * (g ^ xl);
            const int kofs0 = kbase + 64 * (0 ^ xh), kofs1 = kbase + 64 * (1 ^ xh), kofs2 = kbase + 64 * (2 ^ xh), kofs3 = kbase + 64 * (3 ^ xh);
            const int vofs = ql * 128 + 16 * (((kb >> 3) + g) ^ (ql >> 1));
            for (int k = 0;; ++k) {
                int combo, rpair;
                if (G == 256) { if (k >= 8) break; const int lin = k * 32 + cblk; combo = xcd * 2 + (lin >> 7); rpair = lin & 127; }
                else { const int bi = (int)blockIdx.x + k * G; if (bi >= 2048) break; combo = bi >> 7; rpair = bi & 127; }
                const int h = combo & 7, b = combo >> 3, r0 = 2 * rpair, r = r0 + rsel;
                if (h != hcur) { for (int i = lane; i < 465; i += 64) rp[i] = P.rpb[h * 465 + i]; hcur = h; }
                const int u0 = min(max(r0 - 4, 0), 248), rs = min(max(r - 4, 0), 248);
                const size_t tokb = (size_t)b * SEQ, tok_q = tokb + r * 64 + 16 * j;
                const bf16_t* qp = PROJ + (tok_q + ql) * PJ + h * 128 + 8 * g;
                bf16x8 qf[4];
#pragma unroll
                for (int ds = 0; ds < 4; ++ds) qf[ds] = *(const bf16x8*)(qp + 32 * ds);
                na_norm_q(qf, P.na_q_g, g);
#define NA_LOADT(s, R0, R1) do { const size_t t0_ = tokb + (size_t)min(u0 + ((s) % 9), 255) * 64; \
                    if ((s) < 9) { const bf16_t* p_ = PROJ + (t0_ + ktok) * PJ + 1024 + h * 128 + kc * 8; R0 = *(const bf16x8*)p_; R1 = *(const bf16x8*)(p_ + (size_t)32 * PJ); } \
                    else { const bf16_t* p_ = VT + (size_t)(h * 128 + vd) * MP + t0_ + vc * 8; R0 = *(const bf16x8*)p_; R1 = *(const bf16x8*)(p_ + (size_t)64 * MP); } } while (0)
#define NA_WRITET(s, R0, R1) do { char* b_ = stg + ((s) & 1) * 16384; \
                    if ((s) < 9) { *(bf16x8*)(b_ + klds) = R0; *(bf16x8*)(b_ + klds + 8192) = R1; } else { *(bf16x8*)(b_ + vlds) = R0; *(bf16x8*)(b_ + vlds + 8192) = R1; } } while (0)
#define NA_BAR() asm volatile("s_waitcnt lgkmcnt(0)\n\ts_barrier" ::: "memory")
                bf16x8 ra0, ra1, rb0, rb1;
                NA_LOADT(0, ra0, ra1); NA_LOADT(1, rb0, rb1);
                f32x4 st[19];
#define NA_SSTEP(s, R0, R1) do { NA_WRITET(s, R0, R1); NA_LOADT((s) + 2, R0, R1); NA_BAR(); \
                    const char* kbuf_ = stg + ((s) & 1) * 16384; \
                    _Pragma("unroll") for (int hh = 0; hh < 2; ++hh) { f32x4 a = {0.f, 0.f, 0.f, 0.f}; \
                        a = __builtin_amdgcn_mfma_f32_16x16x32_bf16(*(const bf16x8*)(kbuf_ + hh * 1024 + kofs0), qf[0], a, 0, 0, 0); \
                        a = __builtin_amdgcn_mfma_f32_16x16x32_bf16(*(const bf16x8*)(kbuf_ + hh * 1024 + kofs1), qf[1], a, 0, 0, 0); \
                        a = __builtin_amdgcn_mfma_f32_16x16x32_bf16(*(const bf16x8*)(kbuf_ + hh * 1024 + kofs2), qf[2], a, 0, 0, 0); \
                        a = __builtin_amdgcn_mfma_f32_16x16x32_bf16(*(const bf16x8*)(kbuf_ + hh * 1024 + kofs3), qf[3], a, 0, 0, 0); \
                        st[2 * (s) + hh] = a; } } while (0)
                NA_SSTEP(0, ra0, ra1); NA_SSTEP(1, rb0, rb1); NA_SSTEP(2, ra0, ra1); NA_SSTEP(3, rb0, rb1); NA_SSTEP(4, ra0, ra1);
                NA_SSTEP(5, rb0, rb1); NA_SSTEP(6, ra0, ra1);
                bf16x8 km[4];
                { const bf16_t* kpm = PROJ + (size_t)(MROW0 + ql) * PJ + 1024 + h * 128 + 8 * g;
#pragma unroll
                  for (int ds = 0; ds < 4; ++ds) km[ds] = *(const bf16x8*)(kpm + 32 * ds); }
                NA_SSTEP(7, rb0, rb1); NA_SSTEP(8, ra0, ra1);
                { f32x4 a = {0.f, 0.f, 0.f, 0.f};
#pragma unroll
                  for (int ds = 0; ds < 4; ++ds) a = __builtin_amdgcn_mfma_f32_16x16x32_bf16(km[ds], qf[ds], a, 0, 0, 0);
                  st[18] = a; }
                const int c = 16 * j + ql, cs = min(max(c - 8, 0), 48);
                constexpr float SC = 0.08838834764831845f;
                float mx = -1e30f;
#pragma unroll
                for (int t = 0; t < 18; ++t) {
                    const int kr = u0 + (t >> 1); const bool rowok = (kr >= rs) && (kr < rs + 8);
                    const int dr = min(max(kr - r + 7, 0), 14);
#pragma unroll
                    for (int e = 0; e < 4; ++e) {
                        const int kcol = kb + 8 * g + 4 * (t & 1) + e; const bool valid = rowok && (kcol >= cs) && (kcol < cs + 16);
                        const int dc = min(max(kcol - c + 15, 0), 30);
                        float sv = (st[t][e] * SC + rp[dr * 31 + dc]) * LOG2E; sv = valid ? sv : -1e30f; st[t][e] = sv; mx = fmaxf(mx, sv);
                    }
                }
#pragma unroll
                for (int e = 0; e < 4; ++e) { const float sv = (st[18][e] * SC + P.meta_bias[h * 16 + 4 * g + e]) * LOG2E; st[18][e] = sv; mx = fmaxf(mx, sv); }
                mx = fmaxf(mx, __shfl_xor(mx, 16)); mx = fmaxf(mx, __shfl_xor(mx, 32));
                float l = 0.f;
#pragma unroll
                for (int t = 0; t < 19; ++t)
#pragma unroll
                    for (int e = 0; e < 4; ++e) { const float p = __builtin_amdgcn_exp2f(st[t][e] - mx); st[t][e] = p; l += p; }
                l += __shfl_xor(l, 16); l += __shfl_xor(l, 32);
                f32x4 o[8];
#pragma unroll
                for (int dg = 0; dg < 8; ++dg) o[dg] = (f32x4){0.f, 0.f, 0.f, 0.f};
#define NA_VSTEP(s, R0, R1) do { NA_WRITET(s, R0, R1); if ((s) + 2 < 18) NA_LOADT((s) + 2, R0, R1); NA_BAR(); \
                    const char* vbuf_ = stg + ((s) & 1) * 16384 + vofs; constexpr int i_ = (s) - 9; \
                    u32x4 pw; pw.x = cvt_pk_bf16(st[2 * i_][0], st[2 * i_][1]); pw.y = cvt_pk_bf16(st[2 * i_][2], st[2 * i_][3]); pw.z = cvt_pk_bf16(st[2 * i_ + 1][0], st[2 * i_ + 1][1]); pw.w = cvt_pk_bf16(st[2 * i_ + 1][2], st[2 * i_ + 1][3]); \
                    const bf16x8 pa = __builtin_bit_cast(bf16x8, pw); \
                    _Pragma("unroll") for (int dg = 0; dg < 8; ++dg) o[dg] = __builtin_amdgcn_mfma_f32_16x16x32_bf16(pa, *(const bf16x8*)(vbuf_ + dg * 2048), o[dg], 0, 0, 0); } while (0)
                NA_VSTEP(9, rb0, rb1); NA_VSTEP(10, ra0, ra1); NA_VSTEP(11, rb0, rb1); NA_VSTEP(12, ra0, ra1); NA_VSTEP(13, rb0, rb1);
                NA_VSTEP(14, ra0, ra1); NA_VSTEP(15, rb0, rb1);
                u32x2 vmf[8];
                { const bf16_t* vm = VT + (size_t)(h * 128 + ql) * MP + MROW0 + 4 * g;
#pragma unroll
                  for (int dg = 0; dg < 8; ++dg) vmf[dg] = *(const u32x2*)(vm + (size_t)(16 * dg) * MP); }
                NA_VSTEP(16, ra0, ra1); NA_VSTEP(17, rb0, rb1);
                {   u32x4 pw; pw.x = cvt_pk_bf16(st[18][0], st[18][1]); pw.y = cvt_pk_bf16(st[18][2], st[18][3]); pw.z = 0u; pw.w = 0u;
                    const bf16x8 pa = __builtin_bit_cast(bf16x8, pw);
#pragma unroll
                    for (int dg = 0; dg < 8; ++dg) { const u32x4 bw = {vmf[dg].x, vmf[dg].y, 0u, 0u};
                        o[dg] = __builtin_amdgcn_mfma_f32_16x16x32_bf16(pa, __builtin_bit_cast(bf16x8, bw), o[dg], 0, 0, 0); }
                }
#undef NA_LOADT
#undef NA_WRITET
#undef NA_BAR
#undef NA_SSTEP
#undef NA_VSTEP
                const float inv = __builtin_amdgcn_rcpf(l);
                float il[4];
#pragma unroll
                for (int e = 0; e < 4; ++e) il[e] = __shfl(inv, 4 * g + e);
#pragma unroll
                for (int e = 0; e < 4; ++e) { bf16_t* op = OUTA + (tok_q + 4 * g + e) * 1024 + h * 128 + ql;
#pragma unroll
                    for (int dg = 0; dg < 8; ++dg) op[16 * dg] = f2bf(o[dg][e] * il[e]); }
            }
            __syncthreads();
            if (gw < 8) {
                const int h = gw;
                const bf16_t* qp = PROJ + (size_t)(MROW0 + ql) * PJ + h * 128 + 8 * g; const bf16_t* kp = qp + 1024;
                bf16x8 qm[4];
#pragma unroll
                for (int ds = 0; ds < 4; ++ds) qm[ds] = *(const bf16x8*)(qp + 32 * ds);
                na_norm_q(qm, P.na_q_g, g);
                f32x4 a = {0.f, 0.f, 0.f, 0.f};
#pragma unroll
                for (int ds = 0; ds < 4; ++ds) a = __builtin_amdgcn_mfma_f32_16x16x32_bf16(*(const bf16x8*)(kp + 32 * ds), qm[ds], a, 0, 0, 0);
                float mx = -1e30f;
#pragma unroll
                for (int e = 0; e < 4; ++e) { a[e] = (a[e] * 0.08838834764831845f + P.meta_bias[h * 16 + 4 * g + e]) * LOG2E; mx = fmaxf(mx, a[e]); }
                mx = fmaxf(mx, __shfl_xor(mx, 16)); mx = fmaxf(mx, __shfl_xor(mx, 32));
                float l = 0.f;
#pragma unroll
                for (int e = 0; e < 4; ++e) { a[e] = __builtin_amdgcn_exp2f(a[e] - mx); l += a[e]; }
                l += __shfl_xor(l, 16); l += __shfl_xor(l, 32);
                u32x4 pw; pw.x = cvt_pk_bf16(a[0], a[1]); pw.y = cvt_pk_bf16(a[2], a[3]); pw.z = 0u; pw.w = 0u;
                const bf16x8 pa = __builtin_bit_cast(bf16x8, pw);
                const bf16_t* vm = VT + (size_t)(h * 128 + ql) * MP + MROW0 + 4 * g;
                const float inv15 = __shfl(__builtin_amdgcn_rcpf(l), 15);
#pragma unroll
                for (int dg = 0; dg < 8; ++dg) { const u32x2 lo = *(const u32x2*)(vm + (size_t)(16 * dg) * MP); const u32x4 bw = {lo.x, lo.y, 0u, 0u};
                    f32x4 o = {0.f, 0.f, 0.f, 0.f}; o = __builtin_amdgcn_mfma_f32_16x16x32_bf16(pa, __builtin_bit_cast(bf16x8, bw), o, 0, 0, 0);
                    if (g == 3) OA15[h * 128 + 16 * dg + ql] = o[3] * inv15; }
            }
        }
        xcd_barrier(xbar);
        { PH_BEGIN
            const int h = lane >> 3, sub = lane & 7;
            for (int row = gw; row < MP; row += NGW) {
                const int pos = row < NREAL ? 16 + (row & (SEQ - 1)) : ((row - MROW0) & 15);
                const float* tb = TAB + ((size_t)pos * 32 + 8 * (sub & 3)) * 2;
                const f32x4 t0 = *(const f32x4*)tb, t1 = *(const f32x4*)(tb + 4), t2 = *(const f32x4*)(tb + 8), t3 = *(const f32x4*)(tb + 12);
#pragma unroll
                for (int which = 0; which < 2; ++which) {
                    if (which == 0 && row < NREAL) continue;
                    const bf16_t* np = which == 0 ? QRAW + (size_t)row * 1536 + h * 192 + 16 * sub : KV + (size_t)row * 2048 + h * 256 + 16 * sub;
                    const bf16_t* rpp = which == 0 ? QRAW + (size_t)row * 1536 + h * 192 + 128 + 8 * sub : PROJ + (size_t)row * PJ + 2816 + 8 * sub;
                    const float* gn = which == 0 ? P.mq_g : P.mk_g;
                    bf16_t* dst = (which == 0 ? QP : KP) + (size_t)row * 1536 + h * 192;
                    const u32x4 a = *(const u32x4*)np, bq = *(const u32x4*)(np + 8), c = *(const u32x4*)rpp;
                    float n0 = bflo(a.x), n1 = bfhi(a.x), n2 = bflo(a.y), n3 = bfhi(a.y), n4 = bflo(a.z), n5 = bfhi(a.z), n6 = bflo(a.w), n7 = bfhi(a.w);
                    float m0 = bflo(bq.x), m1 = bfhi(bq.x), m2 = bflo(bq.y), m3 = bfhi(bq.y), m4 = bflo(bq.z), m5 = bfhi(bq.z), m6 = bflo(bq.w), m7 = bfhi(bq.w);
                    float r0 = bflo(c.x), r1 = bfhi(c.x), r2 = bflo(c.y), r3 = bfhi(c.y), r4 = bflo(c.z), r5 = bfhi(c.z), r6 = bflo(c.w), r7 = bfhi(c.w);
                    float ss = n0 * n0 + n1 * n1 + n2 * n2 + n3 * n3 + n4 * n4 + n5 * n5 + n6 * n6 + n7 * n7 + m0 * m0 + m1 * m1 + m2 * m2 + m3 * m3 + m4 * m4 + m5 * m5 + m6 * m6 + m7 * m7
                             + r0 * r0 + r1 * r1 + r2 * r2 + r3 * r3 + r4 * r4 + r5 * r5 + r6 * r6 + r7 * r7;
                    ss += __shfl_xor(ss, 1); ss += __shfl_xor(ss, 2); ss += __shfl_xor(ss, 4);
                    const float rs = __builtin_amdgcn_rsqf(ss * (1.f / 192.f) + EPS);
                    const f32x4 ga = *(const f32x4*)(gn + 16 * sub), gb = *(const f32x4*)(gn + 16 * sub + 4), gc = *(const f32x4*)(gn + 16 * sub + 8), gd = *(const f32x4*)(gn + 16 * sub + 12);
                    const f32x4 ge = *(const f32x4*)(gn + 128 + 8 * sub), gf = *(const f32x4*)(gn + 128 + 8 * sub + 4);
                    u32x4 w;
                    w.x = cvt_pk_bf16(n0 * rs * ga.x, n1 * rs * ga.y); w.y = cvt_pk_bf16(n2 * rs * ga.z, n3 * rs * ga.w); w.z = cvt_pk_bf16(n4 * rs * gb.x, n5 * rs * gb.y); w.w = cvt_pk_bf16(n6 * rs * gb.z, n7 * rs * gb.w);
                    *(u32x4*)(dst + 16 * sub) = w;
                    w.x = cvt_pk_bf16(m0 * rs * gc.x, m1 * rs * gc.y); w.y = cvt_pk_bf16(m2 * rs * gc.z, m3 * rs * gc.w); w.z = cvt_pk_bf16(m4 * rs * gd.x, m5 * rs * gd.y); w.w = cvt_pk_bf16(m6 * rs * gd.z, m7 * rs * gd.w);
                    *(u32x4*)(dst + 16 * sub + 8) = w;
                    const float y0 = r0 * rs * ge.x, y1 = r1 * rs * ge.y, y2 = r2 * rs * ge.z, y3 = r3 * rs * ge.w, y4 = r4 * rs * gf.x, y5 = r5 * rs * gf.y, y6 = r6 * rs * gf.z, y7 = r7 * rs * gf.w;
                    const float z0 = __shfl_xor(y0, 4), z1 = __shfl_xor(y1, 4), z2 = __shfl_xor(y2, 4), z3 = __shfl_xor(y3, 4), z4 = __shfl_xor(y4, 4), z5 = __shfl_xor(y5, 4), z6 = __shfl_xor(y6, 4), z7 = __shfl_xor(y7, 4);
                    const float sg = (sub < 4) ? -1.f : 1.f;
                    w.x = cvt_pk_bf16(y0 * t0.x + sg * z0 * t0.y, y1 * t0.z + sg * z1 * t0.w); w.y = cvt_pk_bf16(y2 * t1.x + sg * z2 * t1.y, y3 * t1.z + sg * z3 * t1.w);
                    w.z = cvt_pk_bf16(y4 * t2.x + sg * z4 * t2.y, y5 * t2.z + sg * z5 * t2.w); w.w = cvt_pk_bf16(y6 * t3.x + sg * z6 * t3.y, y7 * t3.z + sg * z7 * t3.w);
                    *(u32x4*)(dst + 128 + 8 * sub) = w;
                }
            }
        }
        xcd_barrier(xbar);
        { PH_BEGIN
            for (int it = gw; it < 16 * NCHUNK; it += NGW) {
                const int bh = it / NCHUNK, c = it % NCHUNK, b = bh >> 3, h = bh & 7;
                const size_t rowbase = (c == 0) ? (size_t)(MROW0 + 16 * b) : (size_t)b * SEQ + (size_t)(c - 1) * 64;
                const bf16_t* q = QP + (size_t)(MROW0 + 16 * b + 15) * 1536 + h * 192; const bf16_t* k = KP + (rowbase + lane) * 1536 + h * 192;
                float s = 0.f;
#pragma unroll 4
                for (int ch = 0; ch < 24; ++ch) s += dot8(*(const u32x4*)(q + ch * 8), *(const u32x4*)(k + ch * 8));
                s *= mla::SCALE * LOG2E; if (c == 0 && lane >= 16) s = -1e30f;
                const float m = wave_max(s); const float p = __builtin_amdgcn_exp2f(s - m); const float l = wave_sum(p);
                const bf16_t* vp = KV + rowbase * 2048 + h * 256 + 128 + 2 * lane;
                float o0 = 0.f, o1 = 0.f;
#pragma unroll 8
                for (int key = 0; key < 64; ++key) { const float pk = __shfl(p, key); const unsigned u = *(const unsigned*)(vp + (size_t)key * 2048); o0 += pk * bflo(u); o1 += pk * bfhi(u); }
                float* pt = PART + (size_t)it * PARTW;
                if (lane == 0) { pt[0] = m; pt[1] = l; }
                pt[4 + 2 * lane] = o0; pt[5 + 2 * lane] = o1;
            }
            __syncthreads();
            const int xcd = blockIdx.x & 7, idx = blockIdx.x >> 3, nper = G >> 3;
            for (int i = 0;; ++i) {
                int u;
                if ((G & 7) == 0 && nper == 32) { const int slot = i * 8 + xcd; if (slot >= 32) break; u = (slot >> 1) * 64 + (slot & 1) * 32 + idx; }
                else { u = blockIdx.x + i * G; if (u >= 1024) break; }
                const int bh = u >> 6, qb = u & 63, b = bh >> 3, h = bh & 7;
                const size_t q0 = (size_t)b * SEQ + (size_t)qb * 256;
                int tid_u = tid; asm volatile("" : "+v"(tid_u));
                mla::attn_unit2(QRAW + q0 * 1536 + h * 192, KP + h * 192, KV + h * 256 + 128, OUTB + q0 * 1024 + h * 128, MROW0 + 16 * b, b * SEQ, (char*)lds, tid_u, P.mq_g, TAB, 16 + qb * 256);
            }
        }
        xcd_barrier(xbar);
        { PH_BEGIN
            const int nw9 = (G > 1) ? (G - 1) * 8 : 8;
            if ((int)blockIdx.x < G - 1 || G == 1)
            for (int row = gw; row < NREAL; row += nw9) {
#pragma unroll
                for (int which = 0; which < 2; ++which) {
                    const bf16_t* src = (which == 0 ? OUTA : OUTB) + (size_t)row * 1024 + 16 * lane; const float* gn = (which == 0 ? P.na_out_g : P.mla_out_g) + 16 * lane;
                    const u32x4 a = *(const u32x4*)src, bq = *(const u32x4*)(src + 8);
                    float n0 = bflo(a.x), n1 = bfhi(a.x), n2 = bflo(a.y), n3 = bfhi(a.y), n4 = bflo(a.z), n5 = bfhi(a.z), n6 = bflo(a.w), n7 = bfhi(a.w);
                    float m0 = bflo(bq.x), m1 = bfhi(bq.x), m2 = bflo(bq.y), m3 = bfhi(bq.y), m4 = bflo(bq.z), m5 = bfhi(bq.z), m6 = bflo(bq.w), m7 = bfhi(bq.w);
                    const float ss = wave_sum(n0 * n0 + n1 * n1 + n2 * n2 + n3 * n3 + n4 * n4 + n5 * n5 + n6 * n6 + n7 * n7 + m0 * m0 + m1 * m1 + m2 * m2 + m3 * m3 + m4 * m4 + m5 * m5 + m6 * m6 + m7 * m7);
                    const float rs = __builtin_amdgcn_rsqf(ss * (1.f / 1024.f) + EPS);
                    const f32x4 ga = *(const f32x4*)gn, gb = *(const f32x4*)(gn + 4), gc = *(const f32x4*)(gn + 8), gd = *(const f32x4*)(gn + 12);
                    bf16_t* dst = MIX + (size_t)row * DM + which * 1024 + 16 * lane; u32x4 w;
                    w.x = cvt_pk_bf16(n0 * rs * ga.x, n1 * rs * ga.y); w.y = cvt_pk_bf16(n2 * rs * ga.z, n3 * rs * ga.w); w.z = cvt_pk_bf16(n4 * rs * gb.x, n5 * rs * gb.y); w.w = cvt_pk_bf16(n6 * rs * gb.z, n7 * rs * gb.w);
                    *(u32x4*)dst = w;
                    w.x = cvt_pk_bf16(m0 * rs * gc.x, m1 * rs * gc.y); w.y = cvt_pk_bf16(m2 * rs * gc.z, m3 * rs * gc.w); w.z = cvt_pk_bf16(m4 * rs * gd.x, m5 * rs * gd.y); w.w = cvt_pk_bf16(m6 * rs * gd.z, m7 * rs * gd.w);
                    *(u32x4*)(dst + 8) = w;
                }
            }
            if ((int)blockIdx.x == G - 1) {
                float* sh = (float*)lds;
                __syncthreads();
                for (int bh = wid; bh < 16; bh += 8) {
                    const float* pt = PART + (size_t)bh * NCHUNK * PARTW;
                    float mm = -1e30f;
                    for (int c = lane; c < NCHUNK; c += 64) mm = fmaxf(mm, pt[(size_t)c * PARTW]);
                    mm = wave_max(mm);
                    float L = 0.f, o0 = 0.f, o1 = 0.f;
                    for (int c = 0; c < NCHUNK; ++c) { const float* pc = pt + (size_t)c * PARTW; const float w = __builtin_amdgcn_exp2f(pc[0] - mm); L += w * pc[1]; o0 += w * pc[4 + 2 * lane]; o1 += w * pc[5 + 2 * lane]; }
                    const float inv = 1.f / L;
                    sh[bh * 128 + 2 * lane] = bfround(o0 * inv); sh[bh * 128 + 2 * lane + 1] = bfround(o1 * inv);
                }
                __syncthreads();
                if (wid < 2) {
                    const int b = wid; float sa = 0.f, sb = 0.f;
#pragma unroll
                    for (int e = 0; e < 16; ++e) { const float va = bfround(OA15[16 * lane + e]), vb = sh[b * 1024 + 16 * lane + e]; sa += va * va; sb += vb * vb; }
                    const float ra = __builtin_amdgcn_rsqf(wave_sum(sa) * (1.f / 1024.f) + EPS), rb = __builtin_amdgcn_rsqf(wave_sum(sb) * (1.f / 1024.f) + EPS);
#pragma unroll
                    for (int e = 0; e < 16; ++e) { const int i = 16 * lane + e;
                        MIX15[b * DM + i] = bfround(bfround(OA15[i]) * ra * P.na_out_g[i]); MIX15[b * DM + 1024 + i] = bfround(sh[b * 1024 + i] * rb * P.mla_out_g[i]); }
                }
                __syncthreads();
            }
        }
        xcd_barrier(xbar);
        { PH_BEGIN pg8::Gemm g = pg8::Gemm{MIX, WOT, NREAL, DM, DM}; pg8::EpiResSsq E = pg8::EpiResSsq{P.x, P.out, HN2, SSQP, DM}; pg8::StaticOrder S; S.init(g.M, g.N, G, (int)blockIdx.x);
          pg8::gemm_phase<pg8::EpiResSsq, pg8::StaticOrder, false, true>((LAS unsigned char*)lds, g, S, E, tid); }
        { PH_BEGIN
            {
                for (int n = gw; n < DM; n += NGW) {
                    const bf16_t* w = WOT + (size_t)n * DM; float a0 = 0.f, a1 = 0.f;
#pragma unroll
                    for (int i = 0; i < 4; ++i) { const int k = 8 * lane + 512 * i; const u32x4 wv = *(const u32x4*)(w + k);
                        const f32x4 x0 = *(const f32x4*)(MIX15 + k), x1 = *(const f32x4*)(MIX15 + k + 4), y0 = *(const f32x4*)(MIX15 + DM + k), y1 = *(const f32x4*)(MIX15 + DM + k + 4);
                        const float w0 = bflo(wv.x), w1 = bfhi(wv.x), w2 = bflo(wv.y), w3 = bfhi(wv.y), w4 = bflo(wv.z), w5 = bfhi(wv.z), w6 = bflo(wv.w), w7 = bfhi(wv.w);
                        a0 += w0 * x0.x + w1 * x0.y + w2 * x0.z + w3 * x0.w + w4 * x1.x + w5 * x1.y + w6 * x1.z + w7 * x1.w;
                        a1 += w0 * y0.x + w1 * y0.y + w2 * y0.z + w3 * y0.w + w4 * y1.x + w5 * y1.y + w6 * y1.z + w7 * y1.w; }
                    a0 = wave_sum(a0); a1 = wave_sum(a1);
                    if (lane == 0) { const float mb = P.meta[15 * DM + n]; H115[n] = mb + a0; H115[DM + n] = mb + a1; }
                }
            }
        }
        xcd_barrier(xbar);
        { PH_BEGIN
            for (int row = (int)blockIdx.x * 512 + tid; row < NREAL; row += G * 512) {
                const f32x4* pp = (const f32x4*)(SSQP + (size_t)row * 32); float ss = 0.f;
#pragma unroll
                for (int i = 0; i < 8; ++i) { const f32x4 v = pp[i]; ss += (v.x + v.y) + (v.z + v.w); }
                SSQ[row] = ss;
            }
        }
        xcd_barrier(xbar);
        { PH_BEGIN pg8::Gemm g = pg8::Gemm{HN2, WGT, NREAL, DFF, DM}; pg8::EpiBf16 E = pg8::EpiBf16{GB, DFF, SSQ}; pg8::StaticOrder S; S.init(g.M, g.N, G, (int)blockIdx.x);
          pg8::gemm_phase<pg8::EpiBf16, pg8::StaticOrder, true, true>((LAS unsigned char*)lds, g, S, E, tid); }
        { PH_BEGIN
            {
                for (int n = gw; n < DFF; n += NGW) {
                    const bf16_t* w = WGT + (size_t)n * DM; float a0 = 0.f, a1 = 0.f, s0 = 0.f, s1 = 0.f;
#pragma unroll
                    for (int i = 0; i < 4; ++i) { const int k = 8 * lane + 512 * i; const u32x4 wv = *(const u32x4*)(w + k);
                        const f32x4 x0 = *(const f32x4*)(H115 + k), x1 = *(const f32x4*)(H115 + k + 4), y0 = *(const f32x4*)(H115 + DM + k), y1 = *(const f32x4*)(H115 + DM + k + 4);
                        const float w0 = bflo(wv.x), w1 = bfhi(wv.x), w2 = bflo(wv.y), w3 = bfhi(wv.y), w4 = bflo(wv.z), w5 = bfhi(wv.z), w6 = bflo(wv.w), w7 = bfhi(wv.w);
                        a0 += w0 * x0.x + w1 * x0.y + w2 * x0.z + w3 * x0.w + w4 * x1.x + w5 * x1.y + w6 * x1.z + w7 * x1.w;
                        a1 += w0 * y0.x + w1 * y0.y + w2 * y0.z + w3 * y0.w + w4 * y1.x + w5 * y1.y + w6 * y1.z + w7 * y1.w;
                        s0 += x0.x * x0.x + x0.y * x0.y + x0.z * x0.z + x0.w * x0.w + x1.x * x1.x + x1.y * x1.y + x1.z * x1.z + x1.w * x1.w;
                        s1 += y0.x * y0.x + y0.y * y0.y + y0.z * y0.z + y0.w * y0.w + y1.x * y1.x + y1.y * y1.y + y1.z * y1.z + y1.w * y1.w; }
                    a0 = wave_sum(a0) * __builtin_amdgcn_rsqf(wave_sum(s0) * (1.f / DM) + EPS); a1 = wave_sum(a1) * __builtin_amdgcn_rsqf(wave_sum(s1) * (1.f / DM) + EPS);
                    if (lane == 0) { G15[n] = a0; G15[DFF + n] = a1; }
                }
            }
        }
        xcd_barrier(xbar);
        { PH_BEGIN pg8::Gemm g{HN2, WUT, NREAL, DFF, DM}; pg8::EpiConvGlu E{GB, ACT, DFF, P.conv_w, P.conv_b, G15, SSQ}; pg8::StaticOrder S; S.init(g.M, g.N, G, (int)blockIdx.x);
          pg8::gemm_phase<pg8::EpiConvGlu, pg8::StaticOrder, true, true>((LAS unsigned char*)lds, g, S, E, tid); }
        xcd_barrier(xbar);
        { PH_BEGIN pg8::Gemm g = pg8::Gemm{ACT, WDT, NREAL, DM, DFF}; pg8::EpiResF32 E = pg8::EpiResF32{P.out, P.out, DM}; pg8::StaticOrder S; S.init(g.M, g.N, G, (int)blockIdx.x);
          pg8::gemm_phase<pg8::EpiResF32, pg8::StaticOrder, true, true>((LAS unsigned char*)lds, g, S, E, tid); }
}

extern "C" void kernel_launch(void* const* d_in, const int* in_sizes, int n_in, void* d_out, int out_size, void* d_ws, size_t ws_size, hipStream_t stream) {
    static int grid = 0;
    if (grid == 0) {
        if (n_in != 23 || in_sizes[0] != NREAL * DM || out_size != NREAL * DM || ws_size < WS_END) {
            fprintf(stderr, "kernel_launch: unexpected shapes: n_in %d in0 %d out %d ws %zu (need %zu)\n", n_in, n_in > 0 ? in_sizes[0] : -1, out_size, ws_size, (size_t)WS_END); grid = -1; return; }
        int dev = 0, cus = 0, per_cu = 0;
        hipGetDevice(&dev); hipDeviceGetAttribute(&cus, hipDeviceAttributeMultiprocessorCount, dev);
        if (hipFuncSetAttribute((const void*)fwd_kernel, hipFuncAttributeMaxDynamicSharedMemorySize, LDS_BYTES) != hipSuccess) { fprintf(stderr, "kernel_launch: hipFuncSetAttribute failed\n"); grid = -1; return; }
        if (hipOccupancyMaxActiveBlocksPerMultiprocessor(&per_cu, (const void*)fwd_kernel, 512, LDS_BYTES) != hipSuccess || per_cu < 1) { fprintf(stderr, "kernel_launch: occupancy query gave %d\n", per_cu); per_cu = 1; }
        (void)hipGetLastError();
        grid = cus * per_cu;
    }
    if (grid < 0) return;
    Args a{};
    const float** ap = (const float**)&a;
    for (int i = 0; i < 23; ++i) ap[i] = (const float*)d_in[i];
    a.out = (float*)d_out; a.ws = (unsigned char*)d_ws;
    if (hipMemsetAsync(d_ws, 0, 16384, stream) != hipSuccess) { fprintf(stderr, "kernel_launch: memset failed\n"); return; }
    void* args[] = {&a};
    hipError_t e = hipLaunchCooperativeKernel((const void*)fwd_kernel, dim3(grid), dim3(512), args, LDS_BYTES, stream);
    if (e != hipSuccess) fprintf(stderr, "cooperative launch failed: %s (grid %d)\n", hipGetErrorString(e), grid);
}
```
